# Optimizing an MI355X kernel written in HIP

```python
import jax, jax.numpy as jnp
from jax import lax
import numpy as np

D_MODEL = 1024
BATCH = 32
SEQ = 2048
DEPTH = 1

HEAD_DIM = 64
ATT_Q_HEADS = 8
ATT_KV_HEADS = 2
ATT_GROUP = ATT_Q_HEADS // ATT_KV_HEADS
WINDOW = 128
ROPE_THETA = 10000.0
SGU_HEADS = 8
SGU_CHUNK = 128
ATT_WIDTH = ATT_Q_HEADS * HEAD_DIM
KV_WIDTH = ATT_KV_HEADS * HEAD_DIM
SGU_WIDTH = SGU_HEADS * HEAD_DIM
MIX_WIDTH = ATT_WIDTH + SGU_WIDTH
IN_COLS = ATT_WIDTH + 2 * KV_WIDTH + 2 * SGU_WIDTH
SPLITS = (ATT_WIDTH, ATT_WIDTH + KV_WIDTH, ATT_WIDTH + 2 * KV_WIDTH,
          ATT_WIDTH + 2 * KV_WIDTH + SGU_WIDTH)
PEER_HEADS = 8
PEER_N_KEYS = 128
PEER_N_EXPERTS = PEER_N_KEYS * PEER_N_KEYS
PEER_TOPK = 16
PEER_QDIM = 256
PEER_TOKEN_BLOCK = 128
EPS = 1e-6

kernel_name = "hybrid_sgu_swa_sink_peer_block"


def rms_norm(x, g):
    xf = x.astype(jnp.float32)
    y = xf * lax.rsqrt(jnp.mean(xf * xf, axis=-1, keepdims=True) + EPS)
    return (y * g.astype(jnp.float32)).astype(x.dtype)


def layer_norm(x, g, b):
    xf = x.astype(jnp.float32)
    mu = jnp.mean(xf, axis=-1, keepdims=True)
    var = jnp.mean(jnp.square(xf - mu), axis=-1, keepdims=True)
    y = (xf - mu) * lax.rsqrt(var + EPS) * g.astype(jnp.float32) + b.astype(jnp.float32)
    return y.astype(x.dtype)


def rope(x, pos):
    half = HEAD_DIM // 2
    inv = ROPE_THETA ** (-jnp.arange(half, dtype=jnp.float32) / half)
    ang = pos.astype(jnp.float32)[:, None] * inv[None, :]
    cos = jnp.cos(ang)[None, :, None, :]
    sin = jnp.sin(ang)[None, :, None, :]
    xf = x.astype(jnp.float32)
    x1, x2 = xf[..., :half], xf[..., half:]
    out = jnp.concatenate([x1 * cos - x2 * sin, x2 * cos + x1 * sin], axis=-1)
    return out.astype(x.dtype)


def sliding_window_attention(q, k, v, sinks):
    B, S = q.shape[0], q.shape[1]
    nb = S // WINDOW
    qb = q.reshape(B, nb, WINDOW, ATT_KV_HEADS, ATT_GROUP, HEAD_DIM)
    kb = k.reshape(B, nb, WINDOW, ATT_KV_HEADS, HEAD_DIM)
    vb = v.reshape(B, nb, WINDOW, ATT_KV_HEADS, HEAD_DIM)
    pad = ((0, 0), (1, 0), (0, 0), (0, 0), (0, 0))
    kcat = jnp.concatenate([jnp.pad(kb[:, :-1], pad), kb], axis=2)
    vcat = jnp.concatenate([jnp.pad(vb[:, :-1], pad), vb], axis=2)
    s = jnp.einsum('bnqhgd,bnkhd->bnhgqk', qb, kcat,
                   preferred_element_type=jnp.float32) * (HEAD_DIM ** -0.5)
    blk = jnp.arange(nb)[:, None, None] * WINDOW
    qpos = blk + jnp.arange(WINDOW)[None, :, None]
    kpos = blk - WINDOW + jnp.arange(2 * WINDOW)[None, None, :]
    diff = qpos - kpos
    valid = (diff >= 0) & (diff < WINDOW) & (kpos >= 0)
    s = jnp.where(valid[None, :, None, None, :, :], s, -jnp.inf)
    sink = sinks.astype(jnp.float32).reshape(ATT_KV_HEADS, ATT_GROUP)[None, None, :, :, None, None]
    m = jnp.maximum(jnp.max(s, axis=-1, keepdims=True), sink)
    p = jnp.exp(s - m)
    p = p / (jnp.sum(p, axis=-1, keepdims=True) + jnp.exp(sink - m))
    o = jnp.einsum('bnhgqk,bnkhd->bnqhgd', p.astype(v.dtype), vcat)
    return o.reshape(B, S, ATT_WIDTH).astype(q.dtype)


def chunked_spatial_gating(u, v, w_s, b_s, ln_g, ln_b):
    B, S = u.shape[0], u.shape[1]
    nc = S // SGU_CHUNK
    vn = layer_norm(v, ln_g, ln_b)
    vc = vn.reshape(B, nc, SGU_CHUNK, SGU_HEADS, HEAD_DIM)
    causal = jnp.tril(jnp.ones((SGU_CHUNK, SGU_CHUNK), dtype=bool))
    w = jnp.where(causal[None], w_s, 0).astype(v.dtype)
    mixed = jnp.einsum('hts,bcshd->bcthd', w, vc) + b_s.T.astype(v.dtype)[None, None, :, :, None]
    return (u * mixed.reshape(u.shape)).reshape(B, S, SGU_WIDTH)


def hybrid_mixer(h, w_in, w_s, b_s, sgu_ln_g, sgu_ln_b, sinks, g_att_out, g_sgu_out, w_out):
    B, S, _ = h.shape
    proj = h @ w_in
    q, k, v, u_s, v_s = jnp.split(proj, SPLITS, axis=-1)
    pos = jnp.arange(S)
    q = rope(q.reshape(B, S, ATT_Q_HEADS, HEAD_DIM), pos)
    k = rope(k.reshape(B, S, ATT_KV_HEADS, HEAD_DIM), pos)
    v = v.reshape(B, S, ATT_KV_HEADS, HEAD_DIM)
    att = sliding_window_attention(q, k, v, sinks)
    u_s = jax.nn.gelu(u_s, approximate=False).reshape(B, S, SGU_HEADS, HEAD_DIM)
    v_s = jax.nn.gelu(v_s, approximate=False).reshape(B, S, SGU_HEADS, HEAD_DIM)
    sgu = chunked_spatial_gating(u_s, v_s, w_s, b_s, sgu_ln_g, sgu_ln_b)
    y = jnp.concatenate([rms_norm(att, g_att_out), rms_norm(sgu, g_sgu_out)], axis=-1)
    return y @ w_out


def peer_ffn(h, w_query, sub_keys, expert_down, expert_up):
    B, S, D = h.shape
    T = B * S
    ht = h.reshape(T, D)
    q = (ht @ w_query).reshape(T, PEER_HEADS, 2, PEER_QDIM // 2)
    sc = jnp.einsum('thpd,hpnd->thpn', q, sub_keys, preferred_element_type=jnp.float32)
    sub_s, sub_i = lax.top_k(sc, PEER_TOPK)
    cand_s = sub_s[:, :, 0, :, None] + sub_s[:, :, 1, None, :]
    cand_i = sub_i[:, :, 0, :, None] * PEER_N_KEYS + sub_i[:, :, 1, None, :]
    top_s, top_j = lax.top_k(cand_s.reshape(T, PEER_HEADS, PEER_TOPK * PEER_TOPK), PEER_TOPK)
    experts = jnp.take_along_axis(cand_i.reshape(T, PEER_HEADS, PEER_TOPK * PEER_TOPK), top_j, axis=-1)
    gates = jax.nn.softmax(top_s, axis=-1)
    nblk = T // PEER_TOKEN_BLOCK
    HK = PEER_HEADS * PEER_TOPK

    def block(args):
        xb, eb, gb = args
        u = jnp.take(expert_down, eb, axis=0)
        a = jax.nn.gelu(jnp.einsum('tkd,td->tk', u, xb), approximate=False)
        w = jnp.take(expert_up, eb, axis=0)
        return jnp.einsum('tk,tkd->td', gb * a, w)

    out = lax.map(block, (ht.reshape(nblk, PEER_TOKEN_BLOCK, D),
                          experts.reshape(nblk, PEER_TOKEN_BLOCK, HK),
                          gates.reshape(nblk, PEER_TOKEN_BLOCK, HK).astype(h.dtype)))
    return out.reshape(B, S, D)


def setup_inputs(seed: int = 0) -> dict:
    key = jax.random.key(seed)
    ks = jax.random.split(key, 24)
    f32 = jnp.float32
    L, D = DEPTH, D_MODEL
    nrm = lambda k, shape, s: jax.random.normal(k, shape, f32) * s
    gain = lambda k, shape: 1.0 + 0.05 * jax.random.normal(k, shape, f32)
    return {
        "x": jax.random.normal(ks[0], (BATCH, SEQ, D), f32),
        "c": jax.random.normal(ks[1], (BATCH, D), f32),
        "w_ada": nrm(ks[2], (L, D, 6 * D), 0.5 * D ** -0.5),
        "b_ada": nrm(ks[3], (L, 6 * D), 0.02),
        "g_pre_mix": gain(ks[4], (L, D)),
        "g_post_mix": gain(ks[5], (L, D)),
        "g_pre_ffn": gain(ks[6], (L, D)),
        "g_post_ffn": gain(ks[7], (L, D)),
        "w_in": nrm(ks[8], (L, D, IN_COLS), D ** -0.5),
        "w_s": nrm(ks[9], (L, SGU_HEADS, SGU_CHUNK, SGU_CHUNK), SGU_CHUNK ** -0.5),
        "b_s": 1.0 + nrm(ks[10], (L, SGU_HEADS, SGU_CHUNK), 0.02),
        "sgu_ln_g": gain(ks[11], (L, SGU_HEADS, HEAD_DIM)),
        "sgu_ln_b": nrm(ks[12], (L, SGU_HEADS, HEAD_DIM), 0.02),
        "sinks": nrm(ks[13], (L, ATT_Q_HEADS), 0.5),
        "g_att_out": gain(ks[14], (L, ATT_WIDTH)),
        "g_sgu_out": gain(ks[15], (L, SGU_WIDTH)),
        "w_out": nrm(ks[16], (L, MIX_WIDTH, D), MIX_WIDTH ** -0.5),
        "w_query": nrm(ks[17], (L, D, PEER_HEADS * PEER_QDIM), D ** -0.5),
        "sub_keys": nrm(ks[18], (L, PEER_HEADS, 2, PEER_N_KEYS, PEER_QDIM // 2), (PEER_QDIM // 2) ** -0.5),
        "expert_down": nrm(ks[19], (L, PEER_N_EXPERTS, D), D ** -0.5),
        "expert_up": nrm(ks[20], (L, PEER_N_EXPERTS, D), PEER_HEADS ** -0.5),
    }


def reference(x, c, w_ada, b_ada, g_pre_mix, g_post_mix, g_pre_ffn, g_post_ffn,
              w_in, w_s, b_s, sgu_ln_g, sgu_ln_b, sinks, g_att_out, g_sgu_out, w_out,
              w_query, sub_keys, expert_down, expert_up):
    c_act = jax.nn.silu(c)
    for l in range(DEPTH):
        mod = c_act @ w_ada[l] + b_ada[l]
        sh1, sc1, gt1, sh2, sc2, gt2 = [m[:, None, :] for m in jnp.split(mod, 6, axis=-1)]
        h = rms_norm(x, g_pre_mix[l]) * (1.0 + sc1) + sh1
        y = hybrid_mixer(h, w_in[l], w_s[l], b_s[l], sgu_ln_g[l], sgu_ln_b[l], sinks[l],
                         g_att_out[l], g_sgu_out[l], w_out[l])
        x = x + gt1 * rms_norm(y, g_post_mix[l])
        h = rms_norm(x, g_pre_ffn[l]) * (1.0 + sc2) + sh2
        y = peer_ffn(h, w_query[l], sub_keys[l], expert_down[l], expert_up[l])
        x = x + gt2 * rms_norm(y, g_post_ffn[l])
    return x
```

```cpp
#include <hip/hip_runtime.h>
#include <hip/hip_cooperative_groups.h>
#include <stdint.h>
#include <stdio.h>
#include <limits.h>
namespace cg = cooperative_groups;

#ifndef MULTI_LAUNCH
#define MULTI_LAUNCH 1
#endif

#define DI __device__ __forceinline__
typedef unsigned short bf16_t;
typedef short bf16x8 __attribute__((ext_vector_type(8)));
typedef short s16x4 __attribute__((ext_vector_type(4)));
typedef float f32x16 __attribute__((ext_vector_type(16)));
typedef float f32x4 __attribute__((ext_vector_type(4)));
typedef unsigned u32x4 __attribute__((ext_vector_type(4)));
typedef unsigned u32x2 __attribute__((ext_vector_type(2)));

constexpr int DM = 1024, NB = 32, SEQ = 2048, T = NB * SEQ;
constexpr int HD = 64, QH = 8, KVH = 2, WIN = 128;
constexpr int INC = 1792;
constexpr int C_K = 512, C_V = 640, C_U = 768, C_VS = 1280;
constexpr int PH = 8, NKEYS = 128, TOPK = 16, NEXP = 16384;
constexpr float EPS = 1e-6f;
constexpr int NTHREADS = 512, NWAVES = 8;

constexpr size_t WS_MOD   = 0;
constexpr size_t WS_ROPE  = WS_MOD + (size_t)NB * 6144 * 4;
constexpr size_t WS_WIN   = WS_ROPE + (size_t)SEQ * 32 * 8;
constexpr size_t WS_WOUT  = WS_WIN + (size_t)INC * DM * 2;
constexpr size_t WS_WQF   = WS_WOUT + (size_t)DM * DM * 2;
constexpr size_t WS_WS    = WS_WQF + (size_t)2048 * DM * 2;
constexpr size_t WS_ED    = WS_WS + (size_t)8 * 128 * 128 * 2;
constexpr size_t WS_EU    = WS_ED + (size_t)NEXP * DM * 2;
constexpr size_t WS_H     = WS_EU + (size_t)NEXP * DM * 2;
constexpr size_t WS_IDS   = WS_H + (size_t)T * DM * 2;
constexpr size_t WS_GATES = WS_IDS + (size_t)T * 128 * 4;
constexpr size_t WS_BIG   = WS_GATES + (size_t)T * 128 * 4;
constexpr size_t WS_PROJ  = WS_BIG;
constexpr size_t WS_YIN   = WS_PROJ + (size_t)T * INC * 2;
constexpr size_t WS_Y     = WS_YIN + (size_t)T * DM * 2;
constexpr size_t WS_SCT   = WS_BIG;
constexpr size_t WS_END   = WS_BIG + (size_t)2048 * T * 4;

struct Params {
    const float* x; const float* c; const float* w_ada; const float* b_ada;
    const float* g_pre_mix; const float* g_post_mix; const float* g_pre_ffn; const float* g_post_ffn;
    const float* w_in; const float* w_s; const float* b_s; const float* sgu_ln_g; const float* sgu_ln_b;
    const float* sinks; const float* g_att_out; const float* g_sgu_out; const float* w_out;
    const float* w_query; const float* sub_keys; const float* expert_down; const float* expert_up;
    float* out; unsigned char* ws;
};

DI float bf2f(unsigned short u) { return __uint_as_float(((unsigned)u) << 16); }
DI float bflo(unsigned w) { return __uint_as_float(w << 16); }
DI float bfhi(unsigned w) { return __uint_as_float(w & 0xffff0000u); }
typedef __bf16 bf2_t __attribute__((ext_vector_type(2)));
typedef float f32x2 __attribute__((ext_vector_type(2)));
DI unsigned pk2(float lo, float hi) { const f32x2 v = {lo, hi}; return __builtin_bit_cast(unsigned, __builtin_convertvector(v, bf2_t)); }
DI unsigned short f2bf(float x) { return __builtin_bit_cast(unsigned short, (__bf16)x); }
DI float wave_sum(float v) {
#pragma unroll
    for (int o = 1; o < 64; o <<= 1) v += __shfl_xor(v, o);
    return v;
}
DI float gelu_exact(float v) { return 0.5f * v * (1.0f + erff(v * 0.70710678118654752f)); }
DI int crow(int i, int h) { return (i & 3) + 8 * (i >> 2) + 4 * h; }
#define MFMA32(a, b, c) __builtin_amdgcn_mfma_f32_32x32x16_bf16((a), (b), (c), 0, 0, 0)

DI void p0_mod_item(const Params& p, int item, unsigned char* smem) {
    float* sc = (float*)smem;
    const int tid = threadIdx.x, w = tid >> 6, lane = tid & 63;
    for (int idx = tid; idx < 32 * 1024; idx += NTHREADS) {
        const int k = idx >> 5, b = idx & 31;
        const float v = p.c[b * 1024 + k];
        sc[k * 32 + b] = v / (1.0f + expf(-v));
    }
    __syncthreads();
    const int col = item * 64 + lane;
    float acc[32];
#pragma unroll
    for (int b = 0; b < 32; ++b) acc[b] = 0.f;
    for (int kk = 0; kk < 128; ++kk) {
        const int k = w * 128 + kk;
        const float wv = p.w_ada[(size_t)k * 6144 + col];
        const f32x4* sp = (const f32x4*)(sc + k * 32);
#pragma unroll
        for (int b4 = 0; b4 < 8; ++b4) {
            const f32x4 s = sp[b4];
            acc[4 * b4 + 0] += s[0] * wv; acc[4 * b4 + 1] += s[1] * wv; acc[4 * b4 + 2] += s[2] * wv; acc[4 * b4 + 3] += s[3] * wv;
        }
    }
    __syncthreads();
    float* red = (float*)smem;
#pragma unroll
    for (int b = 0; b < 32; ++b) red[(w * 32 + b) * 64 + lane] = acc[b];
    __syncthreads();
    float* mod = (float*)(p.ws + WS_MOD);
    for (int idx = tid; idx < 32 * 64; idx += NTHREADS) {
        const int b = idx >> 6, l = idx & 63;
        float s = 0.f;
#pragma unroll
        for (int ww = 0; ww < 8; ++ww) s += red[(ww * 32 + b) * 64 + l];
        const int cc = item * 64 + l;
        mod[b * 6144 + cc] = s + p.b_ada[cc];
    }
    __syncthreads();
}

DI void p0_fold_item(const Params& p, int item, unsigned char* smem) {
    const int hp = item >> 5, nt = (item >> 4) & 1, jt = item & 15;
    const int n0 = nt * 64, j0 = jt * 64;
    float* sk = (float*)smem;
    float* wq = sk + 64 * 132;
    const int tid = threadIdx.x;
    for (int idx = tid; idx < 64 * 32; idx += NTHREADS) {
        const int r = idx >> 5, c4 = idx & 31;
        const f32x4 a = *(const f32x4*)(p.sub_keys + ((size_t)(hp * 128 + n0 + r) * 128 + c4 * 4));
        *(f32x4*)(sk + r * 132 + c4 * 4) = a;
        const f32x4 b = *(const f32x4*)(p.w_query + ((size_t)(j0 + r) * 2048 + hp * 128 + c4 * 4));
        *(f32x4*)(wq + r * 132 + c4 * 4) = b;
    }
    __syncthreads();
    const int tn = tid & 15, tj = tid >> 4;
    float acc[4][2];
#pragma unroll
    for (int a = 0; a < 4; ++a) { acc[a][0] = 0.f; acc[a][1] = 0.f; }
    for (int d = 0; d < 128; d += 4) {
        f32x4 av[4], bv[2];
#pragma unroll
        for (int a = 0; a < 4; ++a) av[a] = *(const f32x4*)(sk + (tn * 4 + a) * 132 + d);
#pragma unroll
        for (int b = 0; b < 2; ++b) bv[b] = *(const f32x4*)(wq + (tj * 2 + b) * 132 + d);
#pragma unroll
        for (int a = 0; a < 4; ++a)
#pragma unroll
            for (int b = 0; b < 2; ++b)
                acc[a][b] += av[a][0] * bv[b][0] + av[a][1] * bv[b][1] + av[a][2] * bv[b][2] + av[a][3] * bv[b][3];
    }
    bf16_t* wf = (bf16_t*)(p.ws + WS_WQF);
#pragma unroll
    for (int a = 0; a < 4; ++a) {
        const size_t row = (size_t)(hp * 128 + n0 + tn * 4 + a);
        *(unsigned*)(wf + row * 1024 + j0 + tj * 2) = pk2(acc[a][0], acc[a][1]);
    }
    __syncthreads();
}

DI void p0_transpose_item(const float* W, int K, int N, bf16_t* WT, int item, unsigned char* smem) {
    const int ntn = N / 64, kb = item / ntn, nb = item % ntn, k0 = kb * 64, n0 = nb * 64;
    float* tile = (float*)smem;
    const int tid = threadIdx.x;
    for (int idx = tid; idx < 64 * 64; idx += NTHREADS) {
        const int k = idx >> 6, n = idx & 63;
        tile[k * 65 + n] = W[(size_t)(k0 + k) * N + n0 + n];
    }
    __syncthreads();
    {
        const int n = tid >> 3, k8 = tid & 7;
        const float* s = tile + (k8 * 8) * 65 + n;
        u32x4 o;
        o[0] = pk2(s[0 * 65], s[1 * 65]); o[1] = pk2(s[2 * 65], s[3 * 65]); o[2] = pk2(s[4 * 65], s[5 * 65]); o[3] = pk2(s[6 * 65], s[7 * 65]);
        *(u32x4*)(WT + (size_t)(n0 + n) * K + k0 + k8 * 8) = o;
    }
    __syncthreads();
}

DI void phase0(const Params& p, unsigned char* smem) {
    const int bid = blockIdx.x, G = gridDim.x, tid = threadIdx.x;
    for (int it = bid; it < 96; it += G) p0_mod_item(p, it, smem);
    for (int it = G - 1 - bid; it < 512; it += G) p0_fold_item(p, it, smem);
    for (int it = bid; it < 16 * 28; it += G) p0_transpose_item(p.w_in, 1024, INC, (bf16_t*)(p.ws + WS_WIN), it, smem);
    for (int it = bid; it < 16 * 16; it += G) p0_transpose_item(p.w_out, 1024, 1024, (bf16_t*)(p.ws + WS_WOUT), it, smem);
    {
        const size_t n8 = (size_t)NEXP * DM / 8, gsz = (size_t)G * NTHREADS;
        u32x4* ed = (u32x4*)(p.ws + WS_ED); u32x4* eu = (u32x4*)(p.ws + WS_EU);
        for (size_t i = (size_t)bid * NTHREADS + tid; i < n8; i += gsz) {
            const f32x4 a0 = ((const f32x4*)p.expert_down)[2 * i], a1 = ((const f32x4*)p.expert_down)[2 * i + 1];
            const f32x4 b0 = ((const f32x4*)p.expert_up)[2 * i], b1 = ((const f32x4*)p.expert_up)[2 * i + 1];
            u32x4 o; o[0] = pk2(a0[0], a0[1]); o[1] = pk2(a0[2], a0[3]); o[2] = pk2(a1[0], a1[1]); o[3] = pk2(a1[2], a1[3]);
            ed[i] = o;
            u32x4 q; q[0] = pk2(b0[0], b0[1]); q[1] = pk2(b0[2], b0[3]); q[2] = pk2(b1[0], b1[1]); q[3] = pk2(b1[2], b1[3]);
            eu[i] = q;
        }
    }
    {
        const int gt = bid * NTHREADS + tid, gsz = G * NTHREADS;
        float* rope = (float*)(p.ws + WS_ROPE);
        for (int i = gt; i < SEQ * 32; i += gsz) {
            const int pos = i >> 5, f = i & 31;
            const float inv = (float)pow(10000.0, -(double)f / 32.0);
            const float ang = (float)pos * inv;
            rope[2 * i] = (float)cos((double)ang); rope[2 * i + 1] = (float)sin((double)ang);
        }
        bf16_t* wsb = (bf16_t*)(p.ws + WS_WS);
        for (int i = gt; i < 8 * 128 * 128; i += gsz) {
            const int t = (i >> 7) & 127, s = i & 127;
            wsb[i] = (s <= t) ? f2bf(p.w_s[i]) : (bf16_t)0;
        }
    }
}

DI void load_row16(const float* row, int lane, float (&v)[16]) {
    const f32x4 a0 = *(const f32x4*)(row + lane * 8), a1 = *(const f32x4*)(row + lane * 8 + 4);
    const f32x4 b0 = *(const f32x4*)(row + 512 + lane * 8), b1 = *(const f32x4*)(row + 512 + lane * 8 + 4);
#pragma unroll
    for (int i = 0; i < 4; ++i) { v[i] = a0[i]; v[4 + i] = a1[i]; v[8 + i] = b0[i]; v[12 + i] = b1[i]; }
}
DI void load_row16_bf(const bf16_t* row, int lane, float (&v)[16]) {
    const u32x4 a = *(const u32x4*)(row + lane * 8), b = *(const u32x4*)(row + 512 + lane * 8);
#pragma unroll
    for (int i = 0; i < 4; ++i) { v[2 * i] = bflo(a[i]); v[2 * i + 1] = bfhi(a[i]); v[8 + 2 * i] = bflo(b[i]); v[8 + 2 * i + 1] = bfhi(b[i]); }
}
DI void store_row16_bf(bf16_t* row, int lane, const float (&v)[16]) {
    u32x4 a, b;
#pragma unroll
    for (int i = 0; i < 4; ++i) { a[i] = pk2(v[2 * i], v[2 * i + 1]); b[i] = pk2(v[8 + 2 * i], v[8 + 2 * i + 1]); }
    *(u32x4*)(row + lane * 8) = a; *(u32x4*)(row + 512 + lane * 8) = b;
}
DI void store_row16(float* row, int lane, const float (&v)[16]) {
    f32x4 a0, a1, b0, b1;
#pragma unroll
    for (int i = 0; i < 4; ++i) { a0[i] = v[i]; a1[i] = v[4 + i]; b0[i] = v[8 + i]; b1[i] = v[12 + i]; }
    *(f32x4*)(row + lane * 8) = a0; *(f32x4*)(row + lane * 8 + 4) = a1; *(f32x4*)(row + 512 + lane * 8) = b0; *(f32x4*)(row + 512 + lane * 8 + 4) = b1;
}

DI void phase1(const Params& p) {
    const int lane = threadIdx.x & 63, gw = blockIdx.x * NWAVES + (threadIdx.x >> 6), NW = gridDim.x * NWAVES;
    const float* mod = (const float*)(p.ws + WS_MOD);
    bf16_t* h = (bf16_t*)(p.ws + WS_H);
    float g[16]; load_row16(p.g_pre_mix, lane, g);
    for (int t = gw; t < T; t += NW) {
        const int b = t >> 11;
        float v[16], sh[16], sc[16];
        load_row16(p.x + (size_t)t * DM, lane, v);
        load_row16(mod + b * 6144 + 0, lane, sh);
        load_row16(mod + b * 6144 + 1024, lane, sc);
        float ss = 0.f;
#pragma unroll
        for (int i = 0; i < 16; ++i) ss += v[i] * v[i];
        const float rstd = rsqrtf(wave_sum(ss) * (1.0f / DM) + EPS);
        float o[16];
#pragma unroll
        for (int i = 0; i < 16; ++i) o[i] = v[i] * rstd * g[i] * (1.0f + sc[i]) + sh[i];
        store_row16_bf(h + (size_t)t * DM, lane, o);
    }
}

DI void phase5(const Params& p) {
    const int lane = threadIdx.x & 63, gw = blockIdx.x * NWAVES + (threadIdx.x >> 6), NW = gridDim.x * NWAVES;
    const float* mod = (const float*)(p.ws + WS_MOD);
    const bf16_t* y = (const bf16_t*)(p.ws + WS_Y);
    bf16_t* h = (bf16_t*)(p.ws + WS_H);
    float g1[16], g2[16]; load_row16(p.g_post_mix, lane, g1); load_row16(p.g_pre_ffn, lane, g2);
    for (int t = gw; t < T; t += NW) {
        const int b = t >> 11;
        float xv[16], yv[16], gt[16], sh[16], sc[16];
        load_row16(p.x + (size_t)t * DM, lane, xv);
        load_row16_bf(y + (size_t)t * DM, lane, yv);
        load_row16(mod + b * 6144 + 2048, lane, gt);
        load_row16(mod + b * 6144 + 3072, lane, sh);
        load_row16(mod + b * 6144 + 4096, lane, sc);
        float ss = 0.f;
#pragma unroll
        for (int i = 0; i < 16; ++i) ss += yv[i] * yv[i];
        const float rstd = rsqrtf(wave_sum(ss) * (1.0f / DM) + EPS);
        float x1[16]; float s1 = 0.f;
#pragma unroll
        for (int i = 0; i < 16; ++i) { x1[i] = xv[i] + gt[i] * (yv[i] * rstd * g1[i]); s1 += x1[i] * x1[i]; }
        store_row16(p.out + (size_t)t * DM, lane, x1);
        const float rstd1 = rsqrtf(wave_sum(s1) * (1.0f / DM) + EPS);
        float o[16];
#pragma unroll
        for (int i = 0; i < 16; ++i) o[i] = x1[i] * rstd1 * g2[i] * (1.0f + sc[i]) + sh[i];
        store_row16_bf(h + (size_t)t * DM, lane, o);
    }
}

constexpr int G_BM = 256, G_BN = 128, G_BK = 64, G_LDS_ROW = 144;
constexpr int G_A_BYTES = G_BM * G_LDS_ROW, G_B_BYTES = G_BN * G_LDS_ROW, G_STAGE = G_A_BYTES + G_B_BYTES;
enum { EPI_PROJ = 0, EPI_BF16 = 1, EPI_F32 = 2 };

template <int EPI>
DI void gemm_epilogue(const Params& p, const f32x16 (&acc)[2][2], int m0, int n0, int N, void* Cv, int lane) {
    const int r = lane & 31, h = lane >> 5;
    if (EPI == EPI_F32) {
        float* C = (float*)Cv;
#pragma unroll
        for (int mi = 0; mi < 2; ++mi)
#pragma unroll
            for (int ni = 0; ni < 2; ++ni)
#pragma unroll
                for (int i = 0; i < 16; ++i) C[(size_t)(m0 + mi * 32 + crow(i, h)) * N + n0 + ni * 32 + r] = acc[mi][ni][i];
    } else if (EPI == EPI_BF16) {
        bf16_t* C = (bf16_t*)Cv;
#pragma unroll
        for (int mi = 0; mi < 2; ++mi)
#pragma unroll
            for (int ni = 0; ni < 2; ++ni)
#pragma unroll
                for (int i = 0; i < 16; ++i) C[(size_t)(m0 + mi * 32 + crow(i, h)) * N + n0 + ni * 32 + r] = f2bf(acc[mi][ni][i]);
    } else {
        bf16_t* C = (bf16_t*)Cv;
        const float* rope = (const float*)(p.ws + WS_ROPE);
        const bool is_rope = n0 < C_V, is_gelu = n0 >= C_U;
        const float qs = (n0 < C_K) ? 0.125f : 1.0f;
#pragma unroll
        for (int mi = 0; mi < 2; ++mi)
#pragma unroll
            for (int i = 0; i < 16; ++i) {
                const int row = m0 + mi * 32 + crow(i, h);
                float a = acc[mi][0][i], b = acc[mi][1][i];
                if (is_rope) {
                    const int pos = row & (SEQ - 1);
                    const float cs = rope[(pos * 32 + r) * 2], sn = rope[(pos * 32 + r) * 2 + 1];
                    const float ra = a * cs - b * sn, rb = b * cs + a * sn;
                    a = ra * qs; b = rb * qs;
                } else if (is_gelu) { a = gelu_exact(a); b = gelu_exact(b); }
                C[(size_t)row * N + n0 + r] = f2bf(a);
                C[(size_t)row * N + n0 + 32 + r] = f2bf(b);
            }
    }
}

template <int EPI, bool N_MAJOR>
DI void gemm_phase(const Params& p, const bf16_t* A, const bf16_t* Bt, int M, int N, int K, void* C, unsigned char* smem) {
    const int tid = threadIdx.x, w = tid >> 6, lane = tid & 63, r = lane & 31, h = lane >> 5;
    const int wm = w >> 1, wn = w & 1;
    const int nM = M / G_BM, nN = N / G_BN, total = nM * nN, G = gridDim.x;
    const int per = (total + G - 1) / G;
    int t_lo = blockIdx.x * per, t_hi = t_lo + per; if (t_hi > total) t_hi = total;
    const int nk = K / G_BK;
    for (int t = t_lo; t < t_hi; ++t) {
        int tm, tn;
        if (N_MAJOR) { tn = t / nM; tm = t % nM; } else { tm = t / nN; tn = t % nN; }
        const int bm0 = tm * G_BM, bn0 = tn * G_BN;
        f32x16 acc[2][2];
#pragma unroll
        for (int mi = 0; mi < 2; ++mi)
#pragma unroll
            for (int ni = 0; ni < 2; ++ni)
#pragma unroll
                for (int i = 0; i < 16; ++i) acc[mi][ni][i] = 0.f;
        u32x4 ra[4], rb[2];
#pragma unroll
        for (int i = 0; i < 4; ++i) { const int c = tid + i * NTHREADS; ra[i] = *(const u32x4*)(A + (size_t)(bm0 + (c >> 3)) * K + (c & 7) * 8); }
#pragma unroll
        for (int i = 0; i < 2; ++i) { const int c = tid + i * NTHREADS; rb[i] = *(const u32x4*)(Bt + (size_t)(bn0 + (c >> 3)) * K + (c & 7) * 8); }
#pragma unroll
        for (int i = 0; i < 4; ++i) { const int c = tid + i * NTHREADS; *(u32x4*)(smem + (c >> 3) * G_LDS_ROW + (c & 7) * 16) = ra[i]; }
#pragma unroll
        for (int i = 0; i < 2; ++i) { const int c = tid + i * NTHREADS; *(u32x4*)(smem + G_A_BYTES + (c >> 3) * G_LDS_ROW + (c & 7) * 16) = rb[i]; }
        __syncthreads();
        for (int kt = 0; kt < nk; ++kt) {
            const int cur = kt & 1;
            if (kt + 1 < nk) {
                const int k0 = (kt + 1) * G_BK;
#pragma unroll
                for (int i = 0; i < 4; ++i) { const int c = tid + i * NTHREADS; ra[i] = *(const u32x4*)(A + (size_t)(bm0 + (c >> 3)) * K + k0 + (c & 7) * 8); }
#pragma unroll
                for (int i = 0; i < 2; ++i) { const int c = tid + i * NTHREADS; rb[i] = *(const u32x4*)(Bt + (size_t)(bn0 + (c >> 3)) * K + k0 + (c & 7) * 8); }
            }
            const unsigned char* sa = smem + cur * G_STAGE + (wm * 64 + r) * G_LDS_ROW + h * 16;
            const unsigned char* sb = smem + cur * G_STAGE + G_A_BYTES + (wn * 64 + r) * G_LDS_ROW + h * 16;
#pragma unroll
            for (int ks = 0; ks < 4; ++ks) {
                bf16x8 af[2], bfr[2];
                af[0] = *(const bf16x8*)(sa + ks * 32); af[1] = *(const bf16x8*)(sa + 32 * G_LDS_ROW + ks * 32);
                bfr[0] = *(const bf16x8*)(sb + ks * 32); bfr[1] = *(const bf16x8*)(sb + 32 * G_LDS_ROW + ks * 32);
#pragma unroll
                for (int mi = 0; mi < 2; ++mi)
#pragma unroll
                    for (int ni = 0; ni < 2; ++ni) acc[mi][ni] = MFMA32(af[mi], bfr[ni], acc[mi][ni]);
            }
            if (kt + 1 < nk) {
                unsigned char* st = smem + (cur ^ 1) * G_STAGE;
#pragma unroll
                for (int i = 0; i < 4; ++i) { const int c = tid + i * NTHREADS; *(u32x4*)(st + (c >> 3) * G_LDS_ROW + (c & 7) * 16) = ra[i]; }
#pragma unroll
                for (int i = 0; i < 2; ++i) { const int c = tid + i * NTHREADS; *(u32x4*)(st + G_A_BYTES + (c >> 3) * G_LDS_ROW + (c & 7) * 16) = rb[i]; }
            }
            __syncthreads();
        }
        gemm_epilogue<EPI>(p, acc, bm0 + wm * 64, bn0 + wn * 64, N, C, lane);
    }
}

constexpr int A_KROW = 144;
constexpr int A_VROW = 520;
constexpr int A_KS = 0;
constexpr int A_VT = 2 * 256 * A_KROW;
constexpr int S_VROW = 272;
constexpr int A_RED = 140288;
constexpr int A_LDS = A_RED + 2 * 8 * 32 * 4;

DI void head_norm_store(const f32x16 (&o)[2], const float* gvec, bf16_t* yrow, float* red, int w, int lane) {
    const int r = lane & 31, h = lane >> 5;
    float ss = 0.f;
#pragma unroll
    for (int dt = 0; dt < 2; ++dt)
#pragma unroll
        for (int i = 0; i < 16; ++i) ss += o[dt][i] * o[dt][i];
    ss += __shfl_xor(ss, 32);
    if (lane < 32) red[w * 32 + r] = ss;
    __syncthreads();
    float tot = 0.f;
#pragma unroll
    for (int ww = 0; ww < 8; ++ww) tot += red[ww * 32 + r];
    const float rstd = rsqrtf(tot * (1.0f / 512.0f) + EPS);
#pragma unroll
    for (int dt = 0; dt < 2; ++dt)
#pragma unroll
        for (int g4 = 0; g4 < 4; ++g4) {
            const int d = dt * 32 + 8 * g4 + 4 * h;
            const f32x4 gv = *(const f32x4*)(gvec + d);
            u32x2 pk;
            pk[0] = pk2(o[dt][4 * g4 + 0] * rstd * gv[0], o[dt][4 * g4 + 1] * rstd * gv[1]);
            pk[1] = pk2(o[dt][4 * g4 + 2] * rstd * gv[2], o[dt][4 * g4 + 3] * rstd * gv[3]);
            *(u32x2*)(yrow + d) = pk;
        }
}

DI bf16x8 pack8(const f32x16& x, int s) {
    u32x4 q;
    q[0] = pk2(x[8 * s + 0], x[8 * s + 1]); q[1] = pk2(x[8 * s + 2], x[8 * s + 3]);
    q[2] = pk2(x[8 * s + 4], x[8 * s + 5]); q[3] = pk2(x[8 * s + 6], x[8 * s + 7]);
    return __builtin_bit_cast(bf16x8, q);
}

DI void phase3(const Params& p, unsigned char* smem) {
    const int tid = threadIdx.x, w = tid >> 6, lane = tid & 63, r = lane & 31, h = lane >> 5;
    const bf16_t* proj = (const bf16_t*)(p.ws + WS_PROJ);
    const bf16_t* wsb = (const bf16_t*)(p.ws + WS_WS);
    bf16_t* yin = (bf16_t*)(p.ws + WS_YIN);
    float* red = (float*)(smem + A_RED);
    for (int item = blockIdx.x; item < NB * 16; item += gridDim.x) {
        const int nblk = item & 15;
        const int tok0 = item * 128;
        for (int c = tid; c < 2 * 256 * 8; c += NTHREADS) {
            const int g = c >> 11, key = (c >> 3) & 255, kc = c & 7;
            u32x4 kv = {0u, 0u, 0u, 0u}, vv = {0u, 0u, 0u, 0u};
            if (nblk > 0 || key >= 128) {
                const size_t base = (size_t)(tok0 - 128 + key) * INC + g * 64 + kc * 8;
                kv = *(const u32x4*)(proj + base + C_K);
                vv = *(const u32x4*)(proj + base + C_V);
            }
            *(u32x4*)(smem + A_KS + (g * 256 + key) * A_KROW + kc * 16) = kv;
            bf16_t* vt = (bf16_t*)(smem + A_VT + (g * 64 + kc * 8) * A_VROW) + key;
#pragma unroll
            for (int i = 0; i < 4; ++i) {
                vt[(2 * i) * (A_VROW / 2)] = (bf16_t)(vv[i] & 0xffffu);
                vt[(2 * i + 1) * (A_VROW / 2)] = (bf16_t)(vv[i] >> 16);
            }
        }
        __syncthreads();
        {
            const int g = w >> 2;
            const float sink = p.sinks[w];
            const unsigned char* kbase = smem + A_KS + (g * 256) * A_KROW;
            const unsigned char* vbase = smem + A_VT + (g * 64) * A_VROW;
            for (int qt = 0; qt < 4; ++qt) {
                const int tq = tok0 + qt * 32 + r;
                bf16x8 bq[4];
#pragma unroll
                for (int s = 0; s < 4; ++s) bq[s] = *(const bf16x8*)(proj + (size_t)tq * INC + w * 64 + s * 16 + h * 8);
                f32x16 sacc[5];
#pragma unroll
                for (int kt = 0; kt < 5; ++kt) {
#pragma unroll
                    for (int i = 0; i < 16; ++i) sacc[kt][i] = 0.f;
                    const unsigned char* kp = kbase + (qt * 32 + kt * 32 + r) * A_KROW + h * 16;
#pragma unroll
                    for (int s = 0; s < 4; ++s) {
                        const bf16x8 ka = *(const bf16x8*)(kp + s * 32);
                        sacc[kt] = MFMA32(ka, bq[s], sacc[kt]);
                    }
                }
                float mx = -INFINITY;
#pragma unroll
                for (int kt = 0; kt < 5; ++kt)
#pragma unroll
                    for (int i = 0; i < 16; ++i) {
                        const int diff = kt * 32 + crow(i, h) - r;
                        bool valid = (diff >= 1) && (diff <= 128);
                        if (nblk == 0) valid = valid && (qt * 32 + kt * 32 + crow(i, h) >= 128);
                        const float sv = valid ? sacc[kt][i] : -INFINITY;
                        sacc[kt][i] = sv;
                        mx = fmaxf(mx, sv);
                    }
                mx = fmaxf(mx, __shfl_xor(mx, 32));
                mx = fmaxf(mx, sink);
                float lsum = 0.f;
#pragma unroll
                for (int kt = 0; kt < 5; ++kt)
#pragma unroll
                    for (int i = 0; i < 16; ++i) { const float e = __expf(sacc[kt][i] - mx); sacc[kt][i] = e; lsum += e; }
                lsum += __shfl_xor(lsum, 32);
                lsum += __expf(sink - mx);
                const float inv_l = 1.0f / lsum;
                f32x16 o[2];
#pragma unroll
                for (int dt = 0; dt < 2; ++dt)
#pragma unroll
                    for (int i = 0; i < 16; ++i) o[dt][i] = 0.f;
#pragma unroll
                for (int kt = 0; kt < 5; ++kt)
#pragma unroll
                    for (int s = 0; s < 2; ++s) {
                        const bf16x8 pb = pack8(sacc[kt], s);
                        const int key0 = qt * 32 + kt * 32 + 16 * s + 4 * h;
#pragma unroll
                        for (int dt = 0; dt < 2; ++dt) {
                            const unsigned char* vp = vbase + (dt * 32 + r) * A_VROW + key0 * 2;
                            const s16x4 lo = *(const s16x4*)(vp), hi = *(const s16x4*)(vp + 16);
                            const bf16x8 va = __builtin_shufflevector(lo, hi, 0, 1, 2, 3, 4, 5, 6, 7);
                            o[dt] = MFMA32(va, pb, o[dt]);
                        }
                    }
#pragma unroll
                for (int dt = 0; dt < 2; ++dt)
#pragma unroll
                    for (int i = 0; i < 16; ++i) o[dt][i] *= inv_l;
                head_norm_store(o, p.g_att_out + w * 64, yin + (size_t)tq * DM + w * 64, red + (qt & 1) * 256, w, lane);
            }
        }
        __syncthreads();
        for (int rr = tid; rr < 128 * 8; rr += NTHREADS) {
            const int s = rr >> 3, hs = rr & 7;
            const bf16_t* src = proj + (size_t)(tok0 + s) * INC + C_VS + hs * 64;
            float v[64];
#pragma unroll
            for (int c = 0; c < 8; ++c) {
                const u32x4 q = *(const u32x4*)(src + c * 8);
#pragma unroll
                for (int i = 0; i < 4; ++i) { v[c * 8 + 2 * i] = bflo(q[i]); v[c * 8 + 2 * i + 1] = bfhi(q[i]); }
            }
            float mu = 0.f;
#pragma unroll
            for (int i = 0; i < 64; ++i) mu += v[i];
            mu *= (1.0f / 64.0f);
            float var = 0.f;
#pragma unroll
            for (int i = 0; i < 64; ++i) { const float d = v[i] - mu; var += d * d; }
            const float rstd = rsqrtf(var * (1.0f / 64.0f) + EPS);
            bf16_t* dst = (bf16_t*)(smem + (hs * 64) * S_VROW) + s;
#pragma unroll
            for (int i = 0; i < 64; ++i) {
                const float yv = (v[i] - mu) * rstd * p.sgu_ln_g[hs * 64 + i] + p.sgu_ln_b[hs * 64 + i];
                dst[i * (S_VROW / 2)] = f2bf(yv);
            }
        }
        __syncthreads();
        {
            const unsigned char* vb = smem + (w * 64) * S_VROW;
            for (int tt = 0; tt < 4; ++tt) {
                const int tl = tt * 32 + r;
                f32x16 o[2];
#pragma unroll
                for (int dt = 0; dt < 2; ++dt)
#pragma unroll
                    for (int i = 0; i < 16; ++i) o[dt][i] = 0.f;
                const bf16_t* wrow = wsb + (size_t)(w * 128 + tl) * 128 + h * 8;
                const int nks = 2 * (tt + 1);
                for (int ks = 0; ks < nks; ++ks) {
                    const bf16x8 wb = *(const bf16x8*)(wrow + ks * 16);
#pragma unroll
                    for (int dt = 0; dt < 2; ++dt) {
                        const bf16x8 va = *(const bf16x8*)(vb + (dt * 32 + r) * S_VROW + (ks * 16 + h * 8) * 2);
                        o[dt] = MFMA32(va, wb, o[dt]);
                    }
                }
                const float bias = p.b_s[w * 128 + tl];
                const bf16_t* urow = proj + (size_t)(tok0 + tl) * INC + C_U + w * 64;
#pragma unroll
                for (int dt = 0; dt < 2; ++dt)
#pragma unroll
                    for (int g4 = 0; g4 < 4; ++g4) {
                        const u32x2 uu = *(const u32x2*)(urow + dt * 32 + 8 * g4 + 4 * h);
                        o[dt][4 * g4 + 0] = (o[dt][4 * g4 + 0] + bias) * bflo(uu[0]);
                        o[dt][4 * g4 + 1] = (o[dt][4 * g4 + 1] + bias) * bfhi(uu[0]);
                        o[dt][4 * g4 + 2] = (o[dt][4 * g4 + 2] + bias) * bflo(uu[1]);
                        o[dt][4 * g4 + 3] = (o[dt][4 * g4 + 3] + bias) * bfhi(uu[1]);
                    }
                head_norm_store(o, p.g_sgu_out + w * 64, yin + (size_t)(tok0 + tl) * DM + 512 + w * 64, red + (tt & 1) * 256, w, lane);
            }
        }
        __syncthreads();
    }
}

DI int f2key(float f) { const int b = __float_as_int(f); return b ^ ((b >> 31) & 0x7fffffff); }
DI float key2f(int k) { return __int_as_float(k ^ ((k >> 31) & 0x7fffffff)); }

DI void phase7(const Params& p) {
    const float* scT = (const float*)(p.ws + WS_SCT);
    int* ids = (int*)(p.ws + WS_IDS);
    float* gates = (float*)(p.ws + WS_GATES);
    const int gsz = gridDim.x * NTHREADS;
    for (int idx = blockIdx.x * NTHREADS + threadIdx.x; idx < T * PH; idx += gsz) {
        const int tok = idx & (T - 1), hd = idx >> 16;
        int a0[16], a1[16];
#pragma unroll
        for (int i = 0; i < 16; ++i) { a0[i] = INT_MIN; a1[i] = INT_MIN; }
        const float* s0 = scT + (size_t)(hd * 256) * T + tok;
        const float* s1 = s0 + (size_t)128 * T;
#pragma unroll 8
        for (int n = 0; n < 128; ++n) {
            int v0 = (f2key(s0[(size_t)n * T]) & ~127) | (127 - n);
            int v1 = (f2key(s1[(size_t)n * T]) & ~127) | (127 - n);
#pragma unroll
            for (int i = 0; i < 16; ++i) {
                const int m0 = max(a0[i], v0); v0 = min(a0[i], v0); a0[i] = m0;
                const int m1 = max(a1[i], v1); v1 = min(a1[i], v1); a1[i] = m1;
            }
        }
        float ts[16]; int tp[16];
#pragma unroll
        for (int i = 0; i < 16; ++i) { ts[i] = -INFINITY; tp[i] = 0; }
#pragma unroll
        for (int i = 0; i < 16; ++i) {
            const float vi = key2f(a0[i] & ~127);
            const int ni = 127 - (a0[i] & 127);
#pragma unroll
            for (int j = 0; j < 16; ++j) {
                if ((i + 1) * (j + 1) <= 16) {
                    float v = vi + key2f(a1[j] & ~127);
                    int pl = ni * 128 + (127 - (a1[j] & 127));
#pragma unroll
                    for (int k = 0; k < 16; ++k) {
                        const bool gt = v > ts[k];
                        const float nv = gt ? ts[k] : v; const int np = gt ? tp[k] : pl;
                        ts[k] = gt ? v : ts[k]; tp[k] = gt ? pl : tp[k];
                        v = nv; pl = np;
                    }
                }
            }
        }
        float e[16], sum = 0.f;
#pragma unroll
        for (int k = 0; k < 16; ++k) { e[k] = __expf(ts[k] - ts[0]); sum += e[k]; }
        const float inv = 1.0f / sum;
        int* ip = ids + (size_t)tok * 128 + hd * 16;
        float* gp = gates + (size_t)tok * 128 + hd * 16;
#pragma unroll
        for (int k4 = 0; k4 < 4; ++k4) {
            int4 iv = make_int4(tp[4 * k4], tp[4 * k4 + 1], tp[4 * k4 + 2], tp[4 * k4 + 3]);
            *(int4*)(ip + 4 * k4) = iv;
            f32x4 gv = {e[4 * k4] * inv, e[4 * k4 + 1] * inv, e[4 * k4 + 2] * inv, e[4 * k4 + 3] * inv};
            *(f32x4*)(gp + 4 * k4) = gv;
        }
    }
}

DI void phase8(const Params& p, unsigned char* smem) {
    const int tid = threadIdx.x, w = tid >> 6, lane = tid & 63;
    const int gw = blockIdx.x * NWAVES + w, NW = gridDim.x * NWAVES;
    const bf16_t* hb = (const bf16_t*)(p.ws + WS_H);
    const bf16_t* ed = (const bf16_t*)(p.ws + WS_ED);
    const bf16_t* eu = (const bf16_t*)(p.ws + WS_EU);
    const int* ids = (const int*)(p.ws + WS_IDS);
    const float* gates = (const float*)(p.ws + WS_GATES);
    const float* mod = (const float*)(p.ws + WS_MOD);
    int* s_ids = (int*)(smem + w * 1024);
    float* s_cf = (float*)(smem + w * 1024 + 512);
    float gpost[16]; load_row16(p.g_post_ffn, lane, gpost);
    for (int t = gw; t < T; t += NW) {
        const int b = t >> 11;
        float hv[16]; load_row16_bf(hb + (size_t)t * DM, lane, hv);
        s_ids[lane] = ids[(size_t)t * 128 + lane];
        s_ids[lane + 64] = ids[(size_t)t * 128 + 64 + lane];
        __builtin_amdgcn_s_waitcnt(0);
        for (int g8 = 0; g8 < 16; ++g8) {
            float part[8];
#pragma unroll
            for (int j = 0; j < 8; ++j) {
                const int e = s_ids[g8 * 8 + j];
                const bf16_t* row = ed + (size_t)e * DM;
                const u32x4 a = *(const u32x4*)(row + lane * 8), c = *(const u32x4*)(row + 512 + lane * 8);
                float s = 0.f;
#pragma unroll
                for (int i = 0; i < 4; ++i) {
                    s += bflo(a[i]) * hv[2 * i] + bfhi(a[i]) * hv[2 * i + 1];
                    s += bflo(c[i]) * hv[8 + 2 * i] + bfhi(c[i]) * hv[8 + 2 * i + 1];
                }
                part[j] = s;
            }
            float q4[4];
#pragma unroll
            for (int i = 0; i < 4; ++i) {
                const bool up = (lane & 32) != 0;
                const float send = up ? part[i] : part[i + 4];
                const float keep = up ? part[i + 4] : part[i];
                q4[i] = keep + __shfl_xor(send, 32);
            }
            float q2[2];
#pragma unroll
            for (int i = 0; i < 2; ++i) {
                const bool up = (lane & 16) != 0;
                const float send = up ? q4[i] : q4[i + 2];
                const float keep = up ? q4[i + 2] : q4[i];
                q2[i] = keep + __shfl_xor(send, 16);
            }
            float s1;
            {
                const bool up = (lane & 8) != 0;
                const float send = up ? q2[0] : q2[1];
                const float keep = up ? q2[1] : q2[0];
                s1 = keep + __shfl_xor(send, 8);
            }
            s1 += __shfl_xor(s1, 4); s1 += __shfl_xor(s1, 2); s1 += __shfl_xor(s1, 1);
            const int k = g8 * 8 + (lane >> 3);
            const float cf = gates[(size_t)t * 128 + k] * gelu_exact(s1);
            if ((lane & 7) == 0) s_cf[k] = cf;
        }
        __builtin_amdgcn_s_waitcnt(0);
        float acc[16];
#pragma unroll
        for (int i = 0; i < 16; ++i) acc[i] = 0.f;
        for (int g8 = 0; g8 < 16; ++g8) {
#pragma unroll
            for (int j = 0; j < 8; ++j) {
                const int e = s_ids[g8 * 8 + j];
                const float cf = s_cf[g8 * 8 + j];
                const bf16_t* row = eu + (size_t)e * DM;
                const u32x4 a = *(const u32x4*)(row + lane * 8), c = *(const u32x4*)(row + 512 + lane * 8);
#pragma unroll
                for (int i = 0; i < 4; ++i) {
                    acc[2 * i] += cf * bflo(a[i]); acc[2 * i + 1] += cf * bfhi(a[i]);
                    acc[8 + 2 * i] += cf * bflo(c[i]); acc[8 + 2 * i + 1] += cf * bfhi(c[i]);
                }
            }
        }
        float ss = 0.f;
#pragma unroll
        for (int i = 0; i < 16; ++i) ss += acc[i] * acc[i];
        const float rstd = rsqrtf(wave_sum(ss) * (1.0f / DM) + EPS);
        float x1[16], gt[16];
        load_row16(p.out + (size_t)t * DM, lane, x1);
        load_row16(mod + b * 6144 + 5120, lane, gt);
        float o[16];
#pragma unroll
        for (int i = 0; i < 16; ++i) o[i] = x1[i] + gt[i] * (acc[i] * rstd * gpost[i]);
        store_row16(p.out + (size_t)t * DM, lane, o);
    }
}

constexpr int LDS_BYTES = 147456;

template <int PHS>
DI void run_phase(const Params& p, unsigned char* smem) {
    if (PHS == 0) phase0(p, smem);
    else if (PHS == 1) phase1(p);
    else if (PHS == 2) gemm_phase<EPI_PROJ, false>(p, (const bf16_t*)(p.ws + WS_H), (const bf16_t*)(p.ws + WS_WIN), T, INC, DM, p.ws + WS_PROJ, smem);
    else if (PHS == 3) phase3(p, smem);
    else if (PHS == 4) gemm_phase<EPI_BF16, false>(p, (const bf16_t*)(p.ws + WS_YIN), (const bf16_t*)(p.ws + WS_WOUT), T, DM, DM, p.ws + WS_Y, smem);
    else if (PHS == 5) phase5(p);
    else if (PHS == 6) gemm_phase<EPI_F32, true>(p, (const bf16_t*)(p.ws + WS_WQF), (const bf16_t*)(p.ws + WS_H), 2048, T, DM, p.ws + WS_SCT, smem);
    else if (PHS == 7) phase7(p);
    else if (PHS == 8) phase8(p, smem);
}

template <int PHS>
__global__ void __launch_bounds__(NTHREADS) k_phase(Params p) {
    __shared__ __attribute__((aligned(16))) unsigned char smem[LDS_BYTES];
    run_phase<PHS>(p, smem);
}

__global__ void __launch_bounds__(NTHREADS) k_mega(Params p) {
    __shared__ __attribute__((aligned(16))) unsigned char smem[LDS_BYTES];
    cg::grid_group grid = cg::this_grid();
    run_phase<0>(p, smem); grid.sync();
    run_phase<1>(p, smem); grid.sync();
    run_phase<2>(p, smem); grid.sync();
    run_phase<3>(p, smem); grid.sync();
    run_phase<4>(p, smem); grid.sync();
    run_phase<5>(p, smem); grid.sync();
    run_phase<6>(p, smem); grid.sync();
    run_phase<7>(p, smem); grid.sync();
    run_phase<8>(p, smem);
}

template <int PHS>
static void launch_phase(const Params& p, int grid, hipStream_t stream) {
    hipLaunchKernelGGL(k_phase<PHS>, dim3(grid), dim3(NTHREADS), 0, stream, p);
}

extern "C" void kernel_launch(void* const* d_in, const int* in_sizes, int n_in, void* d_out, int out_size, void* d_ws, size_t ws_size, hipStream_t stream) {
    if (n_in != 21 || out_size != T * DM || ws_size < WS_END) {
        fprintf(stderr, "kernel_launch: unexpected shapes (n_in %d out %d ws %zu need %zu)\n", n_in, out_size, ws_size, (size_t)WS_END);
        return;
    }
    Params p{};
    const float** f = (const float**)&p;
    for (int i = 0; i < 21; ++i) f[i] = (const float*)d_in[i];
    p.out = (float*)d_out; p.ws = (unsigned char*)d_ws;
#if MULTI_LAUNCH
    const int grid = 256;
    launch_phase<0>(p, grid, stream); launch_phase<1>(p, grid, stream); launch_phase<2>(p, grid, stream);
    launch_phase<3>(p, grid, stream); launch_phase<4>(p, grid, stream); launch_phase<5>(p, grid, stream);
    launch_phase<6>(p, grid, stream); launch_phase<7>(p, grid, stream); launch_phase<8>(p, grid, stream);
#else
    static int grid = 0;
    if (!grid) {
        int dev = 0, cus = 0, per_cu = 0;
        (void)hipGetDevice(&dev);
        (void)hipDeviceGetAttribute(&cus, hipDeviceAttributeMultiprocessorCount, dev);
        (void)hipOccupancyMaxActiveBlocksPerMultiprocessor(&per_cu, (const void*)k_mega, NTHREADS, 0);
        if (per_cu < 1) { fprintf(stderr, "kernel_launch: occupancy query says %d blocks per CU\n", per_cu); per_cu = 1; }
        grid = cus;
    }
    void* args[] = {&p};
    hipError_t e = hipLaunchCooperativeKernel((const void*)k_mega, dim3(grid), dim3(NTHREADS), args, 0, stream);
    if (e != hipSuccess) fprintf(stderr, "cooperative launch failed: %s (grid %d)\n", hipGetErrorString(e), grid);
#endif
}
```

```cpp
#include <hip/hip_runtime.h>
#include <hip/hip_cooperative_groups.h>
#include <stdint.h>
#include <stdio.h>
#include <limits.h>
namespace cg = cooperative_groups;

#ifndef MULTI_LAUNCH
#define MULTI_LAUNCH 0
#endif

#define DI __device__ __forceinline__
typedef unsigned short bf16_t;
typedef short bf16x8 __attribute__((ext_vector_type(8)));
typedef short s16x4 __attribute__((ext_vector_type(4)));
typedef float f32x16 __attribute__((ext_vector_type(16)));
typedef float f32x4 __attribute__((ext_vector_type(4)));
typedef unsigned u32x4 __attribute__((ext_vector_type(4)));
typedef unsigned u32x2 __attribute__((ext_vector_type(2)));

constexpr int DM = 1024, NB = 32, SEQ = 2048, T = NB * SEQ;
constexpr int HD = 64, QH = 8, KVH = 2, WIN = 128;
constexpr int INC = 1792;
constexpr int C_K = 512, C_V = 640, C_U = 768, C_VS = 1280;
constexpr int PH = 8, NKEYS = 128, TOPK = 16, NEXP = 16384;
constexpr float EPS = 1e-6f;
constexpr int NTHREADS = 512, NWAVES = 8;

constexpr size_t WS_MOD   = 0;
constexpr size_t WS_ROPE  = WS_MOD + (size_t)NB * 6144 * 4;
constexpr size_t WS_WIN   = WS_ROPE + (size_t)SEQ * 32 * 8;
constexpr size_t WS_WOUT  = WS_WIN + (size_t)INC * DM * 2;
constexpr size_t WS_WQF   = WS_WOUT + (size_t)DM * DM * 2;
constexpr size_t WS_WS    = WS_WQF + (size_t)2048 * DM * 2;
constexpr size_t WS_ED    = WS_WS + (size_t)8 * 128 * 128 * 2;
constexpr size_t WS_EU    = WS_ED + (size_t)NEXP * DM * 2;
constexpr size_t WS_H     = WS_EU + (size_t)NEXP * DM * 2;
constexpr size_t WS_IDS   = WS_H + (size_t)T * DM * 2;
constexpr size_t WS_GATES = WS_IDS + (size_t)T * 128 * 4;
constexpr size_t WS_BIG   = WS_GATES + (size_t)T * 128 * 4;
constexpr size_t WS_PROJ  = WS_BIG;
constexpr size_t WS_YIN   = WS_PROJ + (size_t)T * INC * 2;
constexpr size_t WS_Y     = WS_YIN + (size_t)T * DM * 2;
constexpr size_t WS_SCT   = WS_BIG;
constexpr size_t WS_END   = WS_BIG + (size_t)2048 * T * 4;

struct Params {
    const float* x; const float* c; const float* w_ada; const float* b_ada;
    const float* g_pre_mix; const float* g_post_mix; const float* g_pre_ffn; const float* g_post_ffn;
    const float* w_in; const float* w_s; const float* b_s; const float* sgu_ln_g; const float* sgu_ln_b;
    const float* sinks; const float* g_att_out; const float* g_sgu_out; const float* w_out;
    const float* w_query; const float* sub_keys; const float* expert_down; const float* expert_up;
    float* out; unsigned char* ws;
};

DI float bf2f(unsigned short u) { return __uint_as_float(((unsigned)u) << 16); }
DI float bflo(unsigned w) { return __uint_as_float(w << 16); }
DI float bfhi(unsigned w) { return __uint_as_float(w & 0xffff0000u); }
typedef __bf16 bf2_t __attribute__((ext_vector_type(2)));
typedef float f32x2 __attribute__((ext_vector_type(2)));
DI unsigned pk2(float lo, float hi) { const f32x2 v = {lo, hi}; return __builtin_bit_cast(unsigned, __builtin_convertvector(v, bf2_t)); }
DI unsigned short f2bf(float x) { return __builtin_bit_cast(unsigned short, (__bf16)x); }
DI float wave_sum(float v) {
#pragma unroll
    for (int o = 1; o < 64; o <<= 1) v += __shfl_xor(v, o);
    return v;
}
DI float gelu_exact(float v) { return 0.5f * v * (1.0f + erff(v * 0.70710678118654752f)); }
DI int crow(int i, int h) { return (i & 3) + 8 * (i >> 2) + 4 * h; }
#define MFMA32(a, b, c) __builtin_amdgcn_mfma_f32_32x32x16_bf16((a), (b), (c), 0, 0, 0)

DI void p0_mod_item(const Params& p, int item, unsigned char* smem) {
    float* sc = (float*)smem;
    const int tid = threadIdx.x, w = tid >> 6, lane = tid & 63;
    for (int idx = tid; idx < 32 * 1024; idx += NTHREADS) {
        const int k = idx >> 5, b = idx & 31;
        const float v = p.c[b * 1024 + k];
        sc[k * 32 + b] = v / (1.0f + expf(-v));
    }
    __syncthreads();
    const int col = item * 64 + lane;
    float acc[32];
#pragma unroll
    for (int b = 0; b < 32; ++b) acc[b] = 0.f;
    for (int kk = 0; kk < 128; ++kk) {
        const int k = w * 128 + kk;
        const float wv = p.w_ada[(size_t)k * 6144 + col];
        const f32x4* sp = (const f32x4*)(sc + k * 32);
#pragma unroll
        for (int b4 = 0; b4 < 8; ++b4) {
            const f32x4 s = sp[b4];
            acc[4 * b4 + 0] += s[0] * wv; acc[4 * b4 + 1] += s[1] * wv; acc[4 * b4 + 2] += s[2] * wv; acc[4 * b4 + 3] += s[3] * wv;
        }
    }
    __syncthreads();
    float* red = (float*)smem;
#pragma unroll
    for (int b = 0; b < 32; ++b) red[(w * 32 + b) * 64 + lane] = acc[b];
    __syncthreads();
    float* mod = (float*)(p.ws + WS_MOD);
    for (int idx = tid; idx < 32 * 64; idx += NTHREADS) {
        const int b = idx >> 6, l = idx & 63;
        float s = 0.f;
#pragma unroll
        for (int ww = 0; ww < 8; ++ww) s += red[(ww * 32 + b) * 64 + l];
        const int cc = item * 64 + l;
        mod[b * 6144 + cc] = s + p.b_ada[cc];
    }
    __syncthreads();
}

DI void p0_fold_item(const Params& p, int item, unsigned char* smem) {
    const int hp = item >> 5, nt = (item >> 4) & 1, jt = item & 15;
    const int n0 = nt * 64, j0 = jt * 64;
    float* sk = (float*)smem;
    float* wq = sk + 64 * 132;
    const int tid = threadIdx.x;
    for (int idx = tid; idx < 64 * 32; idx += NTHREADS) {
        const int r = idx >> 5, c4 = idx & 31;
        const f32x4 a = *(const f32x4*)(p.sub_keys + ((size_t)(hp * 128 + n0 + r) * 128 + c4 * 4));
        *(f32x4*)(sk + r * 132 + c4 * 4) = a;
        const f32x4 b = *(const f32x4*)(p.w_query + ((size_t)(j0 + r) * 2048 + hp * 128 + c4 * 4));
        *(f32x4*)(wq + r * 132 + c4 * 4) = b;
    }
    __syncthreads();
    const int tn = tid & 15, tj = tid >> 4;
    float acc[4][2];
#pragma unroll
    for (int a = 0; a < 4; ++a) { acc[a][0] = 0.f; acc[a][1] = 0.f; }
    for (int d = 0; d < 128; d += 4) {
        f32x4 av[4], bv[2];
#pragma unroll
        for (int a = 0; a < 4; ++a) av[a] = *(const f32x4*)(sk + (tn * 4 + a) * 132 + d);
#pragma unroll
        for (int b = 0; b < 2; ++b) bv[b] = *(const f32x4*)(wq + (tj * 2 + b) * 132 + d);
#pragma unroll
        for (int a = 0; a < 4; ++a)
#pragma unroll
            for (int b = 0; b < 2; ++b)
                acc[a][b] += av[a][0] * bv[b][0] + av[a][1] * bv[b][1] + av[a][2] * bv[b][2] + av[a][3] * bv[b][3];
    }
    bf16_t* wf = (bf16_t*)(p.ws + WS_WQF);
#pragma unroll
    for (int a = 0; a < 4; ++a) {
        const size_t row = (size_t)(hp * 128 + n0 + tn * 4 + a);
        *(unsigned*)(wf + row * 1024 + j0 + tj * 2) = pk2(acc[a][0], acc[a][1]);
    }
    __syncthreads();
}

DI void p0_transpose_item(const float* W, int K, int N, bf16_t* WT, int item, unsigned char* smem) {
    const int ntn = N / 64, kb = item / ntn, nb = item % ntn, k0 = kb * 64, n0 = nb * 64;
    float* tile = (float*)smem;
    const int tid = threadIdx.x;
    for (int idx = tid; idx < 64 * 64; idx += NTHREADS) {
        const int k = idx >> 6, n = idx & 63;
        tile[k * 65 + n] = W[(size_t)(k0 + k) * N + n0 + n];
    }
    __syncthreads();
    {
        const int n = tid >> 3, k8 = tid & 7;
        const float* s = tile + (k8 * 8) * 65 + n;
        u32x4 o;
        o[0] = pk2(s[0 * 65], s[1 * 65]); o[1] = pk2(s[2 * 65], s[3 * 65]); o[2] = pk2(s[4 * 65], s[5 * 65]); o[3] = pk2(s[6 * 65], s[7 * 65]);
        *(u32x4*)(WT + (size_t)(n0 + n) * K + k0 + k8 * 8) = o;
    }
    __syncthreads();
}

DI void phase0(const Params& p, unsigned char* smem) {
    const int bid = blockIdx.x, G = gridDim.x, tid = threadIdx.x;
    for (int it = bid; it < 96; it += G) p0_mod_item(p, it, smem);
    for (int it = G - 1 - bid; it < 512; it += G) p0_fold_item(p, it, smem);
    for (int it = bid; it < 16 * 28; it += G) p0_transpose_item(p.w_in, 1024, INC, (bf16_t*)(p.ws + WS_WIN), it, smem);
    for (int it = bid; it < 16 * 16; it += G) p0_transpose_item(p.w_out, 1024, 1024, (bf16_t*)(p.ws + WS_WOUT), it, smem);
    {
        const size_t n8 = (size_t)NEXP * DM / 8, gsz = (size_t)G * NTHREADS;
        u32x4* ed = (u32x4*)(p.ws + WS_ED); u32x4* eu = (u32x4*)(p.ws + WS_EU);
        for (size_t i = (size_t)bid * NTHREADS + tid; i < n8; i += gsz) {
            const f32x4 a0 = ((const f32x4*)p.expert_down)[2 * i], a1 = ((const f32x4*)p.expert_down)[2 * i + 1];
            const f32x4 b0 = ((const f32x4*)p.expert_up)[2 * i], b1 = ((const f32x4*)p.expert_up)[2 * i + 1];
            u32x4 o; o[0] = pk2(a0[0], a0[1]); o[1] = pk2(a0[2], a0[3]); o[2] = pk2(a1[0], a1[1]); o[3] = pk2(a1[2], a1[3]);
            ed[i] = o;
            u32x4 q; q[0] = pk2(b0[0], b0[1]); q[1] = pk2(b0[2], b0[3]); q[2] = pk2(b1[0], b1[1]); q[3] = pk2(b1[2], b1[3]);
            eu[i] = q;
        }
    }
    {
        const int gt = bid * NTHREADS + tid, gsz = G * NTHREADS;
        float* rope = (float*)(p.ws + WS_ROPE);
        for (int i = gt; i < SEQ * 32; i += gsz) {
            const int pos = i >> 5, f = i & 31;
            const float inv = (float)pow(10000.0, -(double)f / 32.0);
            const float ang = (float)pos * inv;
            rope[2 * i] = (float)cos((double)ang); rope[2 * i + 1] = (float)sin((double)ang);
        }
        bf16_t* wsb = (bf16_t*)(p.ws + WS_WS);
        for (int i = gt; i < 8 * 128 * 128; i += gsz) {
            const int t = (i >> 7) & 127, s = i & 127;
            wsb[i] = (s <= t) ? f2bf(p.w_s[i]) : (bf16_t)0;
        }
    }
}

DI void load_row16(const float* row, int lane, float (&v)[16]) {
    const f32x4 a0 = *(const f32x4*)(row + lane * 8), a1 = *(const f32x4*)(row + lane * 8 + 4);
    const f32x4 b0 = *(const f32x4*)(row + 512 + lane * 8), b1 = *(const f32x4*)(row + 512 + lane * 8 + 4);
#pragma unroll
    for (int i = 0; i < 4; ++i) { v[i] = a0[i]; v[4 + i] = a1[i]; v[8 + i] = b0[i]; v[12 + i] = b1[i]; }
}
DI void load_row16_bf(const bf16_t* row, int lane, float (&v)[16]) {
    const u32x4 a = *(const u32x4*)(row + lane * 8), b = *(const u32x4*)(row + 512 + lane * 8);
#pragma unroll
    for (int i = 0; i < 4; ++i) { v[2 * i] = bflo(a[i]); v[2 * i + 1] = bfhi(a[i]); v[8 + 2 * i] = bflo(b[i]); v[8 + 2 * i + 1] = bfhi(b[i]); }
}
DI void store_row16_bf(bf16_t* row, int lane, const float (&v)[16]) {
    u32x4 a, b;
#pragma unroll
    for (int i = 0; i < 4; ++i) { a[i] = pk2(v[2 * i], v[2 * i + 1]); b[i] = pk2(v[8 + 2 * i], v[8 + 2 * i + 1]); }
    *(u32x4*)(row + lane * 8) = a; *(u32x4*)(row + 512 + lane * 8) = b;
}
DI void store_row16(float* row, int lane, const float (&v)[16]) {
    f32x4 a0, a1, b0, b1;
#pragma unroll
    for (int i = 0; i < 4; ++i) { a0[i] = v[i]; a1[i] = v[4 + i]; b0[i] = v[8 + i]; b1[i] = v[12 + i]; }
    *(f32x4*)(row + lane * 8) = a0; *(f32x4*)(row + lane * 8 + 4) = a1; *(f32x4*)(row + 512 + lane * 8) = b0; *(f32x4*)(row + 512 + lane * 8 + 4) = b1;
}

DI void phase1(const Params& p) {
    const int lane = threadIdx.x & 63, gw = blockIdx.x * NWAVES + (threadIdx.x >> 6), NW = gridDim.x * NWAVES;
    const float* mod = (const float*)(p.ws + WS_MOD);
    bf16_t* h = (bf16_t*)(p.ws + WS_H);
    float g[16]; load_row16(p.g_pre_mix, lane, g);
    for (int t = gw; t < T; t += NW) {
        const int b = t >> 11;
        float v[16], sh[16], sc[16];
        load_row16(p.x + (size_t)t * DM, lane, v);
        load_row16(mod + b * 6144 + 0, lane, sh);
        load_row16(mod + b * 6144 + 1024, lane, sc);
        float ss = 0.f;
#pragma unroll
        for (int i = 0; i < 16; ++i) ss += v[i] * v[i];
        const float rstd = rsqrtf(wave_sum(ss) * (1.0f / DM) + EPS);
        float o[16];
#pragma unroll
        for (int i = 0; i < 16; ++i) o[i] = v[i] * rstd * g[i] * (1.0f + sc[i]) + sh[i];
        store_row16_bf(h + (size_t)t * DM, lane, o);
    }
}

DI void phase5(const Params& p) {
    const int lane = threadIdx.x & 63, gw = blockIdx.x * NWAVES + (threadIdx.x >> 6), NW = gridDim.x * NWAVES;
    const float* mod = (const float*)(p.ws + WS_MOD);
    const bf16_t* y = (const bf16_t*)(p.ws + WS_Y);
    bf16_t* h = (bf16_t*)(p.ws + WS_H);
    float g1[16], g2[16]; load_row16(p.g_post_mix, lane, g1); load_row16(p.g_pre_ffn, lane, g2);
    for (int t = gw; t < T; t += NW) {
        const int b = t >> 11;
        float xv[16], yv[16], gt[16], sh[16], sc[16];
        load_row16(p.x + (size_t)t * DM, lane, xv);
        load_row16_bf(y + (size_t)t * DM, lane, yv);
        load_row16(mod + b * 6144 + 2048, lane, gt);
        load_row16(mod + b * 6144 + 3072, lane, sh);
        load_row16(mod + b * 6144 + 4096, lane, sc);
        float ss = 0.f;
#pragma unroll
        for (int i = 0; i < 16; ++i) ss += yv[i] * yv[i];
        const float rstd = rsqrtf(wave_sum(ss) * (1.0f / DM) + EPS);
        float x1[16]; float s1 = 0.f;
#pragma unroll
        for (int i = 0; i < 16; ++i) { x1[i] = xv[i] + gt[i] * (yv[i] * rstd * g1[i]); s1 += x1[i] * x1[i]; }
        store_row16(p.out + (size_t)t * DM, lane, x1);
        const float rstd1 = rsqrtf(wave_sum(s1) * (1.0f / DM) + EPS);
        float o[16];
#pragma unroll
        for (int i = 0; i < 16; ++i) o[i] = x1[i] * rstd1 * g2[i] * (1.0f + sc[i]) + sh[i];
        store_row16_bf(h + (size_t)t * DM, lane, o);
    }
}

constexpr int G_BM = 256, G_BN = 128, G_BK = 64, G_LDS_ROW = 144;
constexpr int G_A_BYTES = G_BM * G_LDS_ROW, G_B_BYTES = G_BN * G_LDS_ROW, G_STAGE = G_A_BYTES + G_B_BYTES;
enum { EPI_PROJ = 0, EPI_BF16 = 1, EPI_F32 = 2 };

template <int EPI>
DI void gemm_epilogue(const Params& p, const f32x16 (&acc)[2][2], int m0, int n0, int N, void* Cv, int lane) {
    const int r = lane & 31, h = lane >> 5;
    if (EPI == EPI_F32) {
        float* C = (float*)Cv;
#pragma unroll
        for (int mi = 0; mi < 2; ++mi)
#pragma unroll
            for (int ni = 0; ni < 2; ++ni)
#pragma unroll
                for (int i = 0; i < 16; ++i) C[(size_t)(m0 + mi * 32 + crow(i, h)) * N + n0 + ni * 32 + r] = acc[mi][ni][i];
    } else if (EPI == EPI_BF16) {
        bf16_t* C = (bf16_t*)Cv;
#pragma unroll
        for (int mi = 0; mi < 2; ++mi)
#pragma unroll
            for (int ni = 0; ni < 2; ++ni)
#pragma unroll
                for (int i = 0; i < 16; ++i) C[(size_t)(m0 + mi * 32 + crow(i, h)) * N + n0 + ni * 32 + r] = f2bf(acc[mi][ni][i]);
    } else {
        bf16_t* C = (bf16_t*)Cv;
        const float* rope = (const float*)(p.ws + WS_ROPE);
        const bool is_rope = n0 < C_V, is_gelu = n0 >= C_U;
        const float qs = (n0 < C_K) ? 0.125f : 1.0f;
#pragma unroll
        for (int mi = 0; mi < 2; ++mi)
#pragma unroll
            for (int i = 0; i < 16; ++i) {
                const int row = m0 + mi * 32 + crow(i, h);
                float a = acc[mi][0][i], b = acc[mi][1][i];
                if (is_rope) {
                    const int pos = row & (SEQ - 1);
                    const float cs = rope[(pos * 32 + r) * 2], sn = rope[(pos * 32 + r) * 2 + 1];
                    const float ra = a * cs - b * sn, rb = b * cs + a * sn;
                    a = ra * qs; b = rb * qs;
                } else if (is_gelu) { a = gelu_exact(a); b = gelu_exact(b); }
                C[(size_t)row * N + n0 + r] = f2bf(a);
                C[(size_t)row * N + n0 + 32 + r] = f2bf(b);
            }
    }
}

template <int EPI, bool N_MAJOR>
DI void gemm_phase(const Params& p, const bf16_t* A, const bf16_t* Bt, int M, int N, int K, void* C, unsigned char* smem) {
    const int tid = threadIdx.x, w = tid >> 6, lane = tid & 63, r = lane & 31, h = lane >> 5;
    const int wm = w >> 1, wn = w & 1;
    const int nM = M / G_BM, nN = N / G_BN, total = nM * nN, G = gridDim.x;
    const int per = (total + G - 1) / G;
    int t_lo = blockIdx.x * per, t_hi = t_lo + per; if (t_hi > total) t_hi = total;
    const int nk = K / G_BK;
    for (int t = t_lo; t < t_hi; ++t) {
        int tm, tn;
        if (N_MAJOR) { tn = t / nM; tm = t % nM; } else { tm = t / nN; tn = t % nN; }
        const int bm0 = tm * G_BM, bn0 = tn * G_BN;
        f32x16 acc[2][2];
#pragma unroll
        for (int mi = 0; mi < 2; ++mi)
#pragma unroll
            for (int ni = 0; ni < 2; ++ni)
#pragma unroll
                for (int i = 0; i < 16; ++i) acc[mi][ni][i] = 0.f;
        u32x4 ra[4], rb[2];
#pragma unroll
        for (int i = 0; i < 4; ++i) { const int c = tid + i * NTHREADS; ra[i] = *(const u32x4*)(A + (size_t)(bm0 + (c >> 3)) * K + (c & 7) * 8); }
#pragma unroll
        for (int i = 0; i < 2; ++i) { const int c = tid + i * NTHREADS; rb[i] = *(const u32x4*)(Bt + (size_t)(bn0 + (c >> 3)) * K + (c & 7) * 8); }
#pragma unroll
        for (int i = 0; i < 4; ++i) { const int c = tid + i * NTHREADS; *(u32x4*)(smem + (c >> 3) * G_LDS_ROW + (c & 7) * 16) = ra[i]; }
#pragma unroll
        for (int i = 0; i < 2; ++i) { const int c = tid + i * NTHREADS; *(u32x4*)(smem + G_A_BYTES + (c >> 3) * G_LDS_ROW + (c & 7) * 16) = rb[i]; }
        __syncthreads();
        for (int kt = 0; kt < nk; ++kt) {
            const int cur = kt & 1;
            if (kt + 1 < nk) {
                const int k0 = (kt + 1) * G_BK;
#pragma unroll
                for (int i = 0; i < 4; ++i) { const int c = tid + i * NTHREADS; ra[i] = *(const u32x4*)(A + (size_t)(bm0 + (c >> 3)) * K + k0 + (c & 7) * 8); }
#pragma unroll
                for (int i = 0; i < 2; ++i) { const int c = tid + i * NTHREADS; rb[i] = *(const u32x4*)(Bt + (size_t)(bn0 + (c >> 3)) * K + k0 + (c & 7) * 8); }
            }
            const unsigned char* sa = smem + cur * G_STAGE + (wm * 64 + r) * G_LDS_ROW + h * 16;
            const unsigned char* sb = smem + cur * G_STAGE + G_A_BYTES + (wn * 64 + r) * G_LDS_ROW + h * 16;
#pragma unroll
            for (int ks = 0; ks < 4; ++ks) {
                bf16x8 af[2], bfr[2];
                af[0] = *(const bf16x8*)(sa + ks * 32); af[1] = *(const bf16x8*)(sa + 32 * G_LDS_ROW + ks * 32);
                bfr[0] = *(const bf16x8*)(sb + ks * 32); bfr[1] = *(const bf16x8*)(sb + 32 * G_LDS_ROW + ks * 32);
#pragma unroll
                for (int mi = 0; mi < 2; ++mi)
#pragma unroll
                    for (int ni = 0; ni < 2; ++ni) acc[mi][ni] = MFMA32(af[mi], bfr[ni], acc[mi][ni]);
            }
            if (kt + 1 < nk) {
                unsigned char* st = smem + (cur ^ 1) * G_STAGE;
#pragma unroll
                for (int i = 0; i < 4; ++i) { const int c = tid + i * NTHREADS; *(u32x4*)(st + (c >> 3) * G_LDS_ROW + (c & 7) * 16) = ra[i]; }
#pragma unroll
                for (int i = 0; i < 2; ++i) { const int c = tid + i * NTHREADS; *(u32x4*)(st + G_A_BYTES + (c >> 3) * G_LDS_ROW + (c & 7) * 16) = rb[i]; }
            }
            __syncthreads();
        }
        gemm_epilogue<EPI>(p, acc, bm0 + wm * 64, bn0 + wn * 64, N, C, lane);
    }
}

constexpr int A_KROW = 144;
constexpr int A_VROW = 520;
constexpr int A_KS = 0;
constexpr int A_VT = 2 * 256 * A_KROW;
constexpr int S_VROW = 272;
constexpr int A_RED = 140288;
constexpr int A_LDS = A_RED + 2 * 8 * 32 * 4;

DI void head_norm_store(const f32x16 (&o)[2], const float* gvec, bf16_t* yrow, float* red, int w, int lane) {
    const int r = lane & 31, h = lane >> 5;
    float ss = 0.f;
#pragma unroll
    for (int dt = 0; dt < 2; ++dt)
#pragma unroll
        for (int i = 0; i < 16; ++i) ss += o[dt][i] * o[dt][i];
    ss += __shfl_xor(ss, 32);
    if (lane < 32) red[w * 32 + r] = ss;
    __syncthreads();
    float tot = 0.f;
#pragma unroll
    for (int ww = 0; ww < 8; ++ww) tot += red[ww * 32 + r];
    const float rstd = rsqrtf(tot * (1.0f / 512.0f) + EPS);
#pragma unroll
    for (int dt = 0; dt < 2; ++dt)
#pragma unroll
        for (int g4 = 0; g4 < 4; ++g4) {
            const int d = dt * 32 + 8 * g4 + 4 * h;
            const f32x4 gv = *(const f32x4*)(gvec + d);
            u32x2 pk;
            pk[0] = pk2(o[dt][4 * g4 + 0] * rstd * gv[0], o[dt][4 * g4 + 1] * rstd * gv[1]);
            pk[1] = pk2(o[dt][4 * g4 + 2] * rstd * gv[2], o[dt][4 * g4 + 3] * rstd * gv[3]);
            *(u32x2*)(yrow + d) = pk;
        }
}

DI bf16x8 pack8(const f32x16& x, int s) {
    u32x4 q;
    q[0] = pk2(x[8 * s + 0], x[8 * s + 1]); q[1] = pk2(x[8 * s + 2], x[8 * s + 3]);
    q[2] = pk2(x[8 * s + 4], x[8 * s + 5]); q[3] = pk2(x[8 * s + 6], x[8 * s + 7]);
    return __builtin_bit_cast(bf16x8, q);
}

DI void phase3(const Params& p, unsigned char* smem) {
    const int tid = threadIdx.x, w = tid >> 6, lane = tid & 63, r = lane & 31, h = lane >> 5;
    const bf16_t* proj = (const bf16_t*)(p.ws + WS_PROJ);
    const bf16_t* wsb = (const bf16_t*)(p.ws + WS_WS);
    bf16_t* yin = (bf16_t*)(p.ws + WS_YIN);
    float* red = (float*)(smem + A_RED);
    for (int item = blockIdx.x; item < NB * 16; item += gridDim.x) {
        const int nblk = item & 15;
        const int tok0 = item * 128;
        for (int c = tid; c < 2 * 256 * 8; c += NTHREADS) {
            const int g = c >> 11, key = (c >> 3) & 255, kc = c & 7;
            u32x4 kv = {0u, 0u, 0u, 0u}, vv = {0u, 0u, 0u, 0u};
            if (nblk > 0 || key >= 128) {
                const size_t base = (size_t)(tok0 - 128 + key) * INC + g * 64 + kc * 8;
                kv = *(const u32x4*)(proj + base + C_K);
                vv = *(const u32x4*)(proj + base + C_V);
            }
            *(u32x4*)(smem + A_KS + (g * 256 + key) * A_KROW + kc * 16) = kv;
            bf16_t* vt = (bf16_t*)(smem + A_VT + (g * 64 + kc * 8) * A_VROW) + key;
#pragma unroll
            for (int i = 0; i < 4; ++i) {
                vt[(2 * i) * (A_VROW / 2)] = (bf16_t)(vv[i] & 0xffffu);
                vt[(2 * i + 1) * (A_VROW / 2)] = (bf16_t)(vv[i] >> 16);
            }
        }
        __syncthreads();
        {
            const int g = w >> 2;
            const float sink = p.sinks[w];
            const unsigned char* kbase = smem + A_KS + (g * 256) * A_KROW;
            const unsigned char* vbase = smem + A_VT + (g * 64) * A_VROW;
            for (int qt = 0; qt < 4; ++qt) {
                const int tq = tok0 + qt * 32 + r;
                bf16x8 bq[4];
#pragma unroll
                for (int s = 0; s < 4; ++s) bq[s] = *(const bf16x8*)(proj + (size_t)tq * INC + w * 64 + s * 16 + h * 8);
                f32x16 sacc[5];
#pragma unroll
                for (int kt = 0; kt < 5; ++kt) {
#pragma unroll
                    for (int i = 0; i < 16; ++i) sacc[kt][i] = 0.f;
                    const unsigned char* kp = kbase + (qt * 32 + kt * 32 + r) * A_KROW + h * 16;
#pragma unroll
                    for (int s = 0; s < 4; ++s) {
                        const bf16x8 ka = *(const bf16x8*)(kp + s * 32);
                        sacc[kt] = MFMA32(ka, bq[s], sacc[kt]);
                    }
                }
                float mx = -INFINITY;
#pragma unroll
                for (int kt = 0; kt < 5; ++kt)
#pragma unroll
                    for (int i = 0; i < 16; ++i) {
                        const int diff = kt * 32 + crow(i, h) - r;
                        bool valid = (diff >= 1) && (diff <= 128);
                        if (nblk == 0) valid = valid && (qt * 32 + kt * 32 + crow(i, h) >= 128);
                        const float sv = valid ? sacc[kt][i] : -INFINITY;
                        sacc[kt][i] = sv;
                        mx = fmaxf(mx, sv);
                    }
                mx = fmaxf(mx, __shfl_xor(mx, 32));
                mx = fmaxf(mx, sink);
                float lsum = 0.f;
#pragma unroll
                for (int kt = 0; kt < 5; ++kt)
#pragma unroll
                    for (int i = 0; i < 16; ++i) { const float e = __expf(sacc[kt][i] - mx); sacc[kt][i] = e; lsum += e; }
                lsum += __shfl_xor(lsum, 32);
                lsum += __expf(sink - mx);
                const float inv_l = 1.0f / lsum;
                f32x16 o[2];
#pragma unroll
                for (int dt = 0; dt < 2; ++dt)
#pragma unroll
                    for (int i = 0; i < 16; ++i) o[dt][i] = 0.f;
#pragma unroll
                for (int kt = 0; kt < 5; ++kt)
#pragma unroll
                    for (int s = 0; s < 2; ++s) {
                        const bf16x8 pb = pack8(sacc[kt], s);
                        const int key0 = qt * 32 + kt * 32 + 16 * s + 4 * h;
#pragma unroll
                        for (int dt = 0; dt < 2; ++dt) {
                            const unsigned char* vp = vbase + (dt * 32 + r) * A_VROW + key0 * 2;
                            const s16x4 lo = *(const s16x4*)(vp), hi = *(const s16x4*)(vp + 16);
                            const bf16x8 va = __builtin_shufflevector(lo, hi, 0, 1, 2, 3, 4, 5, 6, 7);
                            o[dt] = MFMA32(va, pb, o[dt]);
                        }
                    }
#pragma unroll
                for (int dt = 0; dt < 2; ++dt)
#pragma unroll
                    for (int i = 0; i < 16; ++i) o[dt][i] *= inv_l;
                head_norm_store(o, p.g_att_out + w * 64, yin + (size_t)tq * DM + w * 64, red + (qt & 1) * 256, w, lane);
            }
        }
        __syncthreads();
        for (int rr = tid; rr < 128 * 8; rr += NTHREADS) {
            const int s = rr >> 3, hs = rr & 7;
            const bf16_t* src = proj + (size_t)(tok0 + s) * INC + C_VS + hs * 64;
            float v[64];
#pragma unroll
            for (int c = 0; c < 8; ++c) {
                const u32x4 q = *(const u32x4*)(src + c * 8);
#pragma unroll
                for (int i = 0; i < 4; ++i) { v[c * 8 + 2 * i] = bflo(q[i]); v[c * 8 + 2 * i + 1] = bfhi(q[i]); }
            }
            float mu = 0.f;
#pragma unroll
            for (int i = 0; i < 64; ++i) mu += v[i];
            mu *= (1.0f / 64.0f);
            float var = 0.f;
#pragma unroll
            for (int i = 0; i < 64; ++i) { const float d = v[i] - mu; var += d * d; }
            const float rstd = rsqrtf(var * (1.0f / 64.0f) + EPS);
            bf16_t* dst = (bf16_t*)(smem + (hs * 64) * S_VROW) + s;
#pragma unroll
            for (int i = 0; i < 64; ++i) {
                const float yv = (v[i] - mu) * rstd * p.sgu_ln_g[hs * 64 + i] + p.sgu_ln_b[hs * 64 + i];
                dst[i * (S_VROW / 2)] = f2bf(yv);
            }
        }
        __syncthreads();
        {
            const unsigned char* vb = smem + (w * 64) * S_VROW;
            for (int tt = 0; tt < 4; ++tt) {
                const int tl = tt * 32 + r;
                f32x16 o[2];
#pragma unroll
                for (int dt = 0; dt < 2; ++dt)
#pragma unroll
                    for (int i = 0; i < 16; ++i) o[dt][i] = 0.f;
                const bf16_t* wrow = wsb + (size_t)(w * 128 + tl) * 128 + h * 8;
                const int nks = 2 * (tt + 1);
                for (int ks = 0; ks < nks; ++ks) {
                    const bf16x8 wb = *(const bf16x8*)(wrow + ks * 16);
#pragma unroll
                    for (int dt = 0; dt < 2; ++dt) {
                        const bf16x8 va = *(const bf16x8*)(vb + (dt * 32 + r) * S_VROW + (ks * 16 + h * 8) * 2);
                        o[dt] = MFMA32(va, wb, o[dt]);
                    }
                }
                const float bias = p.b_s[w * 128 + tl];
                const bf16_t* urow = proj + (size_t)(tok0 + tl) * INC + C_U + w * 64;
#pragma unroll
                for (int dt = 0; dt < 2; ++dt)
#pragma unroll
                    for (int g4 = 0; g4 < 4; ++g4) {
                        const u32x2 uu = *(const u32x2*)(urow + dt * 32 + 8 * g4 + 4 * h);
                        o[dt][4 * g4 + 0] = (o[dt][4 * g4 + 0] + bias) * bflo(uu[0]);
                        o[dt][4 * g4 + 1] = (o[dt][4 * g4 + 1] + bias) * bfhi(uu[0]);
                        o[dt][4 * g4 + 2] = (o[dt][4 * g4 + 2] + bias) * bflo(uu[1]);
                        o[dt][4 * g4 + 3] = (o[dt][4 * g4 + 3] + bias) * bfhi(uu[1]);
                    }
                head_norm_store(o, p.g_sgu_out + w * 64, yin + (size_t)(tok0 + tl) * DM + 512 + w * 64, red + (tt & 1) * 256, w, lane);
            }
        }
        __syncthreads();
    }
}

DI int f2key(float f) { const int b = __float_as_int(f); return b ^ ((b >> 31) & 0x7fffffff); }
DI float key2f(int k) { return __int_as_float(k ^ ((k >> 31) & 0x7fffffff)); }

DI void phase7(const Params& p) {
    const float* scT = (const float*)(p.ws + WS_SCT);
    int* ids = (int*)(p.ws + WS_IDS);
    float* gates = (float*)(p.ws + WS_GATES);
    const int gsz = gridDim.x * NTHREADS;
    for (int idx = blockIdx.x * NTHREADS + threadIdx.x; idx < T * PH; idx += gsz) {
        const int tok = idx & (T - 1), hd = idx >> 16;
        int a0[16], a1[16];
#pragma unroll
        for (int i = 0; i < 16; ++i) { a0[i] = INT_MIN; a1[i] = INT_MIN; }
        const float* s0 = scT + (size_t)(hd * 256) * T + tok;
        const float* s1 = s0 + (size_t)128 * T;
#pragma unroll 8
        for (int n = 0; n < 128; ++n) {
            int v0 = (f2key(s0[(size_t)n * T]) & ~127) | (127 - n);
            int v1 = (f2key(s1[(size_t)n * T]) & ~127) | (127 - n);
#pragma unroll
            for (int i = 0; i < 16; ++i) {
                const int m0 = max(a0[i], v0); v0 = min(a0[i], v0); a0[i] = m0;
                const int m1 = max(a1[i], v1); v1 = min(a1[i], v1); a1[i] = m1;
            }
        }
        float ts[16]; int tp[16];
#pragma unroll
        for (int i = 0; i < 16; ++i) { ts[i] = -INFINITY; tp[i] = 0; }
#pragma unroll
        for (int i = 0; i < 16; ++i) {
            const float vi = key2f(a0[i] & ~127);
            const int ni = 127 - (a0[i] & 127);
#pragma unroll
            for (int j = 0; j < 16; ++j) {
                if ((i + 1) * (j + 1) <= 16) {
                    float v = vi + key2f(a1[j] & ~127);
                    int pl = ni * 128 + (127 - (a1[j] & 127));
#pragma unroll
                    for (int k = 0; k < 16; ++k) {
                        const bool gt = v > ts[k];
                        const float nv = gt ? ts[k] : v; const int np = gt ? tp[k] : pl;
                        ts[k] = gt ? v : ts[k]; tp[k] = gt ? pl : tp[k];
                        v = nv; pl = np;
                    }
                }
            }
        }
        float e[16], sum = 0.f;
#pragma unroll
        for (int k = 0; k < 16; ++k) { e[k] = __expf(ts[k] - ts[0]); sum += e[k]; }
        const float inv = 1.0f / sum;
        int* ip = ids + (size_t)tok * 128 + hd * 16;
        float* gp = gates + (size_t)tok * 128 + hd * 16;
#pragma unroll
        for (int k4 = 0; k4 < 4; ++k4) {
            int4 iv = make_int4(tp[4 * k4], tp[4 * k4 + 1], tp[4 * k4 + 2], tp[4 * k4 + 3]);
            *(int4*)(ip + 4 * k4) = iv;
            f32x4 gv = {e[4 * k4] * inv, e[4 * k4 + 1] * inv, e[4 * k4 + 2] * inv, e[4 * k4 + 3] * inv};
            *(f32x4*)(gp + 4 * k4) = gv;
        }
    }
}

DI void phase8(const Params& p, unsigned char* smem) {
    const int tid = threadIdx.x, w = tid >> 6, lane = tid & 63;
    const int gw = blockIdx.x * NWAVES + w, NW = gridDim.x * NWAVES;
    const bf16_t* hb = (const bf16_t*)(p.ws + WS_H);
    const bf16_t* ed = (const bf16_t*)(p.ws + WS_ED);
    const bf16_t* eu = (const bf16_t*)(p.ws + WS_EU);
    const int* ids = (const int*)(p.ws + WS_IDS);
    const float* gates = (const float*)(p.ws + WS_GATES);
    const float* mod = (const float*)(p.ws + WS_MOD);
    int* s_ids = (int*)(smem + w * 1024);
    float* s_cf = (float*)(smem + w * 1024 + 512);
    float gpost[16]; load_row16(p.g_post_ffn, lane, gpost);
    for (int t = gw; t < T; t += NW) {
        const int b = t >> 11;
        float hv[16]; load_row16_bf(hb + (size_t)t * DM, lane, hv);
        s_ids[lane] = ids[(size_t)t * 128 + lane];
        s_ids[lane + 64] = ids[(size_t)t * 128 + 64 + lane];
        __builtin_amdgcn_s_waitcnt(0);
        for (int g8 = 0; g8 < 16; ++g8) {
            float part[8];
#pragma unroll
            for (int j = 0; j < 8; ++j) {
                const int e = s_ids[g8 * 8 + j];
                const bf16_t* row = ed + (size_t)e * DM;
                const u32x4 a = *(const u32x4*)(row + lane * 8), c = *(const u32x4*)(row + 512 + lane * 8);
                float s = 0.f;
#pragma unroll
                for (int i = 0; i < 4; ++i) {
                    s += bflo(a[i]) * hv[2 * i] + bfhi(a[i]) * hv[2 * i + 1];
                    s += bflo(c[i]) * hv[8 + 2 * i] + bfhi(c[i]) * hv[8 + 2 * i + 1];
                }
                part[j] = s;
            }
            float q4[4];
#pragma unroll
            for (int i = 0; i < 4; ++i) {
                const bool up = (lane & 32) != 0;
                const float send = up ? part[i] : part[i + 4];
                const float keep = up ? part[i + 4] : part[i];
                q4[i] = keep + __shfl_xor(send, 32);
            }
            float q2[2];
#pragma unroll
            for (int i = 0; i < 2; ++i) {
                const bool up = (lane & 16) != 0;
                const float send = up ? q4[i] : q4[i + 2];
                const float keep = up ? q4[i + 2] : q4[i];
                q2[i] = keep + __shfl_xor(send, 16);
            }
            float s1;
            {
                const bool up = (lane & 8) != 0;
                const float send = up ? q2[0] : q2[1];
                const float keep = up ? q2[1] : q2[0];
                s1 = keep + __shfl_xor(send, 8);
            }
            s1 += __shfl_xor(s1, 4); s1 += __shfl_xor(s1, 2); s1 += __shfl_xor(s1, 1);
            const int k = g8 * 8 + (lane >> 3);
            const float cf = gates[(size_t)t * 128 + k] * gelu_exact(s1);
            if ((lane & 7) == 0) s_cf[k] = cf;
        }
        __builtin_amdgcn_s_waitcnt(0);
        float acc[16];
#pragma unroll
        for (int i = 0; i < 16; ++i) acc[i] = 0.f;
        for (int g8 = 0; g8 < 16; ++g8) {
#pragma unroll
            for (int j = 0; j < 8; ++j) {
                const int e = s_ids[g8 * 8 + j];
                const float cf = s_cf[g8 * 8 + j];
                const bf16_t* row = eu + (size_t)e * DM;
                const u32x4 a = *(const u32x4*)(row + lane * 8), c = *(const u32x4*)(row + 512 + lane * 8);
#pragma unroll
                for (int i = 0; i < 4; ++i) {
                    acc[2 * i] += cf * bflo(a[i]); acc[2 * i + 1] += cf * bfhi(a[i]);
                    acc[8 + 2 * i] += cf * bflo(c[i]); acc[8 + 2 * i + 1] += cf * bfhi(c[i]);
                }
            }
        }
        float ss = 0.f;
#pragma unroll
        for (int i = 0; i < 16; ++i) ss += acc[i] * acc[i];
        const float rstd = rsqrtf(wave_sum(ss) * (1.0f / DM) + EPS);
        float x1[16], gt[16];
        load_row16(p.out + (size_t)t * DM, lane, x1);
        load_row16(mod + b * 6144 + 5120, lane, gt);
        float o[16];
#pragma unroll
        for (int i = 0; i < 16; ++i) o[i] = x1[i] + gt[i] * (acc[i] * rstd * gpost[i]);
        store_row16(p.out + (size_t)t * DM, lane, o);
    }
}

constexpr int LDS_BYTES = 147456;

template <int PHS>
DI void run_phase(const Params& p, unsigned char* smem) {
    if (PHS == 0) phase0(p, smem);
    else if (PHS == 1) phase1(p);
    else if (PHS == 2) gemm_phase<EPI_PROJ, false>(p, (const bf16_t*)(p.ws + WS_H), (const bf16_t*)(p.ws + WS_WIN), T, INC, DM, p.ws + WS_PROJ, smem);
    else if (PHS == 3) phase3(p, smem);
    else if (PHS == 4) gemm_phase<EPI_BF16, false>(p, (const bf16_t*)(p.ws + WS_YIN), (const bf16_t*)(p.ws + WS_WOUT), T, DM, DM, p.ws + WS_Y, smem);
    else if (PHS == 5) phase5(p);
    else if (PHS == 6) gemm_phase<EPI_F32, true>(p, (const bf16_t*)(p.ws + WS_WQF), (const bf16_t*)(p.ws + WS_H), 2048, T, DM, p.ws + WS_SCT, smem);
    else if (PHS == 7) phase7(p);
    else if (PHS == 8) phase8(p, smem);
}

template <int PHS>
__global__ void __launch_bounds__(NTHREADS) k_phase(Params p) {
    __shared__ __attribute__((aligned(16))) unsigned char smem[LDS_BYTES];
    run_phase<PHS>(p, smem);
}

__global__ void __launch_bounds__(NTHREADS) k_mega(Params p) {
    __shared__ __attribute__((aligned(16))) unsigned char smem[LDS_BYTES];
    cg::grid_group grid = cg::this_grid();
    run_phase<0>(p, smem); grid.sync();
    run_phase<1>(p, smem); grid.sync();
    run_phase<2>(p, smem); grid.sync();
    run_phase<3>(p, smem); grid.sync();
    run_phase<4>(p, smem); grid.sync();
    run_phase<5>(p, smem); grid.sync();
    run_phase<6>(p, smem); grid.sync();
    run_phase<7>(p, smem); grid.sync();
    run_phase<8>(p, smem);
}

template <int PHS>
static void launch_phase(const Params& p, int grid, hipStream_t stream) {
    hipLaunchKernelGGL(k_phase<PHS>, dim3(grid), dim3(NTHREADS), 0, stream, p);
}

extern "C" void kernel_launch(void* const* d_in, const int* in_sizes, int n_in, void* d_out, int out_size, void* d_ws, size_t ws_size, hipStream_t stream) {
    if (n_in != 21 || out_size != T * DM || ws_size < WS_END) {
        fprintf(stderr, "kernel_launch: unexpected shapes (n_in %d out %d ws %zu need %zu)\n", n_in, out_size, ws_size, (size_t)WS_END);
        return;
    }
    Params p{};
    const float** f = (const float**)&p;
    for (int i = 0; i < 21; ++i) f[i] = (const float*)d_in[i];
    p.out = (float*)d_out; p.ws = (unsigned char*)d_ws;
#if MULTI_LAUNCH
    const int grid = 256;
    launch_phase<0>(p, grid, stream); launch_phase<1>(p, grid, stream); launch_phase<2>(p, grid, stream);
    launch_phase<3>(p, grid, stream); launch_phase<4>(p, grid, stream); launch_phase<5>(p, grid, stream);
    launch_phase<6>(p, grid, stream); launch_phase<7>(p, grid, stream); launch_phase<8>(p, grid, stream);
#else
    static int grid = 0;
    if (!grid) {
        int dev = 0, cus = 0, per_cu = 0;
        (void)hipGetDevice(&dev);
        (void)hipDeviceGetAttribute(&cus, hipDeviceAttributeMultiprocessorCount, dev);
        (void)hipOccupancyMaxActiveBlocksPerMultiprocessor(&per_cu, (const void*)k_mega, NTHREADS, 0);
        if (per_cu < 1) { fprintf(stderr, "kernel_launch: occupancy query says %d blocks per CU\n", per_cu); per_cu = 1; }
        grid = cus;
    }
    void* args[] = {&p};
    hipError_t e = hipLaunchCooperativeKernel((const void*)k_mega, dim3(grid), dim3(NTHREADS), args, 0, stream);
    if (e != hipSuccess) fprintf(stderr, "cooperative launch failed: %s (grid %d)\n", hipGetErrorString(e), grid);
#endif
}
```

```cpp
#include <hip/hip_runtime.h>
#include <hip/hip_cooperative_groups.h>
#include <stdint.h>
#include <stdio.h>
#include <limits.h>
namespace cg = cooperative_groups;

#ifndef MULTI_LAUNCH
#define MULTI_LAUNCH 0
#endif

#define DI __device__ __forceinline__
typedef unsigned short bf16_t;
typedef short bf16x8 __attribute__((ext_vector_type(8)));
typedef short s16x4 __attribute__((ext_vector_type(4)));
typedef float f32x16 __attribute__((ext_vector_type(16)));
typedef float f32x4 __attribute__((ext_vector_type(4)));
typedef unsigned u32x4 __attribute__((ext_vector_type(4)));
typedef unsigned u32x2 __attribute__((ext_vector_type(2)));

constexpr int DM = 1024, NB = 32, SEQ = 2048, T = NB * SEQ;
constexpr int HD = 64, QH = 8, KVH = 2, WIN = 128;
constexpr int INC = 1792;
constexpr int C_K = 512, C_V = 640, C_U = 768, C_VS = 1280;
constexpr int PH = 8, NKEYS = 128, TOPK = 16, NEXP = 16384;
constexpr float EPS = 1e-6f;
constexpr int NTHREADS = 512, NWAVES = 8;

constexpr size_t WS_MOD   = 0;
constexpr size_t WS_ROPE  = WS_MOD + (size_t)NB * 6144 * 4;
constexpr size_t WS_WIN   = WS_ROPE + (size_t)SEQ * 32 * 8;
constexpr size_t WS_WOUT  = WS_WIN + (size_t)INC * DM * 2;
constexpr size_t WS_WQF   = WS_WOUT + (size_t)DM * DM * 2;
constexpr size_t WS_WS    = WS_WQF + (size_t)2048 * DM * 2;
constexpr size_t WS_ED    = WS_WS + (size_t)8 * 128 * 128 * 2;
constexpr size_t WS_EU    = WS_ED + (size_t)NEXP * DM;
constexpr size_t WS_SCD   = WS_EU + (size_t)NEXP * DM;
constexpr size_t WS_SCU   = WS_SCD + (size_t)NEXP * 4;
constexpr size_t WS_H     = WS_SCU + (size_t)NEXP * 4;
constexpr size_t WS_IDS   = WS_H + (size_t)T * DM * 2;
constexpr size_t WS_GATES = WS_IDS + (size_t)T * 128 * 4;
constexpr size_t WS_BIG   = WS_GATES + (size_t)T * 128 * 4;
constexpr size_t WS_PROJ  = WS_BIG;
constexpr size_t WS_YIN   = WS_PROJ + (size_t)T * INC * 2;
constexpr size_t WS_Y     = WS_YIN + (size_t)T * DM * 2;
constexpr size_t WS_SCT   = WS_BIG;
constexpr size_t WS_END   = WS_BIG + (size_t)2048 * T * 4;

struct Params {
    const float* x; const float* c; const float* w_ada; const float* b_ada;
    const float* g_pre_mix; const float* g_post_mix; const float* g_pre_ffn; const float* g_post_ffn;
    const float* w_in; const float* w_s; const float* b_s; const float* sgu_ln_g; const float* sgu_ln_b;
    const float* sinks; const float* g_att_out; const float* g_sgu_out; const float* w_out;
    const float* w_query; const float* sub_keys; const float* expert_down; const float* expert_up;
    float* out; unsigned char* ws;
};

DI float bf2f(unsigned short u) { return __uint_as_float(((unsigned)u) << 16); }
DI float bflo(unsigned w) { return __uint_as_float(w << 16); }
DI float bfhi(unsigned w) { return __uint_as_float(w & 0xffff0000u); }
typedef __bf16 bf2_t __attribute__((ext_vector_type(2)));
typedef float f32x2 __attribute__((ext_vector_type(2)));
DI unsigned pk2(float lo, float hi) { const f32x2 v = {lo, hi}; return __builtin_bit_cast(unsigned, __builtin_convertvector(v, bf2_t)); }
DI unsigned short f2bf(float x) { return __builtin_bit_cast(unsigned short, (__bf16)x); }
DI float wave_sum(float v) {
#pragma unroll
    for (int o = 1; o < 64; o <<= 1) v += __shfl_xor(v, o);
    return v;
}
DI float gelu_exact(float v) { return 0.5f * v * (1.0f + erff(v * 0.70710678118654752f)); }
DI int crow(int i, int h) { return (i & 3) + 8 * (i >> 2) + 4 * h; }
#define MFMA32(a, b, c) __builtin_amdgcn_mfma_f32_32x32x16_bf16((a), (b), (c), 0, 0, 0)

DI void p0_mod_item(const Params& p, int item, unsigned char* smem) {
    float* sc = (float*)smem;
    const int tid = threadIdx.x, w = tid >> 6, lane = tid & 63;
    for (int idx = tid; idx < 32 * 1024; idx += NTHREADS) {
        const int k = idx >> 5, b = idx & 31;
        const float v = p.c[b * 1024 + k];
        sc[k * 32 + b] = v / (1.0f + expf(-v));
    }
    __syncthreads();
    const int col = item * 64 + lane;
    float acc[32];
#pragma unroll
    for (int b = 0; b < 32; ++b) acc[b] = 0.f;
    for (int kk = 0; kk < 128; ++kk) {
        const int k = w * 128 + kk;
        const float wv = p.w_ada[(size_t)k * 6144 + col];
        const f32x4* sp = (const f32x4*)(sc + k * 32);
#pragma unroll
        for (int b4 = 0; b4 < 8; ++b4) {
            const f32x4 s = sp[b4];
            acc[4 * b4 + 0] += s[0] * wv; acc[4 * b4 + 1] += s[1] * wv; acc[4 * b4 + 2] += s[2] * wv; acc[4 * b4 + 3] += s[3] * wv;
        }
    }
    __syncthreads();
    float* red = (float*)smem;
#pragma unroll
    for (int b = 0; b < 32; ++b) red[(w * 32 + b) * 64 + lane] = acc[b];
    __syncthreads();
    float* mod = (float*)(p.ws + WS_MOD);
    for (int idx = tid; idx < 32 * 64; idx += NTHREADS) {
        const int b = idx >> 6, l = idx & 63;
        float s = 0.f;
#pragma unroll
        for (int ww = 0; ww < 8; ++ww) s += red[(ww * 32 + b) * 64 + l];
        const int cc = item * 64 + l;
        mod[b * 6144 + cc] = s + p.b_ada[cc];
    }
    __syncthreads();
}

DI void p0_fold_item(const Params& p, int item, unsigned char* smem) {
    const int hp = item >> 5, nt = (item >> 4) & 1, jt = item & 15;
    const int n0 = nt * 64, j0 = jt * 64;
    float* sk = (float*)smem;
    float* wq = sk + 64 * 132;
    const int tid = threadIdx.x;
    for (int idx = tid; idx < 64 * 32; idx += NTHREADS) {
        const int r = idx >> 5, c4 = idx & 31;
        const f32x4 a = *(const f32x4*)(p.sub_keys + ((size_t)(hp * 128 + n0 + r) * 128 + c4 * 4));
        *(f32x4*)(sk + r * 132 + c4 * 4) = a;
        const f32x4 b = *(const f32x4*)(p.w_query + ((size_t)(j0 + r) * 2048 + hp * 128 + c4 * 4));
        *(f32x4*)(wq + r * 132 + c4 * 4) = b;
    }
    __syncthreads();
    const int tn = tid & 15, tj = tid >> 4;
    float acc[4][2];
#pragma unroll
    for (int a = 0; a < 4; ++a) { acc[a][0] = 0.f; acc[a][1] = 0.f; }
    for (int d = 0; d < 128; d += 4) {
        f32x4 av[4], bv[2];
#pragma unroll
        for (int a = 0; a < 4; ++a) av[a] = *(const f32x4*)(sk + (tn * 4 + a) * 132 + d);
#pragma unroll
        for (int b = 0; b < 2; ++b) bv[b] = *(const f32x4*)(wq + (tj * 2 + b) * 132 + d);
#pragma unroll
        for (int a = 0; a < 4; ++a)
#pragma unroll
            for (int b = 0; b < 2; ++b)
                acc[a][b] += av[a][0] * bv[b][0] + av[a][1] * bv[b][1] + av[a][2] * bv[b][2] + av[a][3] * bv[b][3];
    }
    bf16_t* wf = (bf16_t*)(p.ws + WS_WQF);
#pragma unroll
    for (int a = 0; a < 4; ++a) {
        const size_t row = (size_t)(hp * 128 + n0 + tn * 4 + a);
        *(unsigned*)(wf + row * 1024 + j0 + tj * 2) = pk2(acc[a][0], acc[a][1]);
    }
    __syncthreads();
}

DI void p0_transpose_item(const float* W, int K, int N, bf16_t* WT, int item, unsigned char* smem) {
    const int ntn = N / 64, kb = item / ntn, nb = item % ntn, k0 = kb * 64, n0 = nb * 64;
    float* tile = (float*)smem;
    const int tid = threadIdx.x;
    for (int idx = tid; idx < 64 * 64; idx += NTHREADS) {
        const int k = idx >> 6, n = idx & 63;
        tile[k * 65 + n] = W[(size_t)(k0 + k) * N + n0 + n];
    }
    __syncthreads();
    {
        const int n = tid >> 3, k8 = tid & 7;
        const float* s = tile + (k8 * 8) * 65 + n;
        u32x4 o;
        o[0] = pk2(s[0 * 65], s[1 * 65]); o[1] = pk2(s[2 * 65], s[3 * 65]); o[2] = pk2(s[4 * 65], s[5 * 65]); o[3] = pk2(s[6 * 65], s[7 * 65]);
        *(u32x4*)(WT + (size_t)(n0 + n) * K + k0 + k8 * 8) = o;
    }
    __syncthreads();
}

DI void phase0(const Params& p, unsigned char* smem) {
    const int bid = blockIdx.x, G = gridDim.x, tid = threadIdx.x;
    for (int it = bid; it < 96; it += G) p0_mod_item(p, it, smem);
    for (int it = G - 1 - bid; it < 512; it += G) p0_fold_item(p, it, smem);
    for (int it = bid; it < 16 * 28; it += G) p0_transpose_item(p.w_in, 1024, INC, (bf16_t*)(p.ws + WS_WIN), it, smem);
    for (int it = bid; it < 16 * 16; it += G) p0_transpose_item(p.w_out, 1024, 1024, (bf16_t*)(p.ws + WS_WOUT), it, smem);
    {
        const int lane = tid & 63, gw = bid * NWAVES + (tid >> 6), NW = G * NWAVES;
        for (int rr = gw; rr < 2 * NEXP; rr += NW) {
            const int tb = rr >= NEXP, e = rr - tb * NEXP;
            const float* row = (tb ? p.expert_up : p.expert_down) + (size_t)e * DM;
            unsigned char* dst = p.ws + (tb ? WS_EU : WS_ED) + (size_t)e * DM;
            float* scl = (float*)(p.ws + (tb ? WS_SCU : WS_SCD));
            f32x4 v[4]; float am = 0.f;
#pragma unroll
            for (int j = 0; j < 4; ++j) { v[j] = *(const f32x4*)(row + 256 * j + 4 * lane);
#pragma unroll
                for (int i = 0; i < 4; ++i) am = fmaxf(am, fabsf(v[j][i])); }
#pragma unroll
            for (int o = 1; o < 64; o <<= 1) am = fmaxf(am, __shfl_xor(am, o));
            const float sc = am > 0.f ? am * (1.0f / 240.0f) : 1.0f, inv = 1.0f / sc;
            u32x4 o4;
#pragma unroll
            for (int j = 0; j < 4; ++j) {
                int wv = 0;
                wv = __builtin_amdgcn_cvt_pk_fp8_f32(v[j][0] * inv, v[j][1] * inv, wv, false);
                wv = __builtin_amdgcn_cvt_pk_fp8_f32(v[j][2] * inv, v[j][3] * inv, wv, true);
                o4[j] = (unsigned)wv;
            }
            *(u32x4*)(dst + 16 * lane) = o4;
            if (lane == 0) scl[e] = sc;
        }
    }
    {
        const int gt = bid * NTHREADS + tid, gsz = G * NTHREADS;
        float* rope = (float*)(p.ws + WS_ROPE);
        for (int i = gt; i < SEQ * 32; i += gsz) {
            const int pos = i >> 5, f = i & 31;
            const float inv = (float)pow(10000.0, -(double)f / 32.0);
            const float ang = (float)pos * inv;
            rope[2 * i] = (float)cos((double)ang); rope[2 * i + 1] = (float)sin((double)ang);
        }
        bf16_t* wsb = (bf16_t*)(p.ws + WS_WS);
        for (int i = gt; i < 8 * 128 * 128; i += gsz) {
            const int t = (i >> 7) & 127, s = i & 127;
            wsb[i] = (s <= t) ? f2bf(p.w_s[i]) : (bf16_t)0;
        }
    }
}

DI void load_row16(const float* row, int lane, float (&v)[16]) {
    const f32x4 a0 = *(const f32x4*)(row + lane * 8), a1 = *(const f32x4*)(row + lane * 8 + 4);
    const f32x4 b0 = *(const f32x4*)(row + 512 + lane * 8), b1 = *(const f32x4*)(row + 512 + lane * 8 + 4);
#pragma unroll
    for (int i = 0; i < 4; ++i) { v[i] = a0[i]; v[4 + i] = a1[i]; v[8 + i] = b0[i]; v[12 + i] = b1[i]; }
}
DI void load_row16_bf(const bf16_t* row, int lane, float (&v)[16]) {
    const u32x4 a = *(const u32x4*)(row + lane * 8), b = *(const u32x4*)(row + 512 + lane * 8);
#pragma unroll
    for (int i = 0; i < 4; ++i) { v[2 * i] = bflo(a[i]); v[2 * i + 1] = bfhi(a[i]); v[8 + 2 * i] = bflo(b[i]); v[8 + 2 * i + 1] = bfhi(b[i]); }
}
DI void store_row16_bf(bf16_t* row, int lane, const float (&v)[16]) {
    u32x4 a, b;
#pragma unroll
    for (int i = 0; i < 4; ++i) { a[i] = pk2(v[2 * i], v[2 * i + 1]); b[i] = pk2(v[8 + 2 * i], v[8 + 2 * i + 1]); }
    *(u32x4*)(row + lane * 8) = a; *(u32x4*)(row + 512 + lane * 8) = b;
}
DI void store_row16(float* row, int lane, const float (&v)[16]) {
    f32x4 a0, a1, b0, b1;
#pragma unroll
    for (int i = 0; i < 4; ++i) { a0[i] = v[i]; a1[i] = v[4 + i]; b0[i] = v[8 + i]; b1[i] = v[12 + i]; }
    *(f32x4*)(row + lane * 8) = a0; *(f32x4*)(row + lane * 8 + 4) = a1; *(f32x4*)(row + 512 + lane * 8) = b0; *(f32x4*)(row + 512 + lane * 8 + 4) = b1;
}

DI void phase1(const Params& p) {
    const int lane = threadIdx.x & 63, gw = blockIdx.x * NWAVES + (threadIdx.x >> 6), NW = gridDim.x * NWAVES;
    const float* mod = (const float*)(p.ws + WS_MOD);
    bf16_t* h = (bf16_t*)(p.ws + WS_H);
    float g[16]; load_row16(p.g_pre_mix, lane, g);
    for (int t = gw; t < T; t += NW) {
        const int b = t >> 11;
        float v[16], sh[16], sc[16];
        load_row16(p.x + (size_t)t * DM, lane, v);
        load_row16(mod + b * 6144 + 0, lane, sh);
        load_row16(mod + b * 6144 + 1024, lane, sc);
        float ss = 0.f;
#pragma unroll
        for (int i = 0; i < 16; ++i) ss += v[i] * v[i];
        const float rstd = rsqrtf(wave_sum(ss) * (1.0f / DM) + EPS);
        float o[16];
#pragma unroll
        for (int i = 0; i < 16; ++i) o[i] = v[i] * rstd * g[i] * (1.0f + sc[i]) + sh[i];
        store_row16_bf(h + (size_t)t * DM, lane, o);
    }
}

DI void phase5(const Params& p) {
    const int lane = threadIdx.x & 63, gw = blockIdx.x * NWAVES + (threadIdx.x >> 6), NW = gridDim.x * NWAVES;
    const float* mod = (const float*)(p.ws + WS_MOD);
    const bf16_t* y = (const bf16_t*)(p.ws + WS_Y);
    bf16_t* h = (bf16_t*)(p.ws + WS_H);
    float g1[16], g2[16]; load_row16(p.g_post_mix, lane, g1); load_row16(p.g_pre_ffn, lane, g2);
    for (int t = gw; t < T; t += NW) {
        const int b = t >> 11;
        float xv[16], yv[16], gt[16], sh[16], sc[16];
        load_row16(p.x + (size_t)t * DM, lane, xv);
        load_row16_bf(y + (size_t)t * DM, lane, yv);
        load_row16(mod + b * 6144 + 2048, lane, gt);
        load_row16(mod + b * 6144 + 3072, lane, sh);
        load_row16(mod + b * 6144 + 4096, lane, sc);
        float ss = 0.f;
#pragma unroll
        for (int i = 0; i < 16; ++i) ss += yv[i] * yv[i];
        const float rstd = rsqrtf(wave_sum(ss) * (1.0f / DM) + EPS);
        float x1[16]; float s1 = 0.f;
#pragma unroll
        for (int i = 0; i < 16; ++i) { x1[i] = xv[i] + gt[i] * (yv[i] * rstd * g1[i]); s1 += x1[i] * x1[i]; }
        store_row16(p.out + (size_t)t * DM, lane, x1);
        const float rstd1 = rsqrtf(wave_sum(s1) * (1.0f / DM) + EPS);
        float o[16];
#pragma unroll
        for (int i = 0; i < 16; ++i) o[i] = x1[i] * rstd1 * g2[i] * (1.0f + sc[i]) + sh[i];
        store_row16_bf(h + (size_t)t * DM, lane, o);
    }
}

constexpr int G_BM = 256, G_BN = 128, G_BK = 64, G_LDS_ROW = 144;
constexpr int G_A_BYTES = G_BM * G_LDS_ROW, G_B_BYTES = G_BN * G_LDS_ROW, G_STAGE = G_A_BYTES + G_B_BYTES;
enum { EPI_PROJ = 0, EPI_BF16 = 1, EPI_F32 = 2 };

template <int EPI>
DI void gemm_epilogue(const Params& p, const f32x16 (&acc)[2][2], int m0, int n0, int N, void* Cv, int lane) {
    const int r = lane & 31, h = lane >> 5;
    if (EPI == EPI_F32) {
        float* C = (float*)Cv;
#pragma unroll
        for (int mi = 0; mi < 2; ++mi)
#pragma unroll
            for (int ni = 0; ni < 2; ++ni)
#pragma unroll
                for (int i = 0; i < 16; ++i) C[(size_t)(m0 + mi * 32 + crow(i, h)) * N + n0 + ni * 32 + r] = acc[mi][ni][i];
    } else if (EPI == EPI_BF16) {
        bf16_t* C = (bf16_t*)Cv;
#pragma unroll
        for (int mi = 0; mi < 2; ++mi)
#pragma unroll
            for (int ni = 0; ni < 2; ++ni)
#pragma unroll
                for (int i = 0; i < 16; ++i) C[(size_t)(m0 + mi * 32 + crow(i, h)) * N + n0 + ni * 32 + r] = f2bf(acc[mi][ni][i]);
    } else {
        bf16_t* C = (bf16_t*)Cv;
        const float* rope = (const float*)(p.ws + WS_ROPE);
        const bool is_rope = n0 < C_V, is_gelu = n0 >= C_U;
        const float qs = (n0 < C_K) ? 0.125f : 1.0f;
#pragma unroll
        for (int mi = 0; mi < 2; ++mi)
#pragma unroll
            for (int i = 0; i < 16; ++i) {
                const int row = m0 + mi * 32 + crow(i, h);
                float a = acc[mi][0][i], b = acc[mi][1][i];
                if (is_rope) {
                    const int pos = row & (SEQ - 1);
                    const float cs = rope[(pos * 32 + r) * 2], sn = rope[(pos * 32 + r) * 2 + 1];
                    const float ra = a * cs - b * sn, rb = b * cs + a * sn;
                    a = ra * qs; b = rb * qs;
                } else if (is_gelu) { a = gelu_exact(a); b = gelu_exact(b); }
                C[(size_t)row * N + n0 + r] = f2bf(a);
                C[(size_t)row * N + n0 + 32 + r] = f2bf(b);
            }
    }
}

template <int EPI, bool N_MAJOR>
DI void gemm_phase(const Params& p, const bf16_t* A, const bf16_t* Bt, int M, int N, int K, void* C, unsigned char* smem) {
    const int tid = threadIdx.x, w = tid >> 6, lane = tid & 63, r = lane & 31, h = lane >> 5;
    const int wm = w >> 1, wn = w & 1;
    const int nM = M / G_BM, nN = N / G_BN, total = nM * nN, G = gridDim.x;
    const int per = (total + G - 1) / G;
    int t_lo = blockIdx.x * per, t_hi = t_lo + per; if (t_hi > total) t_hi = total;
    const int nk = K / G_BK;
    for (int t = t_lo; t < t_hi; ++t) {
        int tm, tn;
        if (N_MAJOR) { tn = t / nM; tm = t % nM; } else { tm = t / nN; tn = t % nN; }
        const int bm0 = tm * G_BM, bn0 = tn * G_BN;
        f32x16 acc[2][2];
#pragma unroll
        for (int mi = 0; mi < 2; ++mi)
#pragma unroll
            for (int ni = 0; ni < 2; ++ni)
#pragma unroll
                for (int i = 0; i < 16; ++i) acc[mi][ni][i] = 0.f;
        u32x4 ra[4], rb[2];
#pragma unroll
        for (int i = 0; i < 4; ++i) { const int c = tid + i * NTHREADS; ra[i] = *(const u32x4*)(A + (size_t)(bm0 + (c >> 3)) * K + (c & 7) * 8); }
#pragma unroll
        for (int i = 0; i < 2; ++i) { const int c = tid + i * NTHREADS; rb[i] = *(const u32x4*)(Bt + (size_t)(bn0 + (c >> 3)) * K + (c & 7) * 8); }
#pragma unroll
        for (int i = 0; i < 4; ++i) { const int c = tid + i * NTHREADS; *(u32x4*)(smem + (c >> 3) * G_LDS_ROW + (c & 7) * 16) = ra[i]; }
#pragma unroll
        for (int i = 0; i < 2; ++i) { const int c = tid + i * NTHREADS; *(u32x4*)(smem + G_A_BYTES + (c >> 3) * G_LDS_ROW + (c & 7) * 16) = rb[i]; }
        __syncthreads();
        for (int kt = 0; kt < nk; ++kt) {
            const int cur = kt & 1;
            if (kt + 1 < nk) {
                const int k0 = (kt + 1) * G_BK;
#pragma unroll
                for (int i = 0; i < 4; ++i) { const int c = tid + i * NTHREADS; ra[i] = *(const u32x4*)(A + (size_t)(bm0 + (c >> 3)) * K + k0 + (c & 7) * 8); }
#pragma unroll
                for (int i = 0; i < 2; ++i) { const int c = tid + i * NTHREADS; rb[i] = *(const u32x4*)(Bt + (size_t)(bn0 + (c >> 3)) * K + k0 + (c & 7) * 8); }
            }
            const unsigned char* sa = smem + cur * G_STAGE + (wm * 64 + r) * G_LDS_ROW + h * 16;
            const unsigned char* sb = smem + cur * G_STAGE + G_A_BYTES + (wn * 64 + r) * G_LDS_ROW + h * 16;
#pragma unroll
            for (int ks = 0; ks < 4; ++ks) {
                bf16x8 af[2], bfr[2];
                af[0] = *(const bf16x8*)(sa + ks * 32); af[1] = *(const bf16x8*)(sa + 32 * G_LDS_ROW + ks * 32);
                bfr[0] = *(const bf16x8*)(sb + ks * 32); bfr[1] = *(const bf16x8*)(sb + 32 * G_LDS_ROW + ks * 32);
#pragma unroll
                for (int mi = 0; mi < 2; ++mi)
#pragma unroll
                    for (int ni = 0; ni < 2; ++ni) acc[mi][ni] = MFMA32(af[mi], bfr[ni], acc[mi][ni]);
            }
            if (kt + 1 < nk) {
                unsigned char* st = smem + (cur ^ 1) * G_STAGE;
#pragma unroll
                for (int i = 0; i < 4; ++i) { const int c = tid + i * NTHREADS; *(u32x4*)(st + (c >> 3) * G_LDS_ROW + (c & 7) * 16) = ra[i]; }
#pragma unroll
                for (int i = 0; i < 2; ++i) { const int c = tid + i * NTHREADS; *(u32x4*)(st + G_A_BYTES + (c >> 3) * G_LDS_ROW + (c & 7) * 16) = rb[i]; }
            }
            __syncthreads();
        }
        gemm_epilogue<EPI>(p, acc, bm0 + wm * 64, bn0 + wn * 64, N, C, lane);
    }
}

constexpr int A_KROW = 144;
constexpr int A_VROW = 520;
constexpr int A_KS = 0;
constexpr int A_VT = 2 * 256 * A_KROW;
constexpr int S_VROW = 272;
constexpr int A_RED = 140288;
constexpr int A_LDS = A_RED + 2 * 8 * 32 * 4;

DI void head_norm_store(const f32x16 (&o)[2], const float* gvec, bf16_t* yrow, float* red, int w, int lane) {
    const int r = lane & 31, h = lane >> 5;
    float ss = 0.f;
#pragma unroll
    for (int dt = 0; dt < 2; ++dt)
#pragma unroll
        for (int i = 0; i < 16; ++i) ss += o[dt][i] * o[dt][i];
    ss += __shfl_xor(ss, 32);
    if (lane < 32) red[w * 32 + r] = ss;
    __syncthreads();
    float tot = 0.f;
#pragma unroll
    for (int ww = 0; ww < 8; ++ww) tot += red[ww * 32 + r];
    const float rstd = rsqrtf(tot * (1.0f / 512.0f) + EPS);
#pragma unroll
    for (int dt = 0; dt < 2; ++dt)
#pragma unroll
        for (int g4 = 0; g4 < 4; ++g4) {
            const int d = dt * 32 + 8 * g4 + 4 * h;
            const f32x4 gv = *(const f32x4*)(gvec + d);
            u32x2 pk;
            pk[0] = pk2(o[dt][4 * g4 + 0] * rstd * gv[0], o[dt][4 * g4 + 1] * rstd * gv[1]);
            pk[1] = pk2(o[dt][4 * g4 + 2] * rstd * gv[2], o[dt][4 * g4 + 3] * rstd * gv[3]);
            *(u32x2*)(yrow + d) = pk;
        }
}

DI bf16x8 pack8(const f32x16& x, int s) {
    u32x4 q;
    q[0] = pk2(x[8 * s + 0], x[8 * s + 1]); q[1] = pk2(x[8 * s + 2], x[8 * s + 3]);
    q[2] = pk2(x[8 * s + 4], x[8 * s + 5]); q[3] = pk2(x[8 * s + 6], x[8 * s + 7]);
    return __builtin_bit_cast(bf16x8, q);
}

DI void phase3(const Params& p, unsigned char* smem) {
    const int tid = threadIdx.x, w = tid >> 6, lane = tid & 63, r = lane & 31, h = lane >> 5;
    const bf16_t* proj = (const bf16_t*)(p.ws + WS_PROJ);
    const bf16_t* wsb = (const bf16_t*)(p.ws + WS_WS);
    bf16_t* yin = (bf16_t*)(p.ws + WS_YIN);
    float* red = (float*)(smem + A_RED);
    for (int item = blockIdx.x; item < NB * 16; item += gridDim.x) {
        const int nblk = item & 15;
        const int tok0 = item * 128;
        for (int c = tid; c < 2 * 256 * 8; c += NTHREADS) {
            const int g = c >> 11, key = (c >> 3) & 255, kc = c & 7;
            u32x4 kv = {0u, 0u, 0u, 0u}, vv = {0u, 0u, 0u, 0u};
            if (nblk > 0 || key >= 128) {
                const size_t base = (size_t)(tok0 - 128 + key) * INC + g * 64 + kc * 8;
                kv = *(const u32x4*)(proj + base + C_K);
                vv = *(const u32x4*)(proj + base + C_V);
            }
            *(u32x4*)(smem + A_KS + (g * 256 + key) * A_KROW + kc * 16) = kv;
            bf16_t* vt = (bf16_t*)(smem + A_VT + (g * 64 + kc * 8) * A_VROW) + key;
#pragma unroll
            for (int i = 0; i < 4; ++i) {
                vt[(2 * i) * (A_VROW / 2)] = (bf16_t)(vv[i] & 0xffffu);
                vt[(2 * i + 1) * (A_VROW / 2)] = (bf16_t)(vv[i] >> 16);
            }
        }
        __syncthreads();
        {
            const int g = w >> 2;
            const float sink = p.sinks[w];
            const unsigned char* kbase = smem + A_KS + (g * 256) * A_KROW;
            const unsigned char* vbase = smem + A_VT + (g * 64) * A_VROW;
            for (int qt = 0; qt < 4; ++qt) {
                const int tq = tok0 + qt * 32 + r;
                bf16x8 bq[4];
#pragma unroll
                for (int s = 0; s < 4; ++s) bq[s] = *(const bf16x8*)(proj + (size_t)tq * INC + w * 64 + s * 16 + h * 8);
                f32x16 sacc[5];
#pragma unroll
                for (int kt = 0; kt < 5; ++kt) {
#pragma unroll
                    for (int i = 0; i < 16; ++i) sacc[kt][i] = 0.f;
                    const unsigned char* kp = kbase + (qt * 32 + kt * 32 + r) * A_KROW + h * 16;
#pragma unroll
                    for (int s = 0; s < 4; ++s) {
                        const bf16x8 ka = *(const bf16x8*)(kp + s * 32);
                        sacc[kt] = MFMA32(ka, bq[s], sacc[kt]);
                    }
                }
                float mx = -INFINITY;
#pragma unroll
                for (int kt = 0; kt < 5; ++kt)
#pragma unroll
                    for (int i = 0; i < 16; ++i) {
                        const int diff = kt * 32 + crow(i, h) - r;
                        bool valid = (diff >= 1) && (diff <= 128);
                        if (nblk == 0) valid = valid && (qt * 32 + kt * 32 + crow(i, h) >= 128);
                        const float sv = valid ? sacc[kt][i] : -INFINITY;
                        sacc[kt][i] = sv;
                        mx = fmaxf(mx, sv);
                    }
                mx = fmaxf(mx, __shfl_xor(mx, 32));
                mx = fmaxf(mx, sink);
                float lsum = 0.f;
#pragma unroll
                for (int kt = 0; kt < 5; ++kt)
#pragma unroll
                    for (int i = 0; i < 16; ++i) { const float e = __expf(sacc[kt][i] - mx); sacc[kt][i] = e; lsum += e; }
                lsum += __shfl_xor(lsum, 32);
                lsum += __expf(sink - mx);
                const float inv_l = 1.0f / lsum;
                f32x16 o[2];
#pragma unroll
                for (int dt = 0; dt < 2; ++dt)
#pragma unroll
                    for (int i = 0; i < 16; ++i) o[dt][i] = 0.f;
#pragma unroll
                for (int kt = 0; kt < 5; ++kt)
#pragma unroll
                    for (int s = 0; s < 2; ++s) {
                        const bf16x8 pb = pack8(sacc[kt], s);
                        const int key0 = qt * 32 + kt * 32 + 16 * s + 4 * h;
#pragma unroll
                        for (int dt = 0; dt < 2; ++dt) {
                            const unsigned char* vp = vbase + (dt * 32 + r) * A_VROW + key0 * 2;
                            const s16x4 lo = *(const s16x4*)(vp), hi = *(const s16x4*)(vp + 16);
                            const bf16x8 va = __builtin_shufflevector(lo, hi, 0, 1, 2, 3, 4, 5, 6, 7);
                            o[dt] = MFMA32(va, pb, o[dt]);
                        }
                    }
#pragma unroll
                for (int dt = 0; dt < 2; ++dt)
#pragma unroll
                    for (int i = 0; i < 16; ++i) o[dt][i] *= inv_l;
                head_norm_store(o, p.g_att_out + w * 64, yin + (size_t)tq * DM + w * 64, red + (qt & 1) * 256, w, lane);
            }
        }
        __syncthreads();
        for (int rr = tid; rr < 128 * 8; rr += NTHREADS) {
            const int s = rr >> 3, hs = rr & 7;
            const bf16_t* src = proj + (size_t)(tok0 + s) * INC + C_VS + hs * 64;
            float v[64];
#pragma unroll
            for (int c = 0; c < 8; ++c) {
                const u32x4 q = *(const u32x4*)(src + c * 8);
#pragma unroll
                for (int i = 0; i < 4; ++i) { v[c * 8 + 2 * i] = bflo(q[i]); v[c * 8 + 2 * i + 1] = bfhi(q[i]); }
            }
            float mu = 0.f;
#pragma unroll
            for (int i = 0; i < 64; ++i) mu += v[i];
            mu *= (1.0f / 64.0f);
            float var = 0.f;
#pragma unroll
            for (int i = 0; i < 64; ++i) { const float d = v[i] - mu; var += d * d; }
            const float rstd = rsqrtf(var * (1.0f / 64.0f) + EPS);
            bf16_t* dst = (bf16_t*)(smem + (hs * 64) * S_VROW) + s;
#pragma unroll
            for (int i = 0; i < 64; ++i) {
                const float yv = (v[i] - mu) * rstd * p.sgu_ln_g[hs * 64 + i] + p.sgu_ln_b[hs * 64 + i];
                dst[i * (S_VROW / 2)] = f2bf(yv);
            }
        }
        __syncthreads();
        {
            const unsigned char* vb = smem + (w * 64) * S_VROW;
            for (int tt = 0; tt < 4; ++tt) {
                const int tl = tt * 32 + r;
                f32x16 o[2];
#pragma unroll
                for (int dt = 0; dt < 2; ++dt)
#pragma unroll
                    for (int i = 0; i < 16; ++i) o[dt][i] = 0.f;
                const bf16_t* wrow = wsb + (size_t)(w * 128 + tl) * 128 + h * 8;
                const int nks = 2 * (tt + 1);
                for (int ks = 0; ks < nks; ++ks) {
                    const bf16x8 wb = *(const bf16x8*)(wrow + ks * 16);
#pragma unroll
                    for (int dt = 0; dt < 2; ++dt) {
                        const bf16x8 va = *(const bf16x8*)(vb + (dt * 32 + r) * S_VROW + (ks * 16 + h * 8) * 2);
                        o[dt] = MFMA32(va, wb, o[dt]);
                    }
                }
                const float bias = p.b_s[w * 128 + tl];
                const bf16_t* urow = proj + (size_t)(tok0 + tl) * INC + C_U + w * 64;
#pragma unroll
                for (int dt = 0; dt < 2; ++dt)
#pragma unroll
                    for (int g4 = 0; g4 < 4; ++g4) {
                        const u32x2 uu = *(const u32x2*)(urow + dt * 32 + 8 * g4 + 4 * h);
                        o[dt][4 * g4 + 0] = (o[dt][4 * g4 + 0] + bias) * bflo(uu[0]);
                        o[dt][4 * g4 + 1] = (o[dt][4 * g4 + 1] + bias) * bfhi(uu[0]);
                        o[dt][4 * g4 + 2] = (o[dt][4 * g4 + 2] + bias) * bflo(uu[1]);
                        o[dt][4 * g4 + 3] = (o[dt][4 * g4 + 3] + bias) * bfhi(uu[1]);
                    }
                head_norm_store(o, p.g_sgu_out + w * 64, yin + (size_t)(tok0 + tl) * DM + 512 + w * 64, red + (tt & 1) * 256, w, lane);
            }
        }
        __syncthreads();
    }
}

DI int f2key(float f) { const int b = __float_as_int(f); return b ^ ((b >> 31) & 0x7fffffff); }
DI float key2f(int k) { return __int_as_float(k ^ ((k >> 31) & 0x7fffffff)); }

DI void phase7(const Params& p) {
    const float* scT = (const float*)(p.ws + WS_SCT);
    int* ids = (int*)(p.ws + WS_IDS);
    float* gates = (float*)(p.ws + WS_GATES);
    const int gsz = gridDim.x * NTHREADS;
    for (int idx = blockIdx.x * NTHREADS + threadIdx.x; idx < T * PH; idx += gsz) {
        const int tok = idx & (T - 1), hd = idx >> 16;
        int a0[16], a1[16];
#pragma unroll
        for (int i = 0; i < 16; ++i) { a0[i] = INT_MIN; a1[i] = INT_MIN; }
        const float* s0 = scT + (size_t)(hd * 256) * T + tok;
        const float* s1 = s0 + (size_t)128 * T;
#pragma unroll 8
        for (int n = 0; n < 128; ++n) {
            int v0 = (f2key(s0[(size_t)n * T]) & ~127) | (127 - n);
            int v1 = (f2key(s1[(size_t)n * T]) & ~127) | (127 - n);
#pragma unroll
            for (int i = 0; i < 16; ++i) {
                const int m0 = max(a0[i], v0); v0 = min(a0[i], v0); a0[i] = m0;
                const int m1 = max(a1[i], v1); v1 = min(a1[i], v1); a1[i] = m1;
            }
        }
        float ts[16]; int tp[16];
#pragma unroll
        for (int i = 0; i < 16; ++i) { ts[i] = -INFINITY; tp[i] = 0; }
#pragma unroll
        for (int i = 0; i < 16; ++i) {
            const float vi = key2f(a0[i] & ~127);
            const int ni = 127 - (a0[i] & 127);
#pragma unroll
            for (int j = 0; j < 16; ++j) {
                if ((i + 1) * (j + 1) <= 16) {
                    float v = vi + key2f(a1[j] & ~127);
                    int pl = ni * 128 + (127 - (a1[j] & 127));
#pragma unroll
                    for (int k = 0; k < 16; ++k) {
                        const bool gt = v > ts[k];
                        const float nv = gt ? ts[k] : v; const int np = gt ? tp[k] : pl;
                        ts[k] = gt ? v : ts[k]; tp[k] = gt ? pl : tp[k];
                        v = nv; pl = np;
                    }
                }
            }
        }
        float e[16], sum = 0.f;
#pragma unroll
        for (int k = 0; k < 16; ++k) { e[k] = __expf(ts[k] - ts[0]); sum += e[k]; }
        const float inv = 1.0f / sum;
        int* ip = ids + (size_t)tok * 128 + hd * 16;
        float* gp = gates + (size_t)tok * 128 + hd * 16;
#pragma unroll
        for (int k4 = 0; k4 < 4; ++k4) {
            int4 iv = make_int4(tp[4 * k4], tp[4 * k4 + 1], tp[4 * k4 + 2], tp[4 * k4 + 3]);
            *(int4*)(ip + 4 * k4) = iv;
            f32x4 gv = {e[4 * k4] * inv, e[4 * k4 + 1] * inv, e[4 * k4 + 2] * inv, e[4 * k4 + 3] * inv};
            *(f32x4*)(gp + 4 * k4) = gv;
        }
    }
}

DI void load_rowP(const float* row, int lane, float (&v)[16]) {
#pragma unroll
    for (int j = 0; j < 4; ++j) { const f32x4 a = *(const f32x4*)(row + 256 * j + 4 * lane);
#pragma unroll
        for (int i = 0; i < 4; ++i) v[4 * j + i] = a[i]; }
}
DI void store_rowP(float* row, int lane, const float (&v)[16]) {
#pragma unroll
    for (int j = 0; j < 4; ++j) { f32x4 a;
#pragma unroll
        for (int i = 0; i < 4; ++i) a[i] = v[4 * j + i];
        *(f32x4*)(row + 256 * j + 4 * lane) = a; }
}
DI void phase8(const Params& p, unsigned char* smem) {
    const int tid = threadIdx.x, w = tid >> 6, lane = tid & 63;
    const int gw = blockIdx.x * NWAVES + w, NW = gridDim.x * NWAVES;
    const bf16_t* hb = (const bf16_t*)(p.ws + WS_H);
    const unsigned char* ed = p.ws + WS_ED;
    const unsigned char* eu = p.ws + WS_EU;
    const float* scd = (const float*)(p.ws + WS_SCD);
    const float* scu = (const float*)(p.ws + WS_SCU);
    const int* ids = (const int*)(p.ws + WS_IDS);
    const float* gates = (const float*)(p.ws + WS_GATES);
    const float* mod = (const float*)(p.ws + WS_MOD);
    float* s_cf = (float*)(smem + w * 512);
    float gpost[16]; load_rowP(p.g_post_ffn, lane, gpost);
    for (int t = gw; t < T; t += NW) {
        const int b = t >> 11;
        f32x2 h2[8];
#pragma unroll
        for (int j = 0; j < 4; ++j) {
            const u32x2 a = *(const u32x2*)(hb + (size_t)t * DM + 256 * j + 4 * lane);
            h2[2 * j] = (f32x2){bflo(a[0]), bfhi(a[0])}; h2[2 * j + 1] = (f32x2){bflo(a[1]), bfhi(a[1])};
        }
        const int id_lo = ids[(size_t)t * 128 + lane], id_hi = ids[(size_t)t * 128 + 64 + lane];
        for (int g16 = 0; g16 < 8; ++g16) {
            u32x4 rows[16];
            const int idv = (g16 < 4) ? id_lo : id_hi;
#pragma unroll
            for (int j = 0; j < 16; ++j) {
                const int e = __builtin_amdgcn_readlane(idv, (g16 & 3) * 16 + j);
                rows[j] = *(const u32x4*)(ed + (size_t)e * DM + 16 * lane);
            }
#pragma unroll
            for (int hf = 0; hf < 2; ++hf) {
                float part[8];
#pragma unroll
                for (int j = 0; j < 8; ++j) {
                    f32x2 a = {0.f, 0.f};
#pragma unroll
                    for (int q = 0; q < 4; ++q) {
                        const f32x2 lo = __builtin_amdgcn_cvt_pk_f32_fp8(rows[hf * 8 + j][q], false);
                        const f32x2 hi = __builtin_amdgcn_cvt_pk_f32_fp8(rows[hf * 8 + j][q], true);
                        a = __builtin_elementwise_fma(lo, h2[2 * q], a);
                        a = __builtin_elementwise_fma(hi, h2[2 * q + 1], a);
                    }
                    part[j] = a[0] + a[1];
                }
                float q4[4];
#pragma unroll
                for (int i = 0; i < 4; ++i) {
                    const bool up = (lane & 32) != 0;
                    const float send = up ? part[i] : part[i + 4];
                    const float keep = up ? part[i + 4] : part[i];
                    q4[i] = keep + __shfl_xor(send, 32);
                }
                float q2[2];
#pragma unroll
                for (int i = 0; i < 2; ++i) {
                    const bool up = (lane & 16) != 0;
                    const float send = up ? q4[i] : q4[i + 2];
                    const float keep = up ? q4[i + 2] : q4[i];
                    q2[i] = keep + __shfl_xor(send, 16);
                }
                float s1;
                {
                    const bool up = (lane & 8) != 0;
                    const float send = up ? q2[0] : q2[1];
                    const float keep = up ? q2[1] : q2[0];
                    s1 = keep + __shfl_xor(send, 8);
                }
                s1 += __shfl_xor(s1, 4); s1 += __shfl_xor(s1, 2); s1 += __shfl_xor(s1, 1);
                const int k = g16 * 16 + hf * 8 + (lane >> 3);
                const int ek = ids[(size_t)t * 128 + k];
                const float cf = gates[(size_t)t * 128 + k] * gelu_exact(s1 * scd[ek]) * scu[ek];
                if ((lane & 7) == 0) s_cf[k] = cf;
            }
        }
        const float cf_lo = s_cf[lane], cf_hi = s_cf[64 + lane];
        f32x2 acc[8];
#pragma unroll
        for (int i = 0; i < 8; ++i) acc[i] = (f32x2){0.f, 0.f};
        for (int g16 = 0; g16 < 8; ++g16) {
            u32x4 rows[16];
            const int idv = (g16 < 4) ? id_lo : id_hi;
            const float cfv = (g16 < 4) ? cf_lo : cf_hi;
#pragma unroll
            for (int j = 0; j < 16; ++j) {
                const int e = __builtin_amdgcn_readlane(idv, (g16 & 3) * 16 + j);
                rows[j] = *(const u32x4*)(eu + (size_t)e * DM + 16 * lane);
            }
#pragma unroll
            for (int j = 0; j < 16; ++j) {
                const float cf = __builtin_bit_cast(float, __builtin_amdgcn_readlane(__builtin_bit_cast(int, cfv), (g16 & 3) * 16 + j));
                const f32x2 cf2 = {cf, cf};
#pragma unroll
                for (int q = 0; q < 4; ++q) {
                    const f32x2 lo = __builtin_amdgcn_cvt_pk_f32_fp8(rows[j][q], false);
                    const f32x2 hi = __builtin_amdgcn_cvt_pk_f32_fp8(rows[j][q], true);
                    acc[2 * q] = __builtin_elementwise_fma(lo, cf2, acc[2 * q]);
                    acc[2 * q + 1] = __builtin_elementwise_fma(hi, cf2, acc[2 * q + 1]);
                }
            }
        }
        float y2[16];
#pragma unroll
        for (int q = 0; q < 4; ++q) { y2[4 * q] = acc[2 * q][0]; y2[4 * q + 1] = acc[2 * q][1]; y2[4 * q + 2] = acc[2 * q + 1][0]; y2[4 * q + 3] = acc[2 * q + 1][1]; }
        float ss = 0.f;
#pragma unroll
        for (int i = 0; i < 16; ++i) ss += y2[i] * y2[i];
        const float rstd = rsqrtf(wave_sum(ss) * (1.0f / DM) + EPS);
        float x1[16], gt[16];
        load_rowP(p.out + (size_t)t * DM, lane, x1);
        load_rowP(mod + b * 6144 + 5120, lane, gt);
        float o[16];
#pragma unroll
        for (int i = 0; i < 16; ++i) o[i] = x1[i] + gt[i] * (y2[i] * rstd * gpost[i]);
        store_rowP(p.out + (size_t)t * DM, lane, o);
    }
}

constexpr int LDS_BYTES = 147456;

template <int PHS>
DI void run_phase(const Params& p, unsigned char* smem) {
    if (PHS == 0) phase0(p, smem);
    else if (PHS == 1) phase1(p);
    else if (PHS == 2) gemm_phase<EPI_PROJ, false>(p, (const bf16_t*)(p.ws + WS_H), (const bf16_t*)(p.ws + WS_WIN), T, INC, DM, p.ws + WS_PROJ, smem);
    else if (PHS == 3) phase3(p, smem);
    else if (PHS == 4) gemm_phase<EPI_BF16, false>(p, (const bf16_t*)(p.ws + WS_YIN), (const bf16_t*)(p.ws + WS_WOUT), T, DM, DM, p.ws + WS_Y, smem);
    else if (PHS == 5) phase5(p);
    else if (PHS == 6) gemm_phase<EPI_F32, true>(p, (const bf16_t*)(p.ws + WS_WQF), (const bf16_t*)(p.ws + WS_H), 2048, T, DM, p.ws + WS_SCT, smem);
    else if (PHS == 7) phase7(p);
    else if (PHS == 8) phase8(p, smem);
}

template <int PHS>
__global__ void __launch_bounds__(NTHREADS) k_phase(Params p) {
    __shared__ __attribute__((aligned(16))) unsigned char smem[LDS_BYTES];
    run_phase<PHS>(p, smem);
}

__global__ void __launch_bounds__(NTHREADS) k_mega(Params p) {
    __shared__ __attribute__((aligned(16))) unsigned char smem[LDS_BYTES];
    cg::grid_group grid = cg::this_grid();
#ifndef DUP_MASK
#define DUP_MASK 0
#endif
#define RUNP(k) do { run_phase<k>(p, smem); grid.sync(); if ((DUP_MASK >> k) & 1) { run_phase<k>(p, smem); grid.sync(); } } while (0)
    RUNP(0); RUNP(1); RUNP(2); RUNP(3); RUNP(4); RUNP(5); RUNP(6); RUNP(7);
    run_phase<8>(p, smem);
    if ((DUP_MASK >> 8) & 1) { grid.sync(); run_phase<5>(p, smem); grid.sync(); run_phase<8>(p, smem); }
}

template <int PHS>
static void launch_phase(const Params& p, int grid, hipStream_t stream) {
    hipLaunchKernelGGL(k_phase<PHS>, dim3(grid), dim3(NTHREADS), 0, stream, p);
}

extern "C" void kernel_launch(void* const* d_in, const int* in_sizes, int n_in, void* d_out, int out_size, void* d_ws, size_t ws_size, hipStream_t stream) {
    if (n_in != 21 || out_size != T * DM || ws_size < WS_END) {
        fprintf(stderr, "kernel_launch: unexpected shapes (n_in %d out %d ws %zu need %zu)\n", n_in, out_size, ws_size, (size_t)WS_END);
        return;
    }
    Params p{};
    const float** f = (const float**)&p;
    for (int i = 0; i < 21; ++i) f[i] = (const float*)d_in[i];
    p.out = (float*)d_out; p.ws = (unsigned char*)d_ws;
#if MULTI_LAUNCH
    const int grid = 256;
    launch_phase<0>(p, grid, stream); launch_phase<1>(p, grid, stream); launch_phase<2>(p, grid, stream);
    launch_phase<3>(p, grid, stream); launch_phase<4>(p, grid, stream); launch_phase<5>(p, grid, stream);
    launch_phase<6>(p, grid, stream); launch_phase<7>(p, grid, stream); launch_phase<8>(p, grid, stream);
#else
    static int grid = 0;
    if (!grid) {
        int dev = 0, cus = 0, per_cu = 0;
        (void)hipGetDevice(&dev);
        (void)hipDeviceGetAttribute(&cus, hipDeviceAttributeMultiprocessorCount, dev);
        (void)hipOccupancyMaxActiveBlocksPerMultiprocessor(&per_cu, (const void*)k_mega, NTHREADS, 0);
        if (per_cu < 1) { fprintf(stderr, "kernel_launch: occupancy query says %d blocks per CU\n", per_cu); per_cu = 1; }
        grid = cus;
    }
    void* args[] = {&p};
    hipError_t e = hipLaunchCooperativeKernel((const void*)k_mega, dim3(grid), dim3(NTHREADS), args, 0, stream);
    if (e != hipSuccess) fprintf(stderr, "cooperative launch failed: %s (grid %d)\n", hipGetErrorString(e), grid);
#endif
}
```

```cpp
#include <hip/hip_runtime.h>
#include <hip/hip_cooperative_groups.h>
#include <stdint.h>
#include <stdio.h>
#include <limits.h>
namespace cg = cooperative_groups;

#ifndef MULTI_LAUNCH
#define MULTI_LAUNCH 0
#endif

#define DI __device__ __forceinline__
typedef unsigned short bf16_t;
typedef short bf16x8 __attribute__((ext_vector_type(8)));
typedef short s16x4 __attribute__((ext_vector_type(4)));
typedef float f32x16 __attribute__((ext_vector_type(16)));
typedef float f32x4 __attribute__((ext_vector_type(4)));
typedef unsigned u32x4 __attribute__((ext_vector_type(4)));
typedef unsigned u32x2 __attribute__((ext_vector_type(2)));

constexpr int DM = 1024, NB = 32, SEQ = 2048, T = NB * SEQ;
constexpr int HD = 64, QH = 8, KVH = 2, WIN = 128;
constexpr int INC = 1792;
constexpr int C_K = 512, C_V = 640, C_U = 768, C_VS = 1280;
constexpr int PH = 8, NKEYS = 128, TOPK = 16, NEXP = 16384;
constexpr float EPS = 1e-6f;
constexpr int NTHREADS = 512, NWAVES = 8;

constexpr size_t WS_MOD   = 0;
constexpr size_t WS_ROPE  = WS_MOD + (size_t)NB * 6144 * 4;
constexpr size_t WS_WIN   = WS_ROPE + (size_t)SEQ * 32 * 8;
constexpr size_t WS_WOUT  = WS_WIN + (size_t)INC * DM * 2;
constexpr size_t WS_WQF   = WS_WOUT + (size_t)DM * DM * 2;
constexpr size_t WS_WS    = WS_WQF + (size_t)2048 * DM * 2;
constexpr size_t WS_ED    = WS_WS + (size_t)8 * 128 * 128 * 2;
constexpr size_t WS_EU    = WS_ED + (size_t)NEXP * DM;
constexpr size_t WS_SCD   = WS_EU + (size_t)NEXP * DM;
constexpr size_t WS_SCU   = WS_SCD + (size_t)NEXP * 4;
constexpr size_t WS_H     = WS_SCU + (size_t)NEXP * 4;
constexpr size_t WS_IDS   = WS_H + (size_t)T * DM * 2;
constexpr size_t WS_GATES = WS_IDS + (size_t)T * 128 * 4;
constexpr size_t WS_BIG   = WS_GATES + (size_t)T * 128 * 4;
constexpr size_t WS_PROJ  = WS_BIG;
constexpr size_t WS_YIN   = WS_PROJ + (size_t)T * INC * 2;
constexpr size_t WS_Y     = WS_YIN + (size_t)T * DM * 2;
constexpr size_t WS_SCT   = WS_BIG;
constexpr size_t WS_BAR   = WS_BIG + (size_t)2048 * T * 4;
constexpr size_t WS_BAR_BYTES = 16384;
constexpr size_t WS_END   = WS_BAR + WS_BAR_BYTES;

struct Params {
    const float* x; const float* c; const float* w_ada; const float* b_ada;
    const float* g_pre_mix; const float* g_post_mix; const float* g_pre_ffn; const float* g_post_ffn;
    const float* w_in; const float* w_s; const float* b_s; const float* sgu_ln_g; const float* sgu_ln_b;
    const float* sinks; const float* g_att_out; const float* g_sgu_out; const float* w_out;
    const float* w_query; const float* sub_keys; const float* expert_down; const float* expert_up;
    float* out; unsigned char* ws;
};

DI float bf2f(unsigned short u) { return __uint_as_float(((unsigned)u) << 16); }
DI float bflo(unsigned w) { return __uint_as_float(w << 16); }
DI float bfhi(unsigned w) { return __uint_as_float(w & 0xffff0000u); }
typedef __bf16 bf2_t __attribute__((ext_vector_type(2)));
typedef float f32x2 __attribute__((ext_vector_type(2)));
DI unsigned pk2(float lo, float hi) { const f32x2 v = {lo, hi}; return __builtin_bit_cast(unsigned, __builtin_convertvector(v, bf2_t)); }
DI unsigned short f2bf(float x) { return __builtin_bit_cast(unsigned short, (__bf16)x); }
DI float wave_sum(float v) {
#pragma unroll
    for (int o = 1; o < 64; o <<= 1) v += __shfl_xor(v, o);
    return v;
}
DI float gelu_exact(float v) { return 0.5f * v * (1.0f + erff(v * 0.70710678118654752f)); }
DI int opaque_tid() { int t = threadIdx.x; asm volatile("" : "+v"(t)); return t; }
DI int crow(int i, int h) { return (i & 3) + 8 * (i >> 2) + 4 * h; }
#define MFMA32(a, b, c) __builtin_amdgcn_mfma_f32_32x32x16_bf16((a), (b), (c), 0, 0, 0)

DI void p0_mod_item(const Params& p, int item, unsigned char* smem) {
    float* sc = (float*)smem;
    const int tid = opaque_tid(), w = tid >> 6, lane = tid & 63;
    for (int idx = tid; idx < 32 * 1024; idx += NTHREADS) {
        const int k = idx >> 5, b = idx & 31;
        const float v = p.c[b * 1024 + k];
        sc[k * 32 + b] = v / (1.0f + expf(-v));
    }
    __syncthreads();
    const int col = item * 64 + lane;
    float acc[32];
#pragma unroll
    for (int b = 0; b < 32; ++b) acc[b] = 0.f;
    for (int kk = 0; kk < 128; ++kk) {
        const int k = w * 128 + kk;
        const float wv = p.w_ada[(size_t)k * 6144 + col];
        const f32x4* sp = (const f32x4*)(sc + k * 32);
#pragma unroll
        for (int b4 = 0; b4 < 8; ++b4) {
            const f32x4 s = sp[b4];
            acc[4 * b4 + 0] += s[0] * wv; acc[4 * b4 + 1] += s[1] * wv; acc[4 * b4 + 2] += s[2] * wv; acc[4 * b4 + 3] += s[3] * wv;
        }
    }
    __syncthreads();
    float* red = (float*)smem;
#pragma unroll
    for (int b = 0; b < 32; ++b) red[(w * 32 + b) * 64 + lane] = acc[b];
    __syncthreads();
    float* mod = (float*)(p.ws + WS_MOD);
    for (int idx = tid; idx < 32 * 64; idx += NTHREADS) {
        const int b = idx >> 6, l = idx & 63;
        float s = 0.f;
#pragma unroll
        for (int ww = 0; ww < 8; ++ww) s += red[(ww * 32 + b) * 64 + l];
        const int cc = item * 64 + l;
        mod[b * 6144 + cc] = s + p.b_ada[cc];
    }
    __syncthreads();
}

DI void p0_fold_item(const Params& p, int item, unsigned char* smem) {
    const int hp = item >> 5, nt = (item >> 4) & 1, jt = item & 15;
    const int n0 = nt * 64, j0 = jt * 64;
    float* sk = (float*)smem;
    float* wq = sk + 64 * 132;
    const int tid = opaque_tid();
    for (int idx = tid; idx < 64 * 32; idx += NTHREADS) {
        const int r = idx >> 5, c4 = idx & 31;
        const f32x4 a = *(const f32x4*)(p.sub_keys + ((size_t)(hp * 128 + n0 + r) * 128 + c4 * 4));
        *(f32x4*)(sk + r * 132 + c4 * 4) = a;
        const f32x4 b = *(const f32x4*)(p.w_query + ((size_t)(j0 + r) * 2048 + hp * 128 + c4 * 4));
        *(f32x4*)(wq + r * 132 + c4 * 4) = b;
    }
    __syncthreads();
    const int tn = tid & 15, tj = tid >> 4;
    float acc[4][2];
#pragma unroll
    for (int a = 0; a < 4; ++a) { acc[a][0] = 0.f; acc[a][1] = 0.f; }
    for (int d = 0; d < 128; d += 4) {
        f32x4 av[4], bv[2];
#pragma unroll
        for (int a = 0; a < 4; ++a) av[a] = *(const f32x4*)(sk + (tn * 4 + a) * 132 + d);
#pragma unroll
        for (int b = 0; b < 2; ++b) bv[b] = *(const f32x4*)(wq + (tj * 2 + b) * 132 + d);
#pragma unroll
        for (int a = 0; a < 4; ++a)
#pragma unroll
            for (int b = 0; b < 2; ++b)
                acc[a][b] += av[a][0] * bv[b][0] + av[a][1] * bv[b][1] + av[a][2] * bv[b][2] + av[a][3] * bv[b][3];
    }
    bf16_t* wf = (bf16_t*)(p.ws + WS_WQF);
#pragma unroll
    for (int a = 0; a < 4; ++a) {
        const size_t row = (size_t)(hp * 128 + n0 + tn * 4 + a);
        *(unsigned*)(wf + row * 1024 + j0 + tj * 2) = pk2(acc[a][0], acc[a][1]);
    }
    __syncthreads();
}

DI void p0_transpose_item(const float* W, int K, int N, bf16_t* WT, int item, unsigned char* smem, bool permute) {
    const int ntn = N / 64, kb = item / ntn, nb = item % ntn, k0 = kb * 64, n0 = nb * 64;
    float* tile = (float*)smem;
    const int tid = opaque_tid();
    for (int idx = tid; idx < 64 * 64; idx += NTHREADS) {
        const int k = idx >> 6, n = idx & 63;
        tile[k * 65 + n] = W[(size_t)(k0 + k) * N + n0 + n];
    }
    __syncthreads();
    {
        const int n = tid >> 3, k8 = tid & 7;
        const float* s = tile + (k8 * 8) * 65 + n;
        u32x4 o;
        o[0] = pk2(s[0 * 65], s[1 * 65]); o[1] = pk2(s[2 * 65], s[3 * 65]); o[2] = pk2(s[4 * 65], s[5 * 65]); o[3] = pk2(s[6 * 65], s[7 * 65]);
        int nr = n0 + n;
        if (permute) { const int blk = (nr >> 4) & 3; if (blk == 1) nr += 16; else if (blk == 2) nr -= 16; }
        *(u32x4*)(WT + (size_t)nr * K + k0 + k8 * 8) = o;
    }
    __syncthreads();
}

DI void phase0(const Params& p, unsigned char* smem) {
    const int bid = blockIdx.x, G = gridDim.x, tid = opaque_tid();
    for (int it = bid; it < 96; it += G) p0_mod_item(p, it, smem);
    for (int it = G - 1 - bid; it < 512; it += G) p0_fold_item(p, it, smem);
    for (int it = bid; it < 16 * 28; it += G) p0_transpose_item(p.w_in, 1024, INC, (bf16_t*)(p.ws + WS_WIN), it, smem, true);
    for (int it = bid; it < 16 * 16; it += G) p0_transpose_item(p.w_out, 1024, 1024, (bf16_t*)(p.ws + WS_WOUT), it, smem, false);
    {
        const int lane = tid & 63, gw = bid * NWAVES + (tid >> 6), NW = G * NWAVES;
        for (int rr = gw; rr < 2 * NEXP; rr += NW) {
            const int tb = rr >= NEXP, e = rr - tb * NEXP;
            const float* row = (tb ? p.expert_up : p.expert_down) + (size_t)e * DM;
            unsigned char* dst = p.ws + (tb ? WS_EU : WS_ED) + (size_t)e * DM;
            float* scl = (float*)(p.ws + (tb ? WS_SCU : WS_SCD));
            f32x4 v[4]; float am = 0.f;
#pragma unroll
            for (int j = 0; j < 4; ++j) { v[j] = *(const f32x4*)(row + 256 * j + 4 * lane);
#pragma unroll
                for (int i = 0; i < 4; ++i) am = fmaxf(am, fabsf(v[j][i])); }
#pragma unroll
            for (int o = 1; o < 64; o <<= 1) am = fmaxf(am, __shfl_xor(am, o));
            const float sc = am > 0.f ? am * (1.0f / 240.0f) : 1.0f, inv = 1.0f / sc;
            u32x4 o4;
#pragma unroll
            for (int j = 0; j < 4; ++j) {
                int wv = 0;
                wv = __builtin_amdgcn_cvt_pk_fp8_f32(v[j][0] * inv, v[j][1] * inv, wv, false);
                wv = __builtin_amdgcn_cvt_pk_fp8_f32(v[j][2] * inv, v[j][3] * inv, wv, true);
                o4[j] = (unsigned)wv;
            }
            *(u32x4*)(dst + 16 * lane) = o4;
            if (lane == 0) scl[e] = sc;
        }
    }
    {
        const int gt = bid * NTHREADS + tid, gsz = G * NTHREADS;
        float* rope = (float*)(p.ws + WS_ROPE);
        for (int i = gt; i < SEQ * 32; i += gsz) {
            const int pos = i >> 5, f = i & 31;
            const float inv = (float)pow(10000.0, -(double)f / 32.0);
            const float ang = (float)pos * inv;
            rope[2 * i] = (float)cos((double)ang); rope[2 * i + 1] = (float)sin((double)ang);
        }
        bf16_t* wsb = (bf16_t*)(p.ws + WS_WS);
        for (int i = gt; i < 8 * 128 * 128; i += gsz) {
            const int t = (i >> 7) & 127, s = i & 127;
            wsb[i] = (s <= t) ? f2bf(p.w_s[i]) : (bf16_t)0;
        }
    }
}

DI void load_row16(const float* row, int lane, float (&v)[16]) {
    const f32x4 a0 = *(const f32x4*)(row + lane * 8), a1 = *(const f32x4*)(row + lane * 8 + 4);
    const f32x4 b0 = *(const f32x4*)(row + 512 + lane * 8), b1 = *(const f32x4*)(row + 512 + lane * 8 + 4);
#pragma unroll
    for (int i = 0; i < 4; ++i) { v[i] = a0[i]; v[4 + i] = a1[i]; v[8 + i] = b0[i]; v[12 + i] = b1[i]; }
}
DI void load_row16_bf(const bf16_t* row, int lane, float (&v)[16]) {
    const u32x4 a = *(const u32x4*)(row + lane * 8), b = *(const u32x4*)(row + 512 + lane * 8);
#pragma unroll
    for (int i = 0; i < 4; ++i) { v[2 * i] = bflo(a[i]); v[2 * i + 1] = bfhi(a[i]); v[8 + 2 * i] = bflo(b[i]); v[8 + 2 * i + 1] = bfhi(b[i]); }
}
DI void store_row16_bf(bf16_t* row, int lane, const float (&v)[16]) {
    u32x4 a, b;
#pragma unroll
    for (int i = 0; i < 4; ++i) { a[i] = pk2(v[2 * i], v[2 * i + 1]); b[i] = pk2(v[8 + 2 * i], v[8 + 2 * i + 1]); }
    *(u32x4*)(row + lane * 8) = a; *(u32x4*)(row + 512 + lane * 8) = b;
}
DI void store_row16(float* row, int lane, const float (&v)[16]) {
    f32x4 a0, a1, b0, b1;
#pragma unroll
    for (int i = 0; i < 4; ++i) { a0[i] = v[i]; a1[i] = v[4 + i]; b0[i] = v[8 + i]; b1[i] = v[12 + i]; }
    *(f32x4*)(row + lane * 8) = a0; *(f32x4*)(row + lane * 8 + 4) = a1; *(f32x4*)(row + 512 + lane * 8) = b0; *(f32x4*)(row + 512 + lane * 8 + 4) = b1;
}

DI void phase1(const Params& p) {
    const int tid = opaque_tid(), lane = tid & 63, gw = blockIdx.x * NWAVES + (tid >> 6), NW = gridDim.x * NWAVES;
    const float* mod = (const float*)(p.ws + WS_MOD);
    bf16_t* h = (bf16_t*)(p.ws + WS_H);
    float g[16]; load_row16(p.g_pre_mix, lane, g);
    for (int t = gw; t < T; t += NW) {
        const int b = t >> 11;
        float v[16], sh[16], sc[16];
        load_row16(p.x + (size_t)t * DM, lane, v);
        load_row16(mod + b * 6144 + 0, lane, sh);
        load_row16(mod + b * 6144 + 1024, lane, sc);
        float ss = 0.f;
#pragma unroll
        for (int i = 0; i < 16; ++i) ss += v[i] * v[i];
        const float rstd = rsqrtf(wave_sum(ss) * (1.0f / DM) + EPS);
        float o[16];
#pragma unroll
        for (int i = 0; i < 16; ++i) o[i] = v[i] * rstd * g[i] * (1.0f + sc[i]) + sh[i];
        store_row16_bf(h + (size_t)t * DM, lane, o);
    }
}

DI void phase5(const Params& p) {
    const int tid = opaque_tid(), lane = tid & 63, gw = blockIdx.x * NWAVES + (tid >> 6), NW = gridDim.x * NWAVES;
    const float* mod = (const float*)(p.ws + WS_MOD);
    const bf16_t* y = (const bf16_t*)(p.ws + WS_Y);
    bf16_t* h = (bf16_t*)(p.ws + WS_H);
    float g1[16], g2[16]; load_row16(p.g_post_mix, lane, g1); load_row16(p.g_pre_ffn, lane, g2);
    for (int t = gw; t < T; t += NW) {
        const int b = t >> 11;
        float xv[16], yv[16], gt[16], sh[16], sc[16];
        load_row16(p.x + (size_t)t * DM, lane, xv);
        load_row16_bf(y + (size_t)t * DM, lane, yv);
        load_row16(mod + b * 6144 + 2048, lane, gt);
        load_row16(mod + b * 6144 + 3072, lane, sh);
        load_row16(mod + b * 6144 + 4096, lane, sc);
        float ss = 0.f;
#pragma unroll
        for (int i = 0; i < 16; ++i) ss += yv[i] * yv[i];
        const float rstd = rsqrtf(wave_sum(ss) * (1.0f / DM) + EPS);
        float x1[16]; float s1 = 0.f;
#pragma unroll
        for (int i = 0; i < 16; ++i) { x1[i] = xv[i] + gt[i] * (yv[i] * rstd * g1[i]); s1 += x1[i] * x1[i]; }
        store_row16(p.out + (size_t)t * DM, lane, x1);
        const float rstd1 = rsqrtf(wave_sum(s1) * (1.0f / DM) + EPS);
        float o[16];
#pragma unroll
        for (int i = 0; i < 16; ++i) o[i] = x1[i] * rstd1 * g2[i] * (1.0f + sc[i]) + sh[i];
        store_row16_bf(h + (size_t)t * DM, lane, o);
    }
}

constexpr int G_BM = 256, G_BN = 128, G_BK = 64, G_LDS_ROW = 144;
constexpr int G_A_BYTES = G_BM * G_LDS_ROW, G_B_BYTES = G_BN * G_LDS_ROW, G_STAGE = G_A_BYTES + G_B_BYTES;
enum { EPI_PROJ = 0, EPI_BF16 = 1, EPI_F32 = 2 };

template <int EPI>
DI void gemm_epilogue(const Params& p, const f32x16 (&acc)[2][2], int m0, int n0, int N, void* Cv, int lane) {
    const int r = lane & 31, h = lane >> 5;
    if (EPI == EPI_F32) {
        float* C = (float*)Cv;
#pragma unroll
        for (int mi = 0; mi < 2; ++mi)
#pragma unroll
            for (int ni = 0; ni < 2; ++ni)
#pragma unroll
                for (int i = 0; i < 16; ++i) C[(size_t)(m0 + mi * 32 + crow(i, h)) * N + n0 + ni * 32 + r] = acc[mi][ni][i];
    } else if (EPI == EPI_BF16) {
        bf16_t* C = (bf16_t*)Cv;
#pragma unroll
        for (int mi = 0; mi < 2; ++mi)
#pragma unroll
            for (int ni = 0; ni < 2; ++ni)
#pragma unroll
                for (int i = 0; i < 16; ++i) C[(size_t)(m0 + mi * 32 + crow(i, h)) * N + n0 + ni * 32 + r] = f2bf(acc[mi][ni][i]);
    } else {
        bf16_t* C = (bf16_t*)Cv;
        const float* rope = (const float*)(p.ws + WS_ROPE);
        const bool is_rope = n0 < C_V, is_gelu = n0 >= C_U;
        const float qs = (n0 < C_K) ? 0.125f : 1.0f;
#pragma unroll
        for (int mi = 0; mi < 2; ++mi)
#pragma unroll
            for (int i = 0; i < 16; ++i) {
                const int row = m0 + mi * 32 + crow(i, h);
                float a = acc[mi][0][i], b = acc[mi][1][i];
                if (is_rope) {
                    const int pos = row & (SEQ - 1);
                    const float cs = rope[(pos * 32 + r) * 2], sn = rope[(pos * 32 + r) * 2 + 1];
                    const float ra = a * cs - b * sn, rb = b * cs + a * sn;
                    a = ra * qs; b = rb * qs;
                } else if (is_gelu) { a = gelu_exact(a); b = gelu_exact(b); }
                C[(size_t)row * N + n0 + r] = f2bf(a);
                C[(size_t)row * N + n0 + 32 + r] = f2bf(b);
            }
    }
}

template <int EPI, bool N_MAJOR>
DI void gemm_phase(const Params& p, const bf16_t* A, const bf16_t* Bt, int M, int N, int K, void* C, unsigned char* smem) {
    const int tid = threadIdx.x, w = tid >> 6, lane = tid & 63, r = lane & 31, h = lane >> 5;
    const int wm = w >> 1, wn = w & 1;
    const int nM = M / G_BM, nN = N / G_BN, total = nM * nN, G = gridDim.x;
    const int per = (total + G - 1) / G;
    int t_lo = blockIdx.x * per, t_hi = t_lo + per; if (t_hi > total) t_hi = total;
    const int nk = K / G_BK;
    for (int t = t_lo; t < t_hi; ++t) {
        int tm, tn;
        if (N_MAJOR) { tn = t / nM; tm = t % nM; } else { tm = t / nN; tn = t % nN; }
        const int bm0 = tm * G_BM, bn0 = tn * G_BN;
        f32x16 acc[2][2];
#pragma unroll
        for (int mi = 0; mi < 2; ++mi)
#pragma unroll
            for (int ni = 0; ni < 2; ++ni)
#pragma unroll
                for (int i = 0; i < 16; ++i) acc[mi][ni][i] = 0.f;
        u32x4 ra[4], rb[2];
#pragma unroll
        for (int i = 0; i < 4; ++i) { const int c = tid + i * NTHREADS; ra[i] = *(const u32x4*)(A + (size_t)(bm0 + (c >> 3)) * K + (c & 7) * 8); }
#pragma unroll
        for (int i = 0; i < 2; ++i) { const int c = tid + i * NTHREADS; rb[i] = *(const u32x4*)(Bt + (size_t)(bn0 + (c >> 3)) * K + (c & 7) * 8); }
#pragma unroll
        for (int i = 0; i < 4; ++i) { const int c = tid + i * NTHREADS; *(u32x4*)(smem + (c >> 3) * G_LDS_ROW + (c & 7) * 16) = ra[i]; }
#pragma unroll
        for (int i = 0; i < 2; ++i) { const int c = tid + i * NTHREADS; *(u32x4*)(smem + G_A_BYTES + (c >> 3) * G_LDS_ROW + (c & 7) * 16) = rb[i]; }
        __syncthreads();
        for (int kt = 0; kt < nk; ++kt) {
            const int cur = kt & 1;
            if (kt + 1 < nk) {
                const int k0 = (kt + 1) * G_BK;
#pragma unroll
                for (int i = 0; i < 4; ++i) { const int c = tid + i * NTHREADS; ra[i] = *(const u32x4*)(A + (size_t)(bm0 + (c >> 3)) * K + k0 + (c & 7) * 8); }
#pragma unroll
                for (int i = 0; i < 2; ++i) { const int c = tid + i * NTHREADS; rb[i] = *(const u32x4*)(Bt + (size_t)(bn0 + (c >> 3)) * K + k0 + (c & 7) * 8); }
            }
            const unsigned char* sa = smem + cur * G_STAGE + (wm * 64 + r) * G_LDS_ROW + h * 16;
            const unsigned char* sb = smem + cur * G_STAGE + G_A_BYTES + (wn * 64 + r) * G_LDS_ROW + h * 16;
#pragma unroll
            for (int ks = 0; ks < 4; ++ks) {
                bf16x8 af[2], bfr[2];
                af[0] = *(const bf16x8*)(sa + ks * 32); af[1] = *(const bf16x8*)(sa + 32 * G_LDS_ROW + ks * 32);
                bfr[0] = *(const bf16x8*)(sb + ks * 32); bfr[1] = *(const bf16x8*)(sb + 32 * G_LDS_ROW + ks * 32);
#pragma unroll
                for (int mi = 0; mi < 2; ++mi)
#pragma unroll
                    for (int ni = 0; ni < 2; ++ni) acc[mi][ni] = MFMA32(af[mi], bfr[ni], acc[mi][ni]);
            }
            if (kt + 1 < nk) {
                unsigned char* st = smem + (cur ^ 1) * G_STAGE;
#pragma unroll
                for (int i = 0; i < 4; ++i) { const int c = tid + i * NTHREADS; *(u32x4*)(st + (c >> 3) * G_LDS_ROW + (c & 7) * 16) = ra[i]; }
#pragma unroll
                for (int i = 0; i < 2; ++i) { const int c = tid + i * NTHREADS; *(u32x4*)(st + G_A_BYTES + (c >> 3) * G_LDS_ROW + (c & 7) * 16) = rb[i]; }
            }
            __syncthreads();
        }
        gemm_epilogue<EPI>(p, acc, bm0 + wm * 64, bn0 + wn * 64, N, C, lane);
    }
}

constexpr int P8_BM = 256, P8_BK = 64, P8_HALF = 128, P8_HT = P8_HALF * P8_BK;
DI int lds_byte(int r, int c) { const int st = (r >> 4) * 2 + (c >> 5), rr = r & 15, cc = c & 31, ob = rr * 64 + cc * 2; return st * 1024 + (ob ^ (((ob >> 9) & 1) << 5)); }
DI void stage_rc(int b, int& R, int& C) { const int st = b / 1024, sb = b % 1024, swz = sb ^ (((sb >> 9) & 1) << 5); R = (st >> 1) * 16 + swz / 64; C = (st & 1) * 32 + (swz % 64) / 2; }
typedef __attribute__((address_space(3))) unsigned char lds_u8;

template <int EPI>
DI void gemm8_epilogue(const Params& p, const f32x4 (&acc)[2][2][4][2], int brow, int bcol, int N, void* Cv, int wr, int wc, int fr, int fq) {
    if (EPI == EPI_F32) {
        float* C = (float*)Cv;
#pragma unroll
        for (int ai = 0; ai < 2; ++ai)
#pragma unroll
            for (int m = 0; m < 4; ++m) {
                float* rp = C + (size_t)(brow + ai * 128 + wr * 64 + m * 16 + fr) * N + bcol + wc * 32 + fq * 4;
#pragma unroll
                for (int bj = 0; bj < 2; ++bj)
#pragma unroll
                    for (int n = 0; n < 2; ++n) *(f32x4*)(rp + bj * 128 + n * 16) = acc[ai][bj][m][n];
            }
    } else if (EPI == EPI_BF16) {
        bf16_t* C = (bf16_t*)Cv;
#pragma unroll
        for (int ai = 0; ai < 2; ++ai)
#pragma unroll
            for (int m = 0; m < 4; ++m) {
                bf16_t* rp = C + (size_t)(brow + ai * 128 + wr * 64 + m * 16 + fr) * N + bcol + wc * 32 + fq * 4;
#pragma unroll
                for (int bj = 0; bj < 2; ++bj)
#pragma unroll
                    for (int n = 0; n < 2; ++n) {
                        const f32x4 v = acc[ai][bj][m][n];
                        u32x2 o; o[0] = pk2(v[0], v[1]); o[1] = pk2(v[2], v[3]);
                        *(u32x2*)(rp + bj * 128 + n * 16) = o;
                    }
            }
    } else {
        bf16_t* C = (bf16_t*)Cv;
        const float* rope = (const float*)(p.ws + WS_ROPE);
        const int d0 = (wc & 1) * 16 + fq * 4;
#pragma unroll
        for (int bj = 0; bj < 2; ++bj) {
            const int hc = bcol + bj * 128 + (wc >> 1) * 64;
            const bool is_rope = hc < C_V, is_gelu = hc >= C_U;
            const float qs = (hc < C_K) ? 0.125f : 1.0f;
#pragma unroll
            for (int ai = 0; ai < 2; ++ai)
#pragma unroll
                for (int m = 0; m < 4; ++m) {
                    const int row = brow + ai * 128 + wr * 64 + m * 16 + fr;
                    f32x4 a = acc[ai][bj][m][0], b = acc[ai][bj][m][1];
                    if (is_rope) {
                        const int pos = row & (SEQ - 1);
                        const f32x4 t0 = *(const f32x4*)(rope + (pos * 32 + d0) * 2), t1 = *(const f32x4*)(rope + (pos * 32 + d0) * 2 + 4);
                        const float cs[4] = {t0[0], t0[2], t1[0], t1[2]}, sn[4] = {t0[1], t0[3], t1[1], t1[3]};
#pragma unroll
                        for (int j = 0; j < 4; ++j) { const float ra = a[j] * cs[j] - b[j] * sn[j], rb = b[j] * cs[j] + a[j] * sn[j]; a[j] = ra * qs; b[j] = rb * qs; }
                    } else if (is_gelu) {
#pragma unroll
                        for (int j = 0; j < 4; ++j) { a[j] = gelu_exact(a[j]); b[j] = gelu_exact(b[j]); }
                    }
                    bf16_t* rp = C + (size_t)row * N + hc + d0;
                    u32x2 oa, ob; oa[0] = pk2(a[0], a[1]); oa[1] = pk2(a[2], a[3]); ob[0] = pk2(b[0], b[1]); ob[1] = pk2(b[2], b[3]);
                    *(u32x2*)(rp) = oa; *(u32x2*)(rp + 32) = ob;
                }
        }
    }
}

template <int EPI>
DI void gemm8_phase(const Params& p, const bf16_t* A, const bf16_t* Bt, int M, int N, int K, void* C, unsigned char* smem) {
    lds_u8* shm = (lds_u8*)smem;
#define SA(b, h) (shm + (((b) * 2 + (h)) * P8_HT) * 2)
#define SB(b, h) (shm + ((4 + (b) * 2 + (h)) * P8_HT) * 2)
#define STAGE(P, BASE, br, kt) do { const char* _sb = (const char*)(BASE) + ((long)(br) * K + (long)(kt) * P8_BK) * 2; \
      __builtin_amdgcn_global_load_lds((const unsigned*)(_sb + voff0), (__attribute__((address_space(3))) unsigned*)((P) + wbase), 16, 0, 0); \
      __builtin_amdgcn_global_load_lds((const unsigned*)(_sb + voff1), (__attribute__((address_space(3))) unsigned*)((P) + wbase + 8192), 16, 0, 0); } while (0)
#define LDA(dst, b, h) _Pragma("unroll") for (int m = 0; m < 4; ++m) _Pragma("unroll") for (int k = 0; k < 2; ++k) \
    dst[m][k] = *reinterpret_cast<const __attribute__((address_space(3))) bf16x8*>(SA(b, h) + lds_byte(wr * 64 + m * 16 + fr, k * 32 + fq * 8))
#define LDB(dst, b, h) _Pragma("unroll") for (int n = 0; n < 2; ++n) _Pragma("unroll") for (int k = 0; k < 2; ++k) \
    dst[n][k] = *reinterpret_cast<const __attribute__((address_space(3))) bf16x8*>(SB(b, h) + lds_byte(wc * 32 + n * 16 + fr, k * 32 + fq * 8))
#define MMA(ai, bj, At_, Bt_) do { __builtin_amdgcn_s_setprio(1); \
    _Pragma("unroll") for (int m = 0; m < 4; ++m) _Pragma("unroll") for (int n = 0; n < 2; ++n) _Pragma("unroll") for (int k = 0; k < 2; ++k) \
      acc[ai][bj][m][n] = __builtin_amdgcn_mfma_f32_16x16x32_bf16(Bt_[n][k], At_[m][k], acc[ai][bj][m][n], 0, 0, 0); \
    __builtin_amdgcn_s_setprio(0); } while (0)
#define WAIT_V(n) asm volatile("s_waitcnt vmcnt(" #n ")" ::: "memory")
#define WAIT_L(n) asm volatile("s_waitcnt lgkmcnt(" #n ")" ::: "memory")
#define BAR __builtin_amdgcn_s_barrier()
#define SCHED __builtin_amdgcn_sched_barrier(0)
    const int nM = M / P8_BM, nN = N / P8_BM, nwg = nM * nN, G = gridDim.x;
    const int tid = opaque_tid();
    const int wid = tid >> 6, lane = tid & 63, wr = wid >> 2, wc = wid & 3, fr = lane & 15, fq = lane >> 4;
    const int nt = K / P8_BK;
    unsigned voff0, voff1;
    const int wbase = __builtin_amdgcn_readfirstlane(tid >> 6) * 1024;
    { int r_, c_; stage_rc(tid * 16, r_, c_); voff0 = (unsigned)(r_ * K + c_) * 2u; stage_rc(tid * 16 + 8192, r_, c_); voff1 = (unsigned)(r_ * K + c_) * 2u; }
    for (int round = 0;; ++round) {
        const long L = (long)round * G + blockIdx.x;
        if (L >= nwg) break;
        int wgid = (int)L;
        { const int q = nwg / 8, r = nwg % 8, xcd = wgid % 8, off = wgid / 8; wgid = (xcd < r ? xcd * (q + 1) : r * (q + 1) + (xcd - r) * q) + off; }
        const int nig = 8 * nN, gid = wgid / nig, fm = gid * 8, gsz = (nM - fm) < 8 ? (nM - fm) : 8;
        const int pm = fm + ((wgid % nig) % gsz), pn = (wgid % nig) / gsz, brow = pm * P8_BM, bcol = pn * P8_BM;
        f32x4 acc[2][2][4][2];
#pragma unroll
        for (int a = 0; a < 2; ++a)
#pragma unroll
            for (int b = 0; b < 2; ++b)
#pragma unroll
                for (int m = 0; m < 4; ++m)
#pragma unroll
                    for (int n = 0; n < 2; ++n) acc[a][b][m][n] = (f32x4){0.f, 0.f, 0.f, 0.f};
        bf16x8 At[4][2], B0[2][2], B1[2][2];
        STAGE(SB(0, 0), Bt, bcol, 0); STAGE(SA(0, 0), A, brow, 0);
        STAGE(SB(0, 1), Bt, bcol + P8_HALF, 0); STAGE(SA(0, 1), A, brow + P8_HALF, 0);
        if (wr == 1) BAR;
        WAIT_V(4); BAR;
        STAGE(SB(1, 0), Bt, bcol, 1); STAGE(SA(1, 0), A, brow, 1); STAGE(SB(1, 1), Bt, bcol + P8_HALF, 1);
        WAIT_V(6); BAR;
        for (int t = 0; t < nt - 2; t += 2) {
            LDB(B0, 0, 0); SCHED; LDA(At, 0, 0); STAGE(SA(1, 1), A, brow + P8_HALF, t + 1);
            WAIT_L(8); BAR; WAIT_L(0); MMA(0, 0, At, B0); BAR; SCHED;
            LDB(B1, 0, 1); STAGE(SB(0, 0), Bt, bcol, t + 2);
            BAR; WAIT_L(0); MMA(0, 1, At, B1); BAR;
            LDA(At, 0, 1); STAGE(SA(0, 0), A, brow, t + 2);
            BAR; WAIT_L(0); MMA(1, 0, At, B0); BAR; SCHED;
            STAGE(SB(0, 1), Bt, bcol + P8_HALF, t + 2);
            WAIT_V(6); BAR; MMA(1, 1, At, B1); BAR;
            LDB(B0, 1, 0); SCHED; LDA(At, 1, 0); STAGE(SA(0, 1), A, brow + P8_HALF, t + 2);
            WAIT_L(8); BAR; WAIT_L(0); MMA(0, 0, At, B0); BAR; SCHED;
            LDB(B1, 1, 1); STAGE(SB(1, 0), Bt, bcol, t + 3);
            BAR; WAIT_L(0); MMA(0, 1, At, B1); BAR;
            LDA(At, 1, 1); STAGE(SA(1, 0), A, brow, t + 3);
            BAR; WAIT_L(0); MMA(1, 0, At, B0); BAR; SCHED;
            STAGE(SB(1, 1), Bt, bcol + P8_HALF, t + 3);
            WAIT_V(6); BAR; MMA(1, 1, At, B1); BAR;
        }
        { LDB(B0, 0, 0); LDA(At, 0, 0); STAGE(SA(1, 1), A, brow + P8_HALF, nt - 1);
          BAR; WAIT_L(0); MMA(0, 0, At, B0); BAR;
          LDB(B1, 0, 1); BAR; WAIT_L(0); MMA(0, 1, At, B1); BAR;
          LDA(At, 0, 1); WAIT_V(4); BAR; WAIT_L(0); MMA(1, 0, At, B0); MMA(1, 1, At, B1); BAR; }
        { LDB(B0, 1, 0); LDA(At, 1, 0); WAIT_V(2); BAR; WAIT_L(0); MMA(0, 0, At, B0); BAR;
          LDB(B1, 1, 1); WAIT_V(0); BAR; WAIT_L(0); MMA(0, 1, At, B1); BAR;
          LDA(At, 1, 1); BAR; WAIT_L(0); MMA(1, 0, At, B0); MMA(1, 1, At, B1); BAR; }
        if (wr == 0) BAR;
        gemm8_epilogue<EPI>(p, acc, brow, bcol, N, C, wr, wc, fr, fq);
    }
#undef SA
#undef SB
#undef STAGE
#undef LDA
#undef LDB
#undef MMA
}

constexpr int A_KROW = 144;
constexpr int A_VROW = 520;
constexpr int A_KS = 0;
constexpr int A_VT = 2 * 256 * A_KROW;
constexpr int S_VROW = 272;
constexpr int A_RED = 140288;
constexpr int A_LDS = A_RED + 2 * 8 * 32 * 4;

DI void head_norm_store(const f32x16 (&o)[2], const float* gvec, bf16_t* yrow, float* red, int w, int lane) {
    const int r = lane & 31, h = lane >> 5;
    float ss = 0.f;
#pragma unroll
    for (int dt = 0; dt < 2; ++dt)
#pragma unroll
        for (int i = 0; i < 16; ++i) ss += o[dt][i] * o[dt][i];
    ss += __shfl_xor(ss, 32);
    if (lane < 32) red[w * 32 + r] = ss;
    __syncthreads();
    float tot = 0.f;
#pragma unroll
    for (int ww = 0; ww < 8; ++ww) tot += red[ww * 32 + r];
    const float rstd = rsqrtf(tot * (1.0f / 512.0f) + EPS);
#pragma unroll
    for (int dt = 0; dt < 2; ++dt)
#pragma unroll
        for (int g4 = 0; g4 < 4; ++g4) {
            const int d = dt * 32 + 8 * g4 + 4 * h;
            const f32x4 gv = *(const f32x4*)(gvec + d);
            u32x2 pk;
            pk[0] = pk2(o[dt][4 * g4 + 0] * rstd * gv[0], o[dt][4 * g4 + 1] * rstd * gv[1]);
            pk[1] = pk2(o[dt][4 * g4 + 2] * rstd * gv[2], o[dt][4 * g4 + 3] * rstd * gv[3]);
            *(u32x2*)(yrow + d) = pk;
        }
}

DI bf16x8 pack8(const f32x16& x, int s) {
    u32x4 q;
    q[0] = pk2(x[8 * s + 0], x[8 * s + 1]); q[1] = pk2(x[8 * s + 2], x[8 * s + 3]);
    q[2] = pk2(x[8 * s + 4], x[8 * s + 5]); q[3] = pk2(x[8 * s + 6], x[8 * s + 7]);
    return __builtin_bit_cast(bf16x8, q);
}

DI void phase3(const Params& p, unsigned char* smem) {
    const int tid = opaque_tid(), w = tid >> 6, lane = tid & 63, r = lane & 31, h = lane >> 5;
    const bf16_t* proj = (const bf16_t*)(p.ws + WS_PROJ);
    const bf16_t* wsb = (const bf16_t*)(p.ws + WS_WS);
    bf16_t* yin = (bf16_t*)(p.ws + WS_YIN);
    float* red = (float*)(smem + A_RED);
    for (int item = blockIdx.x; item < NB * 16; item += gridDim.x) {
        const int nblk = item & 15;
        const int tok0 = item * 128;
        for (int c = tid; c < 2 * 256 * 8; c += NTHREADS) {
            const int g = c >> 11, key = (c >> 3) & 255, kc = c & 7;
            u32x4 kv = {0u, 0u, 0u, 0u}, vv = {0u, 0u, 0u, 0u};
            if (nblk > 0 || key >= 128) {
                const size_t base = (size_t)(tok0 - 128 + key) * INC + g * 64 + kc * 8;
                kv = *(const u32x4*)(proj + base + C_K);
                vv = *(const u32x4*)(proj + base + C_V);
            }
            *(u32x4*)(smem + A_KS + (g * 256 + key) * A_KROW + kc * 16) = kv;
            bf16_t* vt = (bf16_t*)(smem + A_VT + (g * 64 + kc * 8) * A_VROW) + key;
#pragma unroll
            for (int i = 0; i < 4; ++i) {
                vt[(2 * i) * (A_VROW / 2)] = (bf16_t)(vv[i] & 0xffffu);
                vt[(2 * i + 1) * (A_VROW / 2)] = (bf16_t)(vv[i] >> 16);
            }
        }
        __syncthreads();
        {
            const int g = w >> 2;
            const float sink = p.sinks[w];
            const unsigned char* kbase = smem + A_KS + (g * 256) * A_KROW;
            const unsigned char* vbase = smem + A_VT + (g * 64) * A_VROW;
            for (int qt = 0; qt < 4; ++qt) {
                const int tq = tok0 + qt * 32 + r;
                bf16x8 bq[4];
#pragma unroll
                for (int s = 0; s < 4; ++s) bq[s] = *(const bf16x8*)(proj + (size_t)tq * INC + w * 64 + s * 16 + h * 8);
                f32x16 sacc[5];
#pragma unroll
                for (int kt = 0; kt < 5; ++kt) {
#pragma unroll
                    for (int i = 0; i < 16; ++i) sacc[kt][i] = 0.f;
                    const unsigned char* kp = kbase + (qt * 32 + kt * 32 + r) * A_KROW + h * 16;
#pragma unroll
                    for (int s = 0; s < 4; ++s) {
                        const bf16x8 ka = *(const bf16x8*)(kp + s * 32);
                        sacc[kt] = MFMA32(ka, bq[s], sacc[kt]);
                    }
                }
                float mx = -INFINITY;
#pragma unroll
                for (int kt = 0; kt < 5; ++kt)
#pragma unroll
                    for (int i = 0; i < 16; ++i) {
                        const int diff = kt * 32 + crow(i, h) - r;
                        bool valid = (diff >= 1) && (diff <= 128);
                        if (nblk == 0) valid = valid && (qt * 32 + kt * 32 + crow(i, h) >= 128);
                        const float sv = valid ? sacc[kt][i] : -INFINITY;
                        sacc[kt][i] = sv;
                        mx = fmaxf(mx, sv);
                    }
                mx = fmaxf(mx, __shfl_xor(mx, 32));
                mx = fmaxf(mx, sink);
                float lsum = 0.f;
#pragma unroll
                for (int kt = 0; kt < 5; ++kt)
#pragma unroll
                    for (int i = 0; i < 16; ++i) { const float e = __expf(sacc[kt][i] - mx); sacc[kt][i] = e; lsum += e; }
                lsum += __shfl_xor(lsum, 32);
                lsum += __expf(sink - mx);
                const float inv_l = 1.0f / lsum;
                f32x16 o[2];
#pragma unroll
                for (int dt = 0; dt < 2; ++dt)
#pragma unroll
                    for (int i = 0; i < 16; ++i) o[dt][i] = 0.f;
#pragma unroll
                for (int kt = 0; kt < 5; ++kt)
#pragma unroll
                    for (int s = 0; s < 2; ++s) {
                        const bf16x8 pb = pack8(sacc[kt], s);
                        const int key0 = qt * 32 + kt * 32 + 16 * s + 4 * h;
#pragma unroll
                        for (int dt = 0; dt < 2; ++dt) {
                            const unsigned char* vp = vbase + (dt * 32 + r) * A_VROW + key0 * 2;
                            const s16x4 lo = *(const s16x4*)(vp), hi = *(const s16x4*)(vp + 16);
                            const bf16x8 va = __builtin_shufflevector(lo, hi, 0, 1, 2, 3, 4, 5, 6, 7);
                            o[dt] = MFMA32(va, pb, o[dt]);
                        }
                    }
#pragma unroll
                for (int dt = 0; dt < 2; ++dt)
#pragma unroll
                    for (int i = 0; i < 16; ++i) o[dt][i] *= inv_l;
                head_norm_store(o, p.g_att_out + w * 64, yin + (size_t)tq * DM + w * 64, red + (qt & 1) * 256, w, lane);
            }
        }
        __syncthreads();
        for (int rr = tid; rr < 128 * 8; rr += NTHREADS) {
            const int s = rr >> 3, hs = rr & 7;
            const bf16_t* src = proj + (size_t)(tok0 + s) * INC + C_VS + hs * 64;
            float v[64];
#pragma unroll
            for (int c = 0; c < 8; ++c) {
                const u32x4 q = *(const u32x4*)(src + c * 8);
#pragma unroll
                for (int i = 0; i < 4; ++i) { v[c * 8 + 2 * i] = bflo(q[i]); v[c * 8 + 2 * i + 1] = bfhi(q[i]); }
            }
            float mu = 0.f;
#pragma unroll
            for (int i = 0; i < 64; ++i) mu += v[i];
            mu *= (1.0f / 64.0f);
            float var = 0.f;
#pragma unroll
            for (int i = 0; i < 64; ++i) { const float d = v[i] - mu; var += d * d; }
            const float rstd = rsqrtf(var * (1.0f / 64.0f) + EPS);
            bf16_t* dst = (bf16_t*)(smem + (hs * 64) * S_VROW) + s;
#pragma unroll
            for (int i = 0; i < 64; ++i) {
                const float yv = (v[i] - mu) * rstd * p.sgu_ln_g[hs * 64 + i] + p.sgu_ln_b[hs * 64 + i];
                dst[i * (S_VROW / 2)] = f2bf(yv);
            }
        }
        __syncthreads();
        {
            const unsigned char* vb = smem + (w * 64) * S_VROW;
            for (int tt = 0; tt < 4; ++tt) {
                const int tl = tt * 32 + r;
                f32x16 o[2];
#pragma unroll
                for (int dt = 0; dt < 2; ++dt)
#pragma unroll
                    for (int i = 0; i < 16; ++i) o[dt][i] = 0.f;
                const bf16_t* wrow = wsb + (size_t)(w * 128 + tl) * 128 + h * 8;
                const int nks = 2 * (tt + 1);
                for (int ks = 0; ks < nks; ++ks) {
                    const bf16x8 wb = *(const bf16x8*)(wrow + ks * 16);
#pragma unroll
                    for (int dt = 0; dt < 2; ++dt) {
                        const bf16x8 va = *(const bf16x8*)(vb + (dt * 32 + r) * S_VROW + (ks * 16 + h * 8) * 2);
                        o[dt] = MFMA32(va, wb, o[dt]);
                    }
                }
                const float bias = p.b_s[w * 128 + tl];
                const bf16_t* urow = proj + (size_t)(tok0 + tl) * INC + C_U + w * 64;
#pragma unroll
                for (int dt = 0; dt < 2; ++dt)
#pragma unroll
                    for (int g4 = 0; g4 < 4; ++g4) {
                        const u32x2 uu = *(const u32x2*)(urow + dt * 32 + 8 * g4 + 4 * h);
                        o[dt][4 * g4 + 0] = (o[dt][4 * g4 + 0] + bias) * bflo(uu[0]);
                        o[dt][4 * g4 + 1] = (o[dt][4 * g4 + 1] + bias) * bfhi(uu[0]);
                        o[dt][4 * g4 + 2] = (o[dt][4 * g4 + 2] + bias) * bflo(uu[1]);
                        o[dt][4 * g4 + 3] = (o[dt][4 * g4 + 3] + bias) * bfhi(uu[1]);
                    }
                head_norm_store(o, p.g_sgu_out + w * 64, yin + (size_t)(tok0 + tl) * DM + 512 + w * 64, red + (tt & 1) * 256, w, lane);
            }
        }
        __syncthreads();
    }
}

DI int f2key(float f) { const int b = __float_as_int(f); return b ^ ((b >> 31) & 0x7fffffff); }
DI float key2f(int k) { return __int_as_float(k ^ ((k >> 31) & 0x7fffffff)); }

DI void phase7(const Params& p) {
    const float* scT = (const float*)(p.ws + WS_SCT);
    int* ids = (int*)(p.ws + WS_IDS);
    float* gates = (float*)(p.ws + WS_GATES);
    const int gsz = gridDim.x * NTHREADS;
    for (int idx = blockIdx.x * NTHREADS + opaque_tid(); idx < T * PH; idx += gsz) {
        const int tok = idx & (T - 1), hd = idx >> 16;
        int a0[16], a1[16];
#pragma unroll
        for (int i = 0; i < 16; ++i) { a0[i] = INT_MIN; a1[i] = INT_MIN; }
        const float* s0 = scT + (size_t)(hd * 256) * T + tok;
        const float* s1 = s0 + (size_t)128 * T;
#pragma unroll 8
        for (int n = 0; n < 128; ++n) {
            int v0 = (f2key(s0[(size_t)n * T]) & ~127) | (127 - n);
            int v1 = (f2key(s1[(size_t)n * T]) & ~127) | (127 - n);
#pragma unroll
            for (int i = 0; i < 16; ++i) {
                const int m0 = max(a0[i], v0); v0 = min(a0[i], v0); a0[i] = m0;
                const int m1 = max(a1[i], v1); v1 = min(a1[i], v1); a1[i] = m1;
            }
        }
        float ts[16]; int tp[16];
#pragma unroll
        for (int i = 0; i < 16; ++i) { ts[i] = -INFINITY; tp[i] = 0; }
#pragma unroll
        for (int i = 0; i < 16; ++i) {
            const float vi = key2f(a0[i] & ~127);
            const int ni = 127 - (a0[i] & 127);
#pragma unroll
            for (int j = 0; j < 16; ++j) {
                if ((i + 1) * (j + 1) <= 16) {
                    float v = vi + key2f(a1[j] & ~127);
                    int pl = ni * 128 + (127 - (a1[j] & 127));
#pragma unroll
                    for (int k = 0; k < 16; ++k) {
                        const bool gt = v > ts[k];
                        const float nv = gt ? ts[k] : v; const int np = gt ? tp[k] : pl;
                        ts[k] = gt ? v : ts[k]; tp[k] = gt ? pl : tp[k];
                        v = nv; pl = np;
                    }
                }
            }
        }
        float e[16], sum = 0.f;
#pragma unroll
        for (int k = 0; k < 16; ++k) { e[k] = __expf(ts[k] - ts[0]); sum += e[k]; }
        const float inv = 1.0f / sum;
        int* ip = ids + (size_t)tok * 128 + hd * 16;
        float* gp = gates + (size_t)tok * 128 + hd * 16;
#pragma unroll
        for (int k4 = 0; k4 < 4; ++k4) {
            int4 iv = make_int4(tp[4 * k4], tp[4 * k4 + 1], tp[4 * k4 + 2], tp[4 * k4 + 3]);
            *(int4*)(ip + 4 * k4) = iv;
            f32x4 gv = {e[4 * k4] * inv, e[4 * k4 + 1] * inv, e[4 * k4 + 2] * inv, e[4 * k4 + 3] * inv};
            *(f32x4*)(gp + 4 * k4) = gv;
        }
    }
}

DI void load_rowP(const float* row, int lane, float (&v)[16]) {
#pragma unroll
    for (int j = 0; j < 4; ++j) { const f32x4 a = *(const f32x4*)(row + 256 * j + 4 * lane);
#pragma unroll
        for (int i = 0; i < 4; ++i) v[4 * j + i] = a[i]; }
}
DI void store_rowP(float* row, int lane, const float (&v)[16]) {
#pragma unroll
    for (int j = 0; j < 4; ++j) { f32x4 a;
#pragma unroll
        for (int i = 0; i < 4; ++i) a[i] = v[4 * j + i];
        *(f32x4*)(row + 256 * j + 4 * lane) = a; }
}
DI void phase8(const Params& p, unsigned char* smem) {
    const int tid = opaque_tid(), w = tid >> 6, lane = tid & 63;
    const int gw = blockIdx.x * NWAVES + w, NW = gridDim.x * NWAVES;
    const bf16_t* hb = (const bf16_t*)(p.ws + WS_H);
    const unsigned char* ed = p.ws + WS_ED;
    const unsigned char* eu = p.ws + WS_EU;
    const float* scd = (const float*)(p.ws + WS_SCD);
    const float* scu = (const float*)(p.ws + WS_SCU);
    const int* ids = (const int*)(p.ws + WS_IDS);
    const float* gates = (const float*)(p.ws + WS_GATES);
    const float* mod = (const float*)(p.ws + WS_MOD);
    float* s_cf = (float*)(smem + w * 512);
    float gpost[16]; load_rowP(p.g_post_ffn, lane, gpost);
    for (int t = gw; t < T; t += NW) {
        const int b = t >> 11;
        f32x2 h2[8];
#pragma unroll
        for (int j = 0; j < 4; ++j) {
            const u32x2 a = *(const u32x2*)(hb + (size_t)t * DM + 256 * j + 4 * lane);
            h2[2 * j] = (f32x2){bflo(a[0]), bfhi(a[0])}; h2[2 * j + 1] = (f32x2){bflo(a[1]), bfhi(a[1])};
        }
        const int id_lo = ids[(size_t)t * 128 + lane], id_hi = ids[(size_t)t * 128 + 64 + lane];
        for (int g16 = 0; g16 < 8; ++g16) {
            u32x4 rows[16];
            const int idv = (g16 < 4) ? id_lo : id_hi;
#pragma unroll
            for (int j = 0; j < 16; ++j) {
                const int e = __builtin_amdgcn_readlane(idv, (g16 & 3) * 16 + j);
                rows[j] = *(const u32x4*)(ed + (size_t)e * DM + 16 * lane);
            }
#pragma unroll
            for (int hf = 0; hf < 2; ++hf) {
                float part[8];
#pragma unroll
                for (int j = 0; j < 8; ++j) {
                    f32x2 a = {0.f, 0.f};
#pragma unroll
                    for (int q = 0; q < 4; ++q) {
                        const f32x2 lo = __builtin_amdgcn_cvt_pk_f32_fp8(rows[hf * 8 + j][q], false);
                        const f32x2 hi = __builtin_amdgcn_cvt_pk_f32_fp8(rows[hf * 8 + j][q], true);
                        a = __builtin_elementwise_fma(lo, h2[2 * q], a);
                        a = __builtin_elementwise_fma(hi, h2[2 * q + 1], a);
                    }
                    part[j] = a[0] + a[1];
                }
                float q4[4];
#pragma unroll
                for (int i = 0; i < 4; ++i) {
                    const bool up = (lane & 32) != 0;
                    const float send = up ? part[i] : part[i + 4];
                    const float keep = up ? part[i + 4] : part[i];
                    q4[i] = keep + __shfl_xor(send, 32);
                }
                float q2[2];
#pragma unroll
                for (int i = 0; i < 2; ++i) {
                    const bool up = (lane & 16) != 0;
                    const float send = up ? q4[i] : q4[i + 2];
                    const float keep = up ? q4[i + 2] : q4[i];
                    q2[i] = keep + __shfl_xor(send, 16);
                }
                float s1;
                {
                    const bool up = (lane & 8) != 0;
                    const float send = up ? q2[0] : q2[1];
                    const float keep = up ? q2[1] : q2[0];
                    s1 = keep + __shfl_xor(send, 8);
                }
                s1 += __shfl_xor(s1, 4); s1 += __shfl_xor(s1, 2); s1 += __shfl_xor(s1, 1);
                const int k = g16 * 16 + hf * 8 + (lane >> 3);
                const int ek = ids[(size_t)t * 128 + k];
                const float cf = gates[(size_t)t * 128 + k] * gelu_exact(s1 * scd[ek]) * scu[ek];
                if ((lane & 7) == 0) s_cf[k] = cf;
            }
        }
        const float cf_lo = s_cf[lane], cf_hi = s_cf[64 + lane];
        f32x2 acc[8];
#pragma unroll
        for (int i = 0; i < 8; ++i) acc[i] = (f32x2){0.f, 0.f};
        for (int g16 = 0; g16 < 8; ++g16) {
            u32x4 rows[16];
            const int idv = (g16 < 4) ? id_lo : id_hi;
            const float cfv = (g16 < 4) ? cf_lo : cf_hi;
#pragma unroll
            for (int j = 0; j < 16; ++j) {
                const int e = __builtin_amdgcn_readlane(idv, (g16 & 3) * 16 + j);
                rows[j] = *(const u32x4*)(eu + (size_t)e * DM + 16 * lane);
            }
#pragma unroll
            for (int j = 0; j < 16; ++j) {
                const float cf = __builtin_bit_cast(float, __builtin_amdgcn_readlane(__builtin_bit_cast(int, cfv), (g16 & 3) * 16 + j));
                const f32x2 cf2 = {cf, cf};
#pragma unroll
                for (int q = 0; q < 4; ++q) {
                    const f32x2 lo = __builtin_amdgcn_cvt_pk_f32_fp8(rows[j][q], false);
                    const f32x2 hi = __builtin_amdgcn_cvt_pk_f32_fp8(rows[j][q], true);
                    acc[2 * q] = __builtin_elementwise_fma(lo, cf2, acc[2 * q]);
                    acc[2 * q + 1] = __builtin_elementwise_fma(hi, cf2, acc[2 * q + 1]);
                }
            }
        }
        float y2[16];
#pragma unroll
        for (int q = 0; q < 4; ++q) { y2[4 * q] = acc[2 * q][0]; y2[4 * q + 1] = acc[2 * q][1]; y2[4 * q + 2] = acc[2 * q + 1][0]; y2[4 * q + 3] = acc[2 * q + 1][1]; }
        float ss = 0.f;
#pragma unroll
        for (int i = 0; i < 16; ++i) ss += y2[i] * y2[i];
        const float rstd = rsqrtf(wave_sum(ss) * (1.0f / DM) + EPS);
        float x1[16], gt[16];
        load_rowP(p.out + (size_t)t * DM, lane, x1);
        load_rowP(mod + b * 6144 + 5120, lane, gt);
        float o[16];
#pragma unroll
        for (int i = 0; i < 16; ++i) o[i] = x1[i] + gt[i] * (y2[i] * rstd * gpost[i]);
        store_rowP(p.out + (size_t)t * DM, lane, o);
    }
}

#define XB_TMO      128
#define XB_XCNT(j)  (256  + 64 * (j))
#define XB_XSUB(j)  (1280 + 64 * (j))
#define XB_XGEN(j)  (2304 + 64 * (j))
#define XB_TOP      3328
#define XB_TOPGEN   3392
#define XCD_BAR_WORDS 3456
#define XB_SPIN_CAP (1u << 22)
DI unsigned xb_ld(unsigned* p)              { return __hip_atomic_load(p, __ATOMIC_RELAXED, __HIP_MEMORY_SCOPE_AGENT); }
DI unsigned xb_add(unsigned* p, unsigned v) { return __hip_atomic_fetch_add(p, v, __ATOMIC_RELAXED, __HIP_MEMORY_SCOPE_AGENT); }
DI unsigned xb_xcc_id() { return (unsigned)__builtin_amdgcn_s_getreg((3 << 11) | 20) & 0xFu; }
#define XB_SPIN(cond, bar) do { unsigned _sp = 0; while (cond) { __builtin_amdgcn_s_sleep(1); \
    if ((++_sp & 255u) == 0u) { if (xb_ld(&(bar)[XB_TMO])) break; if (_sp > XB_SPIN_CAP) { atomicAdd(&(bar)[XB_TMO], 1u); break; } } } } while (0)
struct XcdBarrier { unsigned* bar; unsigned x; volatile unsigned* st; };
DI XcdBarrier xcd_barrier_post(unsigned* bar, volatile unsigned* st) {
    XcdBarrier b; b.bar = bar; b.x = xb_xcc_id(); b.st = st;
    if (threadIdx.x == 0) (void)xb_add(&bar[XB_XCNT(b.x)], 1u);
    return b;
}
DI void xcd_barrier_complete(unsigned* bar, unsigned x, unsigned& nloc, unsigned& nx) {
    const unsigned G = gridDim.x;
    unsigned sum, cnt, mine, sp = 0u;
    for (;;) {
        sum = 0u; cnt = 0u; mine = 0u;
#pragma unroll
        for (unsigned j = 0; j < 16; ++j) { const unsigned c = xb_ld(&bar[XB_XCNT(j)]); sum += c; cnt += (c > 0u) ? 1u : 0u; mine = (j == x) ? c : mine; }
        if (sum == G) break;
        __builtin_amdgcn_s_sleep(1);
        if ((++sp & 255u) == 0u) { if (xb_ld(&bar[XB_TMO])) break; if (sp > XB_SPIN_CAP) { atomicAdd(&bar[XB_TMO], 1u); break; } }
    }
    nloc = mine > 0u ? mine : 1u; nx = cnt > 0u ? cnt : 1u;
}
DI void xcd_barrier(const XcdBarrier& b) {
    asm volatile("s_waitcnt vmcnt(0)" ::: "memory");
    __syncthreads();
    if (threadIdx.x == 0) {
        unsigned* bar = b.bar;
        __builtin_amdgcn_s_waitcnt(0);
        unsigned nloc = b.st[0], nx = b.st[1];
        if (nloc == 0u) { xcd_barrier_complete(bar, b.x, nloc, nx); b.st[0] = nloc; b.st[1] = nx; }
        const unsigned old = xb_add(&bar[XB_XSUB(b.x)], 1u);
        const unsigned gen = old / nloc;
        if (old + 1u == (gen + 1u) * nloc) {
            __builtin_amdgcn_fence(__ATOMIC_RELEASE, "agent");
            asm volatile("s_waitcnt vmcnt(0)" ::: "memory");
            const unsigned og = xb_add(&bar[XB_TOP], 1u);
            const unsigned tg = og / nx;
            if (og + 1u == (tg + 1u) * nx) xb_add(&bar[XB_TOPGEN], 1u);
            else XB_SPIN(xb_ld(&bar[XB_TOPGEN]) == tg, bar);
            __builtin_amdgcn_fence(__ATOMIC_ACQUIRE, "agent");
            xb_add(&bar[XB_XGEN(b.x)], 1u);
            asm volatile("s_waitcnt vmcnt(0)" ::: "memory");
        } else {
            XB_SPIN(xb_ld(&bar[XB_XGEN(b.x)]) == gen, bar);
            __builtin_amdgcn_fence(__ATOMIC_ACQUIRE, "agent");
            asm volatile("s_waitcnt vmcnt(0)" ::: "memory");
        }
    }
    __syncthreads();
}

constexpr int LDS_BYTES = 147456;

template <int PHS>
DI void run_phase(const Params& p, unsigned char* smem) {
    if (PHS == 0) phase0(p, smem);
    else if (PHS == 1) phase1(p);
    else if (PHS == 2) gemm8_phase<EPI_PROJ>(p, (const bf16_t*)(p.ws + WS_H), (const bf16_t*)(p.ws + WS_WIN), T, INC, DM, p.ws + WS_PROJ, smem);
    else if (PHS == 3) phase3(p, smem);
    else if (PHS == 4) gemm8_phase<EPI_BF16>(p, (const bf16_t*)(p.ws + WS_YIN), (const bf16_t*)(p.ws + WS_WOUT), T, DM, DM, p.ws + WS_Y, smem);
    else if (PHS == 5) phase5(p);
    else if (PHS == 6) gemm8_phase<EPI_F32>(p, (const bf16_t*)(p.ws + WS_WQF), (const bf16_t*)(p.ws + WS_H), 2048, T, DM, p.ws + WS_SCT, smem);
    else if (PHS == 7) phase7(p);
    else if (PHS == 8) phase8(p, smem);
}

template <int PHS>
__global__ void __launch_bounds__(NTHREADS) k_phase(Params p) {
    __shared__ __attribute__((aligned(16))) unsigned char smem[LDS_BYTES];
    run_phase<PHS>(p, smem);
}

__global__ void __launch_bounds__(NTHREADS) k_mega(Params p) {
    __shared__ __attribute__((aligned(16))) unsigned char smem[LDS_BYTES];
    cg::grid_group grid = cg::this_grid();
    volatile unsigned* st = (volatile unsigned*)(smem + LDS_BYTES - 16);
    if (threadIdx.x == 0) { st[0] = 0u; st[1] = 0u; }
    __syncthreads();
    const XcdBarrier xb = xcd_barrier_post((unsigned*)(p.ws + WS_BAR), st);
#ifndef DUP_MASK
#define DUP_MASK 0
#endif
#define RUNP(k) do { run_phase<k>(p, smem); xcd_barrier(xb); if ((DUP_MASK >> k) & 1) { run_phase<k>(p, smem); xcd_barrier(xb); } } while (0)
    run_phase<0>(p, smem); grid.sync();
    RUNP(1); RUNP(2); RUNP(3); RUNP(4); RUNP(5); RUNP(6); RUNP(7);
    run_phase<8>(p, smem);
}

template <int PHS>
static void launch_phase(const Params& p, int grid, hipStream_t stream) {
    hipLaunchKernelGGL(k_phase<PHS>, dim3(grid), dim3(NTHREADS), 0, stream, p);
}

extern "C" void kernel_launch(void* const* d_in, const int* in_sizes, int n_in, void* d_out, int out_size, void* d_ws, size_t ws_size, hipStream_t stream) {
    if (n_in != 21 || out_size != T * DM || ws_size < WS_END) {
        fprintf(stderr, "kernel_launch: unexpected shapes (n_in %d out %d ws %zu need %zu)\n", n_in, out_size, ws_size, (size_t)WS_END);
        return;
    }
    Params p{};
    const float** f = (const float**)&p;
    for (int i = 0; i < 21; ++i) f[i] = (const float*)d_in[i];
    p.out = (float*)d_out; p.ws = (unsigned char*)d_ws;
#if MULTI_LAUNCH
    const int grid = 256;
    launch_phase<0>(p, grid, stream); launch_phase<1>(p, grid, stream); launch_phase<2>(p, grid, stream);
    launch_phase<3>(p, grid, stream); launch_phase<4>(p, grid, stream); launch_phase<5>(p, grid, stream);
    launch_phase<6>(p, grid, stream); launch_phase<7>(p, grid, stream); launch_phase<8>(p, grid, stream);
#else
    static int grid = 0;
    if (!grid) {
        int dev = 0, cus = 0, per_cu = 0;
        (void)hipGetDevice(&dev);
        (void)hipDeviceGetAttribute(&cus, hipDeviceAttributeMultiprocessorCount, dev);
        (void)hipOccupancyMaxActiveBlocksPerMultiprocessor(&per_cu, (const void*)k_mega, NTHREADS, 0);
        if (per_cu < 1) { fprintf(stderr, "kernel_launch: occupancy query says %d blocks per CU\n", per_cu); per_cu = 1; }
        grid = cus;
    }
    (void)hipMemsetAsync((unsigned char*)d_ws + WS_BAR, 0, WS_BAR_BYTES, stream);
    void* args[] = {&p};
    hipError_t e = hipLaunchCooperativeKernel((const void*)k_mega, dim3(grid), dim3(NTHREADS), args, 0, stream);
    if (e != hipSuccess) fprintf(stderr, "cooperative launch failed: %s (grid %d)\n", hipGetErrorString(e), grid);
#endif
}
```

```cpp
#include <hip/hip_runtime.h>
#include <hip/hip_cooperative_groups.h>
#include <stdint.h>
#include <stdio.h>
#include <limits.h>
namespace cg = cooperative_groups;

#ifndef MULTI_LAUNCH
#define MULTI_LAUNCH 0
#endif

#define DI __device__ __forceinline__
typedef unsigned short bf16_t;
typedef short bf16x8 __attribute__((ext_vector_type(8)));
typedef short s16x4 __attribute__((ext_vector_type(4)));
typedef float f32x16 __attribute__((ext_vector_type(16)));
typedef float f32x4 __attribute__((ext_vector_type(4)));
typedef unsigned u32x4 __attribute__((ext_vector_type(4)));
typedef unsigned u32x2 __attribute__((ext_vector_type(2)));

constexpr int DM = 1024, NB = 32, SEQ = 2048, T = NB * SEQ;
constexpr int HD = 64, QH = 8, KVH = 2, WIN = 128;
constexpr int INC = 1792;
constexpr int C_K = 512, C_V = 640, C_U = 768, C_VS = 1280;
constexpr int PH = 8, NKEYS = 128, TOPK = 16, NEXP = 16384;
constexpr float EPS = 1e-6f;
constexpr int NTHREADS = 512, NWAVES = 8;

constexpr size_t WS_MOD   = 0;
constexpr size_t WS_ROPE  = WS_MOD + (size_t)NB * 6144 * 4;
constexpr size_t WS_WIN   = WS_ROPE + (size_t)SEQ * 32 * 8;
constexpr size_t WS_WOUT  = WS_WIN + (size_t)INC * DM * 2;
constexpr size_t WS_WQF   = WS_WOUT + (size_t)DM * DM * 2;
constexpr size_t WS_WS    = WS_WQF + (size_t)2048 * DM * 2;
constexpr size_t WS_ED    = WS_WS + (size_t)8 * 128 * 128 * 2;
constexpr size_t WS_EU    = WS_ED + (size_t)NEXP * DM;
constexpr size_t WS_SCD   = WS_EU + (size_t)NEXP * DM;
constexpr size_t WS_SCU   = WS_SCD + (size_t)NEXP * 4;
constexpr size_t WS_H     = WS_SCU + (size_t)NEXP * 4;
constexpr size_t WS_IDS   = WS_H + (size_t)T * DM * 2;
constexpr size_t WS_GATES = WS_IDS + (size_t)T * 128 * 4;
constexpr size_t WS_BIG   = WS_GATES + (size_t)T * 128 * 4;
constexpr size_t WS_PROJ  = WS_BIG;
constexpr size_t WS_YIN   = WS_PROJ + (size_t)T * INC * 2;
constexpr size_t WS_Y     = WS_YIN + (size_t)T * DM * 2;
constexpr size_t WS_SCT   = WS_BIG;
constexpr size_t WS_BAR   = WS_BIG + (size_t)2048 * T * 4;
constexpr size_t WS_BAR_BYTES = 16384;
constexpr size_t WS_HQ    = WS_BAR + WS_BAR_BYTES;
constexpr size_t WS_HS    = WS_HQ + (size_t)T * DM;
constexpr size_t WS_END   = WS_HS + (size_t)T * 4;

struct Params {
    const float* x; const float* c; const float* w_ada; const float* b_ada;
    const float* g_pre_mix; const float* g_post_mix; const float* g_pre_ffn; const float* g_post_ffn;
    const float* w_in; const float* w_s; const float* b_s; const float* sgu_ln_g; const float* sgu_ln_b;
    const float* sinks; const float* g_att_out; const float* g_sgu_out; const float* w_out;
    const float* w_query; const float* sub_keys; const float* expert_down; const float* expert_up;
    float* out; unsigned char* ws;
};

DI float bf2f(unsigned short u) { return __uint_as_float(((unsigned)u) << 16); }
DI float bflo(unsigned w) { return __uint_as_float(w << 16); }
DI float bfhi(unsigned w) { return __uint_as_float(w & 0xffff0000u); }
typedef __bf16 bf2_t __attribute__((ext_vector_type(2)));
typedef float f32x2 __attribute__((ext_vector_type(2)));
DI unsigned pk2(float lo, float hi) { const f32x2 v = {lo, hi}; return __builtin_bit_cast(unsigned, __builtin_convertvector(v, bf2_t)); }
DI unsigned short f2bf(float x) { return __builtin_bit_cast(unsigned short, (__bf16)x); }
DI float wave_sum(float v) {
#pragma unroll
    for (int o = 1; o < 64; o <<= 1) v += __shfl_xor(v, o);
    return v;
}
DI float gelu_exact(float v) { return 0.5f * v * (1.0f + erff(v * 0.70710678118654752f)); }
DI int opaque_tid() { int t = threadIdx.x; asm volatile("" : "+v"(t)); return t; }
DI int crow(int i, int h) { return (i & 3) + 8 * (i >> 2) + 4 * h; }
#define MFMA32(a, b, c) __builtin_amdgcn_mfma_f32_32x32x16_bf16((a), (b), (c), 0, 0, 0)

DI void p0_mod_item(const Params& p, int item, unsigned char* smem) {
    float* sc = (float*)smem;
    const int tid = opaque_tid(), w = tid >> 6, lane = tid & 63;
    for (int idx = tid; idx < 32 * 1024; idx += NTHREADS) {
        const int k = idx >> 5, b = idx & 31;
        const float v = p.c[b * 1024 + k];
        sc[k * 32 + b] = v / (1.0f + expf(-v));
    }
    __syncthreads();
    const int col = item * 64 + lane;
    float acc[32];
#pragma unroll
    for (int b = 0; b < 32; ++b) acc[b] = 0.f;
    for (int kk = 0; kk < 128; ++kk) {
        const int k = w * 128 + kk;
        const float wv = p.w_ada[(size_t)k * 6144 + col];
        const f32x4* sp = (const f32x4*)(sc + k * 32);
#pragma unroll
        for (int b4 = 0; b4 < 8; ++b4) {
            const f32x4 s = sp[b4];
            acc[4 * b4 + 0] += s[0] * wv; acc[4 * b4 + 1] += s[1] * wv; acc[4 * b4 + 2] += s[2] * wv; acc[4 * b4 + 3] += s[3] * wv;
        }
    }
    __syncthreads();
    float* red = (float*)smem;
#pragma unroll
    for (int b = 0; b < 32; ++b) red[(w * 32 + b) * 64 + lane] = acc[b];
    __syncthreads();
    float* mod = (float*)(p.ws + WS_MOD);
    for (int idx = tid; idx < 32 * 64; idx += NTHREADS) {
        const int b = idx >> 6, l = idx & 63;
        float s = 0.f;
#pragma unroll
        for (int ww = 0; ww < 8; ++ww) s += red[(ww * 32 + b) * 64 + l];
        const int cc = item * 64 + l;
        mod[b * 6144 + cc] = s + p.b_ada[cc];
    }
    __syncthreads();
}

DI void p0_fold_item(const Params& p, int item, unsigned char* smem) {
    const int hp = item >> 5, nt = (item >> 4) & 1, jt = item & 15;
    const int n0 = nt * 64, j0 = jt * 64;
    float* sk = (float*)smem;
    float* wq = sk + 64 * 132;
    const int tid = opaque_tid();
    for (int idx = tid; idx < 64 * 32; idx += NTHREADS) {
        const int r = idx >> 5, c4 = idx & 31;
        const f32x4 a = *(const f32x4*)(p.sub_keys + ((size_t)(hp * 128 + n0 + r) * 128 + c4 * 4));
        *(f32x4*)(sk + r * 132 + c4 * 4) = a;
        const f32x4 b = *(const f32x4*)(p.w_query + ((size_t)(j0 + r) * 2048 + hp * 128 + c4 * 4));
        *(f32x4*)(wq + r * 132 + c4 * 4) = b;
    }
    __syncthreads();
    const int tn = tid & 15, tj = tid >> 4;
    float acc[4][2];
#pragma unroll
    for (int a = 0; a < 4; ++a) { acc[a][0] = 0.f; acc[a][1] = 0.f; }
    for (int d = 0; d < 128; d += 4) {
        f32x4 av[4], bv[2];
#pragma unroll
        for (int a = 0; a < 4; ++a) av[a] = *(const f32x4*)(sk + (tn * 4 + a) * 132 + d);
#pragma unroll
        for (int b = 0; b < 2; ++b) bv[b] = *(const f32x4*)(wq + (tj * 2 + b) * 132 + d);
#pragma unroll
        for (int a = 0; a < 4; ++a)
#pragma unroll
            for (int b = 0; b < 2; ++b)
                acc[a][b] += av[a][0] * bv[b][0] + av[a][1] * bv[b][1] + av[a][2] * bv[b][2] + av[a][3] * bv[b][3];
    }
    bf16_t* wf = (bf16_t*)(p.ws + WS_WQF);
#pragma unroll
    for (int a = 0; a < 4; ++a) {
        const size_t row = (size_t)(hp * 128 + n0 + tn * 4 + a);
        *(unsigned*)(wf + row * 1024 + j0 + tj * 2) = pk2(acc[a][0], acc[a][1]);
    }
    __syncthreads();
}

DI void p0_transpose_item(const float* W, int K, int N, bf16_t* WT, int item, unsigned char* smem, bool permute) {
    const int ntn = N / 64, kb = item / ntn, nb = item % ntn, k0 = kb * 64, n0 = nb * 64;
    float* tile = (float*)smem;
    const int tid = opaque_tid();
    for (int idx = tid; idx < 64 * 64; idx += NTHREADS) {
        const int k = idx >> 6, n = idx & 63;
        tile[k * 65 + n] = W[(size_t)(k0 + k) * N + n0 + n];
    }
    __syncthreads();
    {
        const int n = tid >> 3, k8 = tid & 7;
        const float* s = tile + (k8 * 8) * 65 + n;
        u32x4 o;
        o[0] = pk2(s[0 * 65], s[1 * 65]); o[1] = pk2(s[2 * 65], s[3 * 65]); o[2] = pk2(s[4 * 65], s[5 * 65]); o[3] = pk2(s[6 * 65], s[7 * 65]);
        int nr = n0 + n;
        if (permute) { const int blk = (nr >> 4) & 3; if (blk == 1) nr += 16; else if (blk == 2) nr -= 16; }
        *(u32x4*)(WT + (size_t)nr * K + k0 + k8 * 8) = o;
    }
    __syncthreads();
}

DI void phase0(const Params& p, unsigned char* smem) {
    const int bid = blockIdx.x, G = gridDim.x, tid = opaque_tid();
    for (int it = bid; it < 96; it += G) p0_mod_item(p, it, smem);
    for (int it = G - 1 - bid; it < 512; it += G) p0_fold_item(p, it, smem);
    for (int it = bid; it < 16 * 28; it += G) p0_transpose_item(p.w_in, 1024, INC, (bf16_t*)(p.ws + WS_WIN), it, smem, true);
    for (int it = bid; it < 16 * 16; it += G) p0_transpose_item(p.w_out, 1024, 1024, (bf16_t*)(p.ws + WS_WOUT), it, smem, false);
    {
        const int lane = tid & 63, gw = bid * NWAVES + (tid >> 6), NW = G * NWAVES;
        for (int rr = gw; rr < 2 * NEXP; rr += NW) {
            const int tb = rr >= NEXP, e = rr - tb * NEXP;
            const float* row = (tb ? p.expert_up : p.expert_down) + (size_t)e * DM;
            unsigned char* dst = p.ws + (tb ? WS_EU : WS_ED) + (size_t)e * DM;
            float* scl = (float*)(p.ws + (tb ? WS_SCU : WS_SCD));
            f32x4 v[4]; float am = 0.f;
#pragma unroll
            for (int j = 0; j < 4; ++j) { v[j] = tb ? *(const f32x4*)(row + 256 * j + 4 * lane) : *(const f32x4*)(row + 16 * lane + 4 * j);
#pragma unroll
                for (int i = 0; i < 4; ++i) am = fmaxf(am, fabsf(v[j][i])); }
#pragma unroll
            for (int o = 1; o < 64; o <<= 1) am = fmaxf(am, __shfl_xor(am, o));
            const float sc = am > 0.f ? am * (1.0f / 240.0f) : 1.0f, inv = 1.0f / sc;
            u32x4 o4;
#pragma unroll
            for (int j = 0; j < 4; ++j) {
                int wv = 0;
                wv = __builtin_amdgcn_cvt_pk_fp8_f32(v[j][0] * inv, v[j][1] * inv, wv, false);
                wv = __builtin_amdgcn_cvt_pk_fp8_f32(v[j][2] * inv, v[j][3] * inv, wv, true);
                o4[j] = (unsigned)wv;
            }
            *(u32x4*)(dst + 16 * lane) = o4;
            if (lane == 0) scl[e] = sc;
        }
    }
    {
        const int gt = bid * NTHREADS + tid, gsz = G * NTHREADS;
        float* rope = (float*)(p.ws + WS_ROPE);
        for (int i = gt; i < SEQ * 32; i += gsz) {
            const int pos = i >> 5, f = i & 31;
            const float inv = (float)pow(10000.0, -(double)f / 32.0);
            const float ang = (float)pos * inv;
            rope[2 * i] = (float)cos((double)ang); rope[2 * i + 1] = (float)sin((double)ang);
        }
        bf16_t* wsb = (bf16_t*)(p.ws + WS_WS);
        for (int i = gt; i < 8 * 128 * 128; i += gsz) {
            const int t = (i >> 7) & 127, s = i & 127;
            wsb[i] = (s <= t) ? f2bf(p.w_s[i]) : (bf16_t)0;
        }
    }
}

DI void load_row16(const float* row, int lane, float (&v)[16]) {
    const f32x4 a0 = *(const f32x4*)(row + lane * 8), a1 = *(const f32x4*)(row + lane * 8 + 4);
    const f32x4 b0 = *(const f32x4*)(row + 512 + lane * 8), b1 = *(const f32x4*)(row + 512 + lane * 8 + 4);
#pragma unroll
    for (int i = 0; i < 4; ++i) { v[i] = a0[i]; v[4 + i] = a1[i]; v[8 + i] = b0[i]; v[12 + i] = b1[i]; }
}
DI void load_row16_bf(const bf16_t* row, int lane, float (&v)[16]) {
    const u32x4 a = *(const u32x4*)(row + lane * 8), b = *(const u32x4*)(row + 512 + lane * 8);
#pragma unroll
    for (int i = 0; i < 4; ++i) { v[2 * i] = bflo(a[i]); v[2 * i + 1] = bfhi(a[i]); v[8 + 2 * i] = bflo(b[i]); v[8 + 2 * i + 1] = bfhi(b[i]); }
}
DI void store_row16_bf(bf16_t* row, int lane, const float (&v)[16]) {
    u32x4 a, b;
#pragma unroll
    for (int i = 0; i < 4; ++i) { a[i] = pk2(v[2 * i], v[2 * i + 1]); b[i] = pk2(v[8 + 2 * i], v[8 + 2 * i + 1]); }
    *(u32x4*)(row + lane * 8) = a; *(u32x4*)(row + 512 + lane * 8) = b;
}
DI void store_row16(float* row, int lane, const float (&v)[16]) {
    f32x4 a0, a1, b0, b1;
#pragma unroll
    for (int i = 0; i < 4; ++i) { a0[i] = v[i]; a1[i] = v[4 + i]; b0[i] = v[8 + i]; b1[i] = v[12 + i]; }
    *(f32x4*)(row + lane * 8) = a0; *(f32x4*)(row + lane * 8 + 4) = a1; *(f32x4*)(row + 512 + lane * 8) = b0; *(f32x4*)(row + 512 + lane * 8 + 4) = b1;
}

DI void phase1(const Params& p) {
    const int tid = opaque_tid(), lane = tid & 63, gw = blockIdx.x * NWAVES + (tid >> 6), NW = gridDim.x * NWAVES;
    const float* mod = (const float*)(p.ws + WS_MOD);
    bf16_t* h = (bf16_t*)(p.ws + WS_H);
    float g[16]; load_row16(p.g_pre_mix, lane, g);
    for (int t = gw; t < T; t += NW) {
        const int b = t >> 11;
        float v[16], sh[16], sc[16];
        load_row16(p.x + (size_t)t * DM, lane, v);
        load_row16(mod + b * 6144 + 0, lane, sh);
        load_row16(mod + b * 6144 + 1024, lane, sc);
        float ss = 0.f;
#pragma unroll
        for (int i = 0; i < 16; ++i) ss += v[i] * v[i];
        const float rstd = rsqrtf(wave_sum(ss) * (1.0f / DM) + EPS);
        float o[16];
#pragma unroll
        for (int i = 0; i < 16; ++i) o[i] = v[i] * rstd * g[i] * (1.0f + sc[i]) + sh[i];
        store_row16_bf(h + (size_t)t * DM, lane, o);
    }
}

DI void phase5(const Params& p) {
    const int tid = opaque_tid(), lane = tid & 63, gw = blockIdx.x * NWAVES + (tid >> 6), NW = gridDim.x * NWAVES;
    const float* mod = (const float*)(p.ws + WS_MOD);
    const bf16_t* y = (const bf16_t*)(p.ws + WS_Y);
    bf16_t* h = (bf16_t*)(p.ws + WS_H);
    float g1[16], g2[16]; load_row16(p.g_post_mix, lane, g1); load_row16(p.g_pre_ffn, lane, g2);
    for (int t = gw; t < T; t += NW) {
        const int b = t >> 11;
        float xv[16], yv[16], gt[16], sh[16], sc[16];
        load_row16(p.x + (size_t)t * DM, lane, xv);
        load_row16_bf(y + (size_t)t * DM, lane, yv);
        load_row16(mod + b * 6144 + 2048, lane, gt);
        load_row16(mod + b * 6144 + 3072, lane, sh);
        load_row16(mod + b * 6144 + 4096, lane, sc);
        float ss = 0.f;
#pragma unroll
        for (int i = 0; i < 16; ++i) ss += yv[i] * yv[i];
        const float rstd = rsqrtf(wave_sum(ss) * (1.0f / DM) + EPS);
        float x1[16]; float s1 = 0.f;
#pragma unroll
        for (int i = 0; i < 16; ++i) { x1[i] = xv[i] + gt[i] * (yv[i] * rstd * g1[i]); s1 += x1[i] * x1[i]; }
        store_row16(p.out + (size_t)t * DM, lane, x1);
        const float rstd1 = rsqrtf(wave_sum(s1) * (1.0f / DM) + EPS);
        float o[16];
#pragma unroll
        for (int i = 0; i < 16; ++i) o[i] = x1[i] * rstd1 * g2[i] * (1.0f + sc[i]) + sh[i];
        store_row16_bf(h + (size_t)t * DM, lane, o);
        float am = 0.f;
#pragma unroll
        for (int i = 0; i < 16; ++i) am = fmaxf(am, fabsf(o[i]));
#pragma unroll
        for (int of = 1; of < 64; of <<= 1) am = fmaxf(am, __shfl_xor(am, of));
        const float hsc = am > 0.f ? am * (1.0f / 240.0f) : 1.0f, hinv = 1.0f / hsc;
        u32x2 qa, qb; int wv;
        wv = 0; wv = __builtin_amdgcn_cvt_pk_fp8_f32(o[0] * hinv, o[1] * hinv, wv, false); wv = __builtin_amdgcn_cvt_pk_fp8_f32(o[2] * hinv, o[3] * hinv, wv, true); qa[0] = (unsigned)wv;
        wv = 0; wv = __builtin_amdgcn_cvt_pk_fp8_f32(o[4] * hinv, o[5] * hinv, wv, false); wv = __builtin_amdgcn_cvt_pk_fp8_f32(o[6] * hinv, o[7] * hinv, wv, true); qa[1] = (unsigned)wv;
        wv = 0; wv = __builtin_amdgcn_cvt_pk_fp8_f32(o[8] * hinv, o[9] * hinv, wv, false); wv = __builtin_amdgcn_cvt_pk_fp8_f32(o[10] * hinv, o[11] * hinv, wv, true); qb[0] = (unsigned)wv;
        wv = 0; wv = __builtin_amdgcn_cvt_pk_fp8_f32(o[12] * hinv, o[13] * hinv, wv, false); wv = __builtin_amdgcn_cvt_pk_fp8_f32(o[14] * hinv, o[15] * hinv, wv, true); qb[1] = (unsigned)wv;
        unsigned char* hq = p.ws + WS_HQ + (size_t)t * DM;
        *(u32x2*)(hq + lane * 8) = qa; *(u32x2*)(hq + 512 + lane * 8) = qb;
        if (lane == 0) ((float*)(p.ws + WS_HS))[t] = hsc;
    }
}

constexpr int G_BM = 256, G_BN = 128, G_BK = 64, G_LDS_ROW = 144;
constexpr int G_A_BYTES = G_BM * G_LDS_ROW, G_B_BYTES = G_BN * G_LDS_ROW, G_STAGE = G_A_BYTES + G_B_BYTES;
enum { EPI_PROJ = 0, EPI_BF16 = 1, EPI_F32 = 2 };

template <int EPI>
DI void gemm_epilogue(const Params& p, const f32x16 (&acc)[2][2], int m0, int n0, int N, void* Cv, int lane) {
    const int r = lane & 31, h = lane >> 5;
    if (EPI == EPI_F32) {
        float* C = (float*)Cv;
#pragma unroll
        for (int mi = 0; mi < 2; ++mi)
#pragma unroll
            for (int ni = 0; ni < 2; ++ni)
#pragma unroll
                for (int i = 0; i < 16; ++i) C[(size_t)(m0 + mi * 32 + crow(i, h)) * N + n0 + ni * 32 + r] = acc[mi][ni][i];
    } else if (EPI == EPI_BF16) {
        bf16_t* C = (bf16_t*)Cv;
#pragma unroll
        for (int mi = 0; mi < 2; ++mi)
#pragma unroll
            for (int ni = 0; ni < 2; ++ni)
#pragma unroll
                for (int i = 0; i < 16; ++i) C[(size_t)(m0 + mi * 32 + crow(i, h)) * N + n0 + ni * 32 + r] = f2bf(acc[mi][ni][i]);
    } else {
        bf16_t* C = (bf16_t*)Cv;
        const float* rope = (const float*)(p.ws + WS_ROPE);
        const bool is_rope = n0 < C_V, is_gelu = n0 >= C_U;
        const float qs = (n0 < C_K) ? 0.125f : 1.0f;
#pragma unroll
        for (int mi = 0; mi < 2; ++mi)
#pragma unroll
            for (int i = 0; i < 16; ++i) {
                const int row = m0 + mi * 32 + crow(i, h);
                float a = acc[mi][0][i], b = acc[mi][1][i];
                if (is_rope) {
                    const int pos = row & (SEQ - 1);
                    const float cs = rope[(pos * 32 + r) * 2], sn = rope[(pos * 32 + r) * 2 + 1];
                    const float ra = a * cs - b * sn, rb = b * cs + a * sn;
                    a = ra * qs; b = rb * qs;
                } else if (is_gelu) { a = gelu_exact(a); b = gelu_exact(b); }
                C[(size_t)row * N + n0 + r] = f2bf(a);
                C[(size_t)row * N + n0 + 32 + r] = f2bf(b);
            }
    }
}

template <int EPI, bool N_MAJOR>
DI void gemm_phase(const Params& p, const bf16_t* A, const bf16_t* Bt, int M, int N, int K, void* C, unsigned char* smem) {
    const int tid = threadIdx.x, w = tid >> 6, lane = tid & 63, r = lane & 31, h = lane >> 5;
    const int wm = w >> 1, wn = w & 1;
    const int nM = M / G_BM, nN = N / G_BN, total = nM * nN, G = gridDim.x;
    const int per = (total + G - 1) / G;
    int t_lo = blockIdx.x * per, t_hi = t_lo + per; if (t_hi > total) t_hi = total;
    const int nk = K / G_BK;
    for (int t = t_lo; t < t_hi; ++t) {
        int tm, tn;
        if (N_MAJOR) { tn = t / nM; tm = t % nM; } else { tm = t / nN; tn = t % nN; }
        const int bm0 = tm * G_BM, bn0 = tn * G_BN;
        f32x16 acc[2][2];
#pragma unroll
        for (int mi = 0; mi < 2; ++mi)
#pragma unroll
            for (int ni = 0; ni < 2; ++ni)
#pragma unroll
                for (int i = 0; i < 16; ++i) acc[mi][ni][i] = 0.f;
        u32x4 ra[4], rb[2];
#pragma unroll
        for (int i = 0; i < 4; ++i) { const int c = tid + i * NTHREADS; ra[i] = *(const u32x4*)(A + (size_t)(bm0 + (c >> 3)) * K + (c & 7) * 8); }
#pragma unroll
        for (int i = 0; i < 2; ++i) { const int c = tid + i * NTHREADS; rb[i] = *(const u32x4*)(Bt + (size_t)(bn0 + (c >> 3)) * K + (c & 7) * 8); }
#pragma unroll
        for (int i = 0; i < 4; ++i) { const int c = tid + i * NTHREADS; *(u32x4*)(smem + (c >> 3) * G_LDS_ROW + (c & 7) * 16) = ra[i]; }
#pragma unroll
        for (int i = 0; i < 2; ++i) { const int c = tid + i * NTHREADS; *(u32x4*)(smem + G_A_BYTES + (c >> 3) * G_LDS_ROW + (c & 7) * 16) = rb[i]; }
        __syncthreads();
        for (int kt = 0; kt < nk; ++kt) {
            const int cur = kt & 1;
            if (kt + 1 < nk) {
                const int k0 = (kt + 1) * G_BK;
#pragma unroll
                for (int i = 0; i < 4; ++i) { const int c = tid + i * NTHREADS; ra[i] = *(const u32x4*)(A + (size_t)(bm0 + (c >> 3)) * K + k0 + (c & 7) * 8); }
#pragma unroll
                for (int i = 0; i < 2; ++i) { const int c = tid + i * NTHREADS; rb[i] = *(const u32x4*)(Bt + (size_t)(bn0 + (c >> 3)) * K + k0 + (c & 7) * 8); }
            }
            const unsigned char* sa = smem + cur * G_STAGE + (wm * 64 + r) * G_LDS_ROW + h * 16;
            const unsigned char* sb = smem + cur * G_STAGE + G_A_BYTES + (wn * 64 + r) * G_LDS_ROW + h * 16;
#pragma unroll
            for (int ks = 0; ks < 4; ++ks) {
                bf16x8 af[2], bfr[2];
                af[0] = *(const bf16x8*)(sa + ks * 32); af[1] = *(const bf16x8*)(sa + 32 * G_LDS_ROW + ks * 32);
                bfr[0] = *(const bf16x8*)(sb + ks * 32); bfr[1] = *(const bf16x8*)(sb + 32 * G_LDS_ROW + ks * 32);
#pragma unroll
                for (int mi = 0; mi < 2; ++mi)
#pragma unroll
                    for (int ni = 0; ni < 2; ++ni) acc[mi][ni] = MFMA32(af[mi], bfr[ni], acc[mi][ni]);
            }
            if (kt + 1 < nk) {
                unsigned char* st = smem + (cur ^ 1) * G_STAGE;
#pragma unroll
                for (int i = 0; i < 4; ++i) { const int c = tid + i * NTHREADS; *(u32x4*)(st + (c >> 3) * G_LDS_ROW + (c & 7) * 16) = ra[i]; }
#pragma unroll
                for (int i = 0; i < 2; ++i) { const int c = tid + i * NTHREADS; *(u32x4*)(st + G_A_BYTES + (c >> 3) * G_LDS_ROW + (c & 7) * 16) = rb[i]; }
            }
            __syncthreads();
        }
        gemm_epilogue<EPI>(p, acc, bm0 + wm * 64, bn0 + wn * 64, N, C, lane);
    }
}

constexpr int P8_BM = 256, P8_BK = 64, P8_HALF = 128, P8_HT = P8_HALF * P8_BK;
DI int lds_byte(int r, int c) { const int st = (r >> 4) * 2 + (c >> 5), rr = r & 15, cc = c & 31, ob = rr * 64 + cc * 2; return st * 1024 + (ob ^ (((ob >> 9) & 1) << 5)); }
DI void stage_rc(int b, int& R, int& C) { const int st = b / 1024, sb = b % 1024, swz = sb ^ (((sb >> 9) & 1) << 5); R = (st >> 1) * 16 + swz / 64; C = (st & 1) * 32 + (swz % 64) / 2; }
typedef __attribute__((address_space(3))) unsigned char lds_u8;

template <int EPI>
DI void gemm8_epilogue(const Params& p, const f32x4 (&acc)[2][2][4][2], int brow, int bcol, int N, void* Cv, int wr, int wc, int fr, int fq) {
    if (EPI == EPI_F32) {
        float* C = (float*)Cv;
#pragma unroll
        for (int ai = 0; ai < 2; ++ai)
#pragma unroll
            for (int m = 0; m < 4; ++m) {
                float* rp = C + (size_t)(brow + ai * 128 + wr * 64 + m * 16 + fr) * N + bcol + wc * 32 + fq * 4;
#pragma unroll
                for (int bj = 0; bj < 2; ++bj)
#pragma unroll
                    for (int n = 0; n < 2; ++n) *(f32x4*)(rp + bj * 128 + n * 16) = acc[ai][bj][m][n];
            }
    } else if (EPI == EPI_BF16) {
        bf16_t* C = (bf16_t*)Cv;
#pragma unroll
        for (int ai = 0; ai < 2; ++ai)
#pragma unroll
            for (int m = 0; m < 4; ++m) {
                bf16_t* rp = C + (size_t)(brow + ai * 128 + wr * 64 + m * 16 + fr) * N + bcol + wc * 32 + fq * 4;
#pragma unroll
                for (int bj = 0; bj < 2; ++bj)
#pragma unroll
                    for (int n = 0; n < 2; ++n) {
                        const f32x4 v = acc[ai][bj][m][n];
                        u32x2 o; o[0] = pk2(v[0], v[1]); o[1] = pk2(v[2], v[3]);
                        *(u32x2*)(rp + bj * 128 + n * 16) = o;
                    }
            }
    } else {
        bf16_t* C = (bf16_t*)Cv;
        const float* rope = (const float*)(p.ws + WS_ROPE);
        const int d0 = (wc & 1) * 16 + fq * 4;
#pragma unroll
        for (int bj = 0; bj < 2; ++bj) {
            const int hc = bcol + bj * 128 + (wc >> 1) * 64;
            const bool is_rope = hc < C_V, is_gelu = hc >= C_U;
            const float qs = (hc < C_K) ? 0.125f : 1.0f;
#pragma unroll
            for (int ai = 0; ai < 2; ++ai)
#pragma unroll
                for (int m = 0; m < 4; ++m) {
                    const int row = brow + ai * 128 + wr * 64 + m * 16 + fr;
                    f32x4 a = acc[ai][bj][m][0], b = acc[ai][bj][m][1];
                    if (is_rope) {
                        const int pos = row & (SEQ - 1);
                        const f32x4 t0 = *(const f32x4*)(rope + (pos * 32 + d0) * 2), t1 = *(const f32x4*)(rope + (pos * 32 + d0) * 2 + 4);
                        const float cs[4] = {t0[0], t0[2], t1[0], t1[2]}, sn[4] = {t0[1], t0[3], t1[1], t1[3]};
#pragma unroll
                        for (int j = 0; j < 4; ++j) { const float ra = a[j] * cs[j] - b[j] * sn[j], rb = b[j] * cs[j] + a[j] * sn[j]; a[j] = ra * qs; b[j] = rb * qs; }
                    } else if (is_gelu) {
#pragma unroll
                        for (int j = 0; j < 4; ++j) { a[j] = gelu_exact(a[j]); b[j] = gelu_exact(b[j]); }
                    }
                    bf16_t* rp = C + (size_t)row * N + hc + d0;
                    u32x2 oa, ob; oa[0] = pk2(a[0], a[1]); oa[1] = pk2(a[2], a[3]); ob[0] = pk2(b[0], b[1]); ob[1] = pk2(b[2], b[3]);
                    *(u32x2*)(rp) = oa; *(u32x2*)(rp + 32) = ob;
                }
        }
    }
}

template <int EPI>
DI void gemm8_phase(const Params& p, const bf16_t* A, const bf16_t* Bt, int M, int N, int K, void* C, unsigned char* smem) {
    lds_u8* shm = (lds_u8*)smem;
#define SA(b, h) (shm + (((b) * 2 + (h)) * P8_HT) * 2)
#define SB(b, h) (shm + ((4 + (b) * 2 + (h)) * P8_HT) * 2)
#define STAGE(P, BASE, br, kt) do { const char* _sb = (const char*)(BASE) + ((long)(br) * K + (long)(kt) * P8_BK) * 2; \
      __builtin_amdgcn_global_load_lds((const unsigned*)(_sb + voff0), (__attribute__((address_space(3))) unsigned*)((P) + wbase), 16, 0, 0); \
      __builtin_amdgcn_global_load_lds((const unsigned*)(_sb + voff1), (__attribute__((address_space(3))) unsigned*)((P) + wbase + 8192), 16, 0, 0); } while (0)
#define LDA(dst, b, h) _Pragma("unroll") for (int m = 0; m < 4; ++m) _Pragma("unroll") for (int k = 0; k < 2; ++k) \
    dst[m][k] = *reinterpret_cast<const __attribute__((address_space(3))) bf16x8*>(SA(b, h) + lds_byte(wr * 64 + m * 16 + fr, k * 32 + fq * 8))
#define LDB(dst, b, h) _Pragma("unroll") for (int n = 0; n < 2; ++n) _Pragma("unroll") for (int k = 0; k < 2; ++k) \
    dst[n][k] = *reinterpret_cast<const __attribute__((address_space(3))) bf16x8*>(SB(b, h) + lds_byte(wc * 32 + n * 16 + fr, k * 32 + fq * 8))
#define MMA(ai, bj, At_, Bt_) do { __builtin_amdgcn_s_setprio(1); \
    _Pragma("unroll") for (int m = 0; m < 4; ++m) _Pragma("unroll") for (int n = 0; n < 2; ++n) _Pragma("unroll") for (int k = 0; k < 2; ++k) \
      acc[ai][bj][m][n] = __builtin_amdgcn_mfma_f32_16x16x32_bf16(Bt_[n][k], At_[m][k], acc[ai][bj][m][n], 0, 0, 0); \
    __builtin_amdgcn_s_setprio(0); } while (0)
#define WAIT_V(n) asm volatile("s_waitcnt vmcnt(" #n ")" ::: "memory")
#define WAIT_L(n) asm volatile("s_waitcnt lgkmcnt(" #n ")" ::: "memory")
#define BAR __builtin_amdgcn_s_barrier()
#define SCHED __builtin_amdgcn_sched_barrier(0)
    const int nM = M / P8_BM, nN = N / P8_BM, nwg = nM * nN, G = gridDim.x;
    const int tid = opaque_tid();
    const int wid = tid >> 6, lane = tid & 63, wr = wid >> 2, wc = wid & 3, fr = lane & 15, fq = lane >> 4;
    const int nt = K / P8_BK;
    unsigned voff0, voff1;
    const int wbase = __builtin_amdgcn_readfirstlane(tid >> 6) * 1024;
    { int r_, c_; stage_rc(tid * 16, r_, c_); voff0 = (unsigned)(r_ * K + c_) * 2u; stage_rc(tid * 16 + 8192, r_, c_); voff1 = (unsigned)(r_ * K + c_) * 2u; }
    for (int round = 0;; ++round) {
        const long L = (long)round * G + blockIdx.x;
        if (L >= nwg) break;
        int wgid = (int)L;
        { const int q = nwg / 8, r = nwg % 8, xcd = wgid % 8, off = wgid / 8; wgid = (xcd < r ? xcd * (q + 1) : r * (q + 1) + (xcd - r) * q) + off; }
        const int nig = 8 * nN, gid = wgid / nig, fm = gid * 8, gsz = (nM - fm) < 8 ? (nM - fm) : 8;
        const int pm = fm + ((wgid % nig) % gsz), pn = (wgid % nig) / gsz, brow = pm * P8_BM, bcol = pn * P8_BM;
        f32x4 acc[2][2][4][2];
#pragma unroll
        for (int a = 0; a < 2; ++a)
#pragma unroll
            for (int b = 0; b < 2; ++b)
#pragma unroll
                for (int m = 0; m < 4; ++m)
#pragma unroll
                    for (int n = 0; n < 2; ++n) acc[a][b][m][n] = (f32x4){0.f, 0.f, 0.f, 0.f};
        bf16x8 At[4][2], B0[2][2], B1[2][2];
        STAGE(SB(0, 0), Bt, bcol, 0); STAGE(SA(0, 0), A, brow, 0);
        STAGE(SB(0, 1), Bt, bcol + P8_HALF, 0); STAGE(SA(0, 1), A, brow + P8_HALF, 0);
        if (wr == 1) BAR;
        WAIT_V(4); BAR;
        STAGE(SB(1, 0), Bt, bcol, 1); STAGE(SA(1, 0), A, brow, 1); STAGE(SB(1, 1), Bt, bcol + P8_HALF, 1);
        WAIT_V(6); BAR;
        for (int t = 0; t < nt - 2; t += 2) {
            LDB(B0, 0, 0); SCHED; LDA(At, 0, 0); STAGE(SA(1, 1), A, brow + P8_HALF, t + 1);
            WAIT_L(8); BAR; WAIT_L(0); MMA(0, 0, At, B0); BAR; SCHED;
            LDB(B1, 0, 1); STAGE(SB(0, 0), Bt, bcol, t + 2);
            BAR; WAIT_L(0); MMA(0, 1, At, B1); BAR;
            LDA(At, 0, 1); STAGE(SA(0, 0), A, brow, t + 2);
            BAR; WAIT_L(0); MMA(1, 0, At, B0); BAR; SCHED;
            STAGE(SB(0, 1), Bt, bcol + P8_HALF, t + 2);
            WAIT_V(6); BAR; MMA(1, 1, At, B1); BAR;
            LDB(B0, 1, 0); SCHED; LDA(At, 1, 0); STAGE(SA(0, 1), A, brow + P8_HALF, t + 2);
            WAIT_L(8); BAR; WAIT_L(0); MMA(0, 0, At, B0); BAR; SCHED;
            LDB(B1, 1, 1); STAGE(SB(1, 0), Bt, bcol, t + 3);
            BAR; WAIT_L(0); MMA(0, 1, At, B1); BAR;
            LDA(At, 1, 1); STAGE(SA(1, 0), A, brow, t + 3);
            BAR; WAIT_L(0); MMA(1, 0, At, B0); BAR; SCHED;
            STAGE(SB(1, 1), Bt, bcol + P8_HALF, t + 3);
            WAIT_V(6); BAR; MMA(1, 1, At, B1); BAR;
        }
        { LDB(B0, 0, 0); LDA(At, 0, 0); STAGE(SA(1, 1), A, brow + P8_HALF, nt - 1);
          BAR; WAIT_L(0); MMA(0, 0, At, B0); BAR;
          LDB(B1, 0, 1); BAR; WAIT_L(0); MMA(0, 1, At, B1); BAR;
          LDA(At, 0, 1); WAIT_V(4); BAR; WAIT_L(0); MMA(1, 0, At, B0); MMA(1, 1, At, B1); BAR; }
        { LDB(B0, 1, 0); LDA(At, 1, 0); WAIT_V(2); BAR; WAIT_L(0); MMA(0, 0, At, B0); BAR;
          LDB(B1, 1, 1); WAIT_V(0); BAR; WAIT_L(0); MMA(0, 1, At, B1); BAR;
          LDA(At, 1, 1); BAR; WAIT_L(0); MMA(1, 0, At, B0); MMA(1, 1, At, B1); BAR; }
        if (wr == 0) BAR;
        gemm8_epilogue<EPI>(p, acc, brow, bcol, N, C, wr, wc, fr, fq);
    }
#undef SA
#undef SB
#undef STAGE
#undef LDA
#undef LDB
#undef MMA
}

constexpr int A_KROW = 144;
constexpr int A_VROW = 520;
constexpr int A_KS = 0;
constexpr int A_VT = 2 * 256 * A_KROW;
constexpr int S_VROW = 272;
constexpr int A_RED = 140288;
constexpr int A_LDS = A_RED + 2 * 8 * 32 * 4;

DI void head_norm_store(const f32x16 (&o)[2], const float* gvec, bf16_t* yrow, float* red, int w, int lane) {
    const int r = lane & 31, h = lane >> 5;
    float ss = 0.f;
#pragma unroll
    for (int dt = 0; dt < 2; ++dt)
#pragma unroll
        for (int i = 0; i < 16; ++i) ss += o[dt][i] * o[dt][i];
    ss += __shfl_xor(ss, 32);
    if (lane < 32) red[w * 32 + r] = ss;
    __syncthreads();
    float tot = 0.f;
#pragma unroll
    for (int ww = 0; ww < 8; ++ww) tot += red[ww * 32 + r];
    const float rstd = rsqrtf(tot * (1.0f / 512.0f) + EPS);
#pragma unroll
    for (int dt = 0; dt < 2; ++dt)
#pragma unroll
        for (int g4 = 0; g4 < 4; ++g4) {
            const int d = dt * 32 + 8 * g4 + 4 * h;
            const f32x4 gv = *(const f32x4*)(gvec + d);
            u32x2 pk;
            pk[0] = pk2(o[dt][4 * g4 + 0] * rstd * gv[0], o[dt][4 * g4 + 1] * rstd * gv[1]);
            pk[1] = pk2(o[dt][4 * g4 + 2] * rstd * gv[2], o[dt][4 * g4 + 3] * rstd * gv[3]);
            *(u32x2*)(yrow + d) = pk;
        }
}

DI bf16x8 pack8(const f32x16& x, int s) {
    u32x4 q;
    q[0] = pk2(x[8 * s + 0], x[8 * s + 1]); q[1] = pk2(x[8 * s + 2], x[8 * s + 3]);
    q[2] = pk2(x[8 * s + 4], x[8 * s + 5]); q[3] = pk2(x[8 * s + 6], x[8 * s + 7]);
    return __builtin_bit_cast(bf16x8, q);
}

DI void phase3(const Params& p, unsigned char* smem) {
    const int tid = opaque_tid(), w = tid >> 6, lane = tid & 63, r = lane & 31, h = lane >> 5;
    const bf16_t* proj = (const bf16_t*)(p.ws + WS_PROJ);
    const bf16_t* wsb = (const bf16_t*)(p.ws + WS_WS);
    bf16_t* yin = (bf16_t*)(p.ws + WS_YIN);
    float* red = (float*)(smem + A_RED);
    for (int item = blockIdx.x; item < NB * 16; item += gridDim.x) {
        const int nblk = item & 15;
        const int tok0 = item * 128;
        for (int c = tid; c < 2 * 256 * 8; c += NTHREADS) {
            const int g = c >> 11, key = (c >> 3) & 255, kc = c & 7;
            u32x4 kv = {0u, 0u, 0u, 0u}, vv = {0u, 0u, 0u, 0u};
            if (nblk > 0 || key >= 128) {
                const size_t base = (size_t)(tok0 - 128 + key) * INC + g * 64 + kc * 8;
                kv = *(const u32x4*)(proj + base + C_K);
                vv = *(const u32x4*)(proj + base + C_V);
            }
            *(u32x4*)(smem + A_KS + (g * 256 + key) * A_KROW + kc * 16) = kv;
            bf16_t* vt = (bf16_t*)(smem + A_VT + (g * 64 + kc * 8) * A_VROW) + key;
#pragma unroll
            for (int i = 0; i < 4; ++i) {
                vt[(2 * i) * (A_VROW / 2)] = (bf16_t)(vv[i] & 0xffffu);
                vt[(2 * i + 1) * (A_VROW / 2)] = (bf16_t)(vv[i] >> 16);
            }
        }
        __syncthreads();
        {
            const int g = w >> 2;
            const float sink = p.sinks[w];
            const unsigned char* kbase = smem + A_KS + (g * 256) * A_KROW;
            const unsigned char* vbase = smem + A_VT + (g * 64) * A_VROW;
            for (int qt = 0; qt < 4; ++qt) {
                const int tq = tok0 + qt * 32 + r;
                bf16x8 bq[4];
#pragma unroll
                for (int s = 0; s < 4; ++s) bq[s] = *(const bf16x8*)(proj + (size_t)tq * INC + w * 64 + s * 16 + h * 8);
                f32x16 sacc[5];
#pragma unroll
                for (int kt = 0; kt < 5; ++kt) {
#pragma unroll
                    for (int i = 0; i < 16; ++i) sacc[kt][i] = 0.f;
                    const unsigned char* kp = kbase + (qt * 32 + kt * 32 + r) * A_KROW + h * 16;
#pragma unroll
                    for (int s = 0; s < 4; ++s) {
                        const bf16x8 ka = *(const bf16x8*)(kp + s * 32);
                        sacc[kt] = MFMA32(ka, bq[s], sacc[kt]);
                    }
                }
                float mx = -INFINITY;
#pragma unroll
                for (int kt = 0; kt < 5; ++kt)
#pragma unroll
                    for (int i = 0; i < 16; ++i) {
                        const int diff = kt * 32 + crow(i, h) - r;
                        bool valid = (diff >= 1) && (diff <= 128);
                        if (nblk == 0) valid = valid && (qt * 32 + kt * 32 + crow(i, h) >= 128);
                        const float sv = valid ? sacc[kt][i] : -INFINITY;
                        sacc[kt][i] = sv;
                        mx = fmaxf(mx, sv);
                    }
                mx = fmaxf(mx, __shfl_xor(mx, 32));
                mx = fmaxf(mx, sink);
                float lsum = 0.f;
#pragma unroll
                for (int kt = 0; kt < 5; ++kt)
#pragma unroll
                    for (int i = 0; i < 16; ++i) { const float e = __expf(sacc[kt][i] - mx); sacc[kt][i] = e; lsum += e; }
                lsum += __shfl_xor(lsum, 32);
                lsum += __expf(sink - mx);
                const float inv_l = 1.0f / lsum;
                f32x16 o[2];
#pragma unroll
                for (int dt = 0; dt < 2; ++dt)
#pragma unroll
                    for (int i = 0; i < 16; ++i) o[dt][i] = 0.f;
#pragma unroll
                for (int kt = 0; kt < 5; ++kt)
#pragma unroll
                    for (int s = 0; s < 2; ++s) {
                        const bf16x8 pb = pack8(sacc[kt], s);
                        const int key0 = qt * 32 + kt * 32 + 16 * s + 4 * h;
#pragma unroll
                        for (int dt = 0; dt < 2; ++dt) {
                            const unsigned char* vp = vbase + (dt * 32 + r) * A_VROW + key0 * 2;
                            const s16x4 lo = *(const s16x4*)(vp), hi = *(const s16x4*)(vp + 16);
                            const bf16x8 va = __builtin_shufflevector(lo, hi, 0, 1, 2, 3, 4, 5, 6, 7);
                            o[dt] = MFMA32(va, pb, o[dt]);
                        }
                    }
#pragma unroll
                for (int dt = 0; dt < 2; ++dt)
#pragma unroll
                    for (int i = 0; i < 16; ++i) o[dt][i] *= inv_l;
                head_norm_store(o, p.g_att_out + w * 64, yin + (size_t)tq * DM + w * 64, red + (qt & 1) * 256, w, lane);
            }
        }
        __syncthreads();
        for (int rr = tid; rr < 128 * 8; rr += NTHREADS) {
            const int s = rr >> 3, hs = rr & 7;
            const bf16_t* src = proj + (size_t)(tok0 + s) * INC + C_VS + hs * 64;
            float v[64];
#pragma unroll
            for (int c = 0; c < 8; ++c) {
                const u32x4 q = *(const u32x4*)(src + c * 8);
#pragma unroll
                for (int i = 0; i < 4; ++i) { v[c * 8 + 2 * i] = bflo(q[i]); v[c * 8 + 2 * i + 1] = bfhi(q[i]); }
            }
            float mu = 0.f;
#pragma unroll
            for (int i = 0; i < 64; ++i) mu += v[i];
            mu *= (1.0f / 64.0f);
            float var = 0.f;
#pragma unroll
            for (int i = 0; i < 64; ++i) { const float d = v[i] - mu; var += d * d; }
            const float rstd = rsqrtf(var * (1.0f / 64.0f) + EPS);
            bf16_t* dst = (bf16_t*)(smem + (hs * 64) * S_VROW) + s;
#pragma unroll
            for (int i = 0; i < 64; ++i) {
                const float yv = (v[i] - mu) * rstd * p.sgu_ln_g[hs * 64 + i] + p.sgu_ln_b[hs * 64 + i];
                dst[i * (S_VROW / 2)] = f2bf(yv);
            }
        }
        __syncthreads();
        {
            const unsigned char* vb = smem + (w * 64) * S_VROW;
            for (int tt = 0; tt < 4; ++tt) {
                const int tl = tt * 32 + r;
                f32x16 o[2];
#pragma unroll
                for (int dt = 0; dt < 2; ++dt)
#pragma unroll
                    for (int i = 0; i < 16; ++i) o[dt][i] = 0.f;
                const bf16_t* wrow = wsb + (size_t)(w * 128 + tl) * 128 + h * 8;
                const int nks = 2 * (tt + 1);
                for (int ks = 0; ks < nks; ++ks) {
                    const bf16x8 wb = *(const bf16x8*)(wrow + ks * 16);
#pragma unroll
                    for (int dt = 0; dt < 2; ++dt) {
                        const bf16x8 va = *(const bf16x8*)(vb + (dt * 32 + r) * S_VROW + (ks * 16 + h * 8) * 2);
                        o[dt] = MFMA32(va, wb, o[dt]);
                    }
                }
                const float bias = p.b_s[w * 128 + tl];
                const bf16_t* urow = proj + (size_t)(tok0 + tl) * INC + C_U + w * 64;
#pragma unroll
                for (int dt = 0; dt < 2; ++dt)
#pragma unroll
                    for (int g4 = 0; g4 < 4; ++g4) {
                        const u32x2 uu = *(const u32x2*)(urow + dt * 32 + 8 * g4 + 4 * h);
                        o[dt][4 * g4 + 0] = (o[dt][4 * g4 + 0] + bias) * bflo(uu[0]);
                        o[dt][4 * g4 + 1] = (o[dt][4 * g4 + 1] + bias) * bfhi(uu[0]);
                        o[dt][4 * g4 + 2] = (o[dt][4 * g4 + 2] + bias) * bflo(uu[1]);
                        o[dt][4 * g4 + 3] = (o[dt][4 * g4 + 3] + bias) * bfhi(uu[1]);
                    }
                head_norm_store(o, p.g_sgu_out + w * 64, yin + (size_t)(tok0 + tl) * DM + 512 + w * 64, red + (tt & 1) * 256, w, lane);
            }
        }
        __syncthreads();
    }
}

DI int f2key(float f) { const int b = __float_as_int(f); return b ^ ((b >> 31) & 0x7fffffff); }
DI float key2f(int k) { return __int_as_float(k ^ ((k >> 31) & 0x7fffffff)); }

DI void phase7(const Params& p) {
    const float* scT = (const float*)(p.ws + WS_SCT);
    int* ids = (int*)(p.ws + WS_IDS);
    float* gates = (float*)(p.ws + WS_GATES);
    const int gsz = gridDim.x * NTHREADS;
    for (int idx = blockIdx.x * NTHREADS + opaque_tid(); idx < T * PH; idx += gsz) {
        const int tok = idx & (T - 1), hd = idx >> 16;
        int a0[16], a1[16];
#pragma unroll
        for (int i = 0; i < 16; ++i) { a0[i] = INT_MIN; a1[i] = INT_MIN; }
        const float* s0 = scT + (size_t)(hd * 256) * T + tok;
        const float* s1 = s0 + (size_t)128 * T;
#pragma unroll 8
        for (int n = 0; n < 128; ++n) {
            int v0 = (f2key(s0[(size_t)n * T]) & ~127) | (127 - n);
            int v1 = (f2key(s1[(size_t)n * T]) & ~127) | (127 - n);
#pragma unroll
            for (int i = 0; i < 16; ++i) {
                const int m0 = max(a0[i], v0); v0 = min(a0[i], v0); a0[i] = m0;
                const int m1 = max(a1[i], v1); v1 = min(a1[i], v1); a1[i] = m1;
            }
        }
        float ts[16]; int tp[16];
#pragma unroll
        for (int i = 0; i < 16; ++i) { ts[i] = -INFINITY; tp[i] = 0; }
#pragma unroll
        for (int i = 0; i < 16; ++i) {
            const float vi = key2f(a0[i] & ~127);
            const int ni = 127 - (a0[i] & 127);
#pragma unroll
            for (int j = 0; j < 16; ++j) {
                if ((i + 1) * (j + 1) <= 16) {
                    float v = vi + key2f(a1[j] & ~127);
                    int pl = ni * 128 + (127 - (a1[j] & 127));
#pragma unroll
                    for (int k = 0; k < 16; ++k) {
                        const bool gt = v > ts[k];
                        const float nv = gt ? ts[k] : v; const int np = gt ? tp[k] : pl;
                        ts[k] = gt ? v : ts[k]; tp[k] = gt ? pl : tp[k];
                        v = nv; pl = np;
                    }
                }
            }
        }
        float e[16], sum = 0.f;
#pragma unroll
        for (int k = 0; k < 16; ++k) { e[k] = __expf(ts[k] - ts[0]); sum += e[k]; }
        const float inv = 1.0f / sum;
        int* ip = ids + (size_t)tok * 128 + hd * 16;
        float* gp = gates + (size_t)tok * 128 + hd * 16;
#pragma unroll
        for (int k4 = 0; k4 < 4; ++k4) {
            int4 iv = make_int4(tp[4 * k4], tp[4 * k4 + 1], tp[4 * k4 + 2], tp[4 * k4 + 3]);
            *(int4*)(ip + 4 * k4) = iv;
            f32x4 gv = {e[4 * k4] * inv, e[4 * k4 + 1] * inv, e[4 * k4 + 2] * inv, e[4 * k4 + 3] * inv};
            *(f32x4*)(gp + 4 * k4) = gv;
        }
    }
}

DI void load_rowP(const float* row, int lane, float (&v)[16]) {
#pragma unroll
    for (int j = 0; j < 4; ++j) { const f32x4 a = *(const f32x4*)(row + 256 * j + 4 * lane);
#pragma unroll
        for (int i = 0; i < 4; ++i) v[4 * j + i] = a[i]; }
}
DI void store_rowP(float* row, int lane, const float (&v)[16]) {
#pragma unroll
    for (int j = 0; j < 4; ++j) { f32x4 a;
#pragma unroll
        for (int i = 0; i < 4; ++i) a[i] = v[4 * j + i];
        *(f32x4*)(row + 256 * j + 4 * lane) = a; }
}
template <int M> DI int shxi(int v, int lane) {
    if constexpr (M < 32) return __builtin_amdgcn_ds_swizzle(v, (M << 10) | 0x1f);
    else return __builtin_amdgcn_ds_bpermute((lane ^ 32) << 2, v);
}
template <int M> DI float shxf(float v, int lane) { return __int_as_float(shxi<M>(__float_as_int(v), lane)); }
DI float wave_sum_l(float v, int lane) {
    v += shxf<1>(v, lane); v += shxf<2>(v, lane); v += shxf<4>(v, lane); v += shxf<8>(v, lane); v += shxf<16>(v, lane); v += shxf<32>(v, lane);
    return v;
}
DI int lane_id_fresh() { int l; asm volatile("v_mbcnt_lo_u32_b32 %0, -1, 0\n\tv_mbcnt_hi_u32_b32 %0, -1, %0" : "=v"(l)); return l; }
template <int K, int J>
DI void bitonic_step128(unsigned (&key)[8], int lane) {
    if constexpr (J >= 64) {
#pragma unroll
        for (int t = 0; t < 4; ++t) {
            const unsigned lo = min(key[2 * t], key[2 * t + 1]), hi = max(key[2 * t], key[2 * t + 1]);
            key[2 * t] = lo; key[2 * t + 1] = hi;
        }
    } else {
        const bool lower = (lane & J) == 0;
#pragma unroll
        for (int r = 0; r < 8; ++r) {
            const unsigned other = (unsigned)shxi<J>((int)key[r], lane);
            const bool up = (K >= 128) ? true : ((K == 64) ? ((r & 1) == 0) : ((lane & K) == 0));
            const unsigned mn = min(key[r], other), mx = max(key[r], other);
            key[r] = (lower == up) ? mn : mx;
        }
    }
}
template <int K, int J>
DI void bitonic_merge128(unsigned (&key)[8], int lane) {
    bitonic_step128<K, J>(key, lane);
    if constexpr (J > 1) bitonic_merge128<K, J / 2>(key, lane);
}
template <int K>
DI void bitonic_sort128(unsigned (&key)[8], int lane) {
    if constexpr (K > 2) bitonic_sort128<K / 2>(key, lane);
    bitonic_merge128<K, K / 2>(key, lane);
}

DI void phase8(const Params& p, unsigned char* smem) {
    const int w = __builtin_amdgcn_readfirstlane(opaque_tid() >> 6);
    const int gw = blockIdx.x * NWAVES + w, NW = gridDim.x * NWAVES;
    const unsigned char* hq = p.ws + WS_HQ;
    const float* hs = (const float*)(p.ws + WS_HS);
    const unsigned char* ed = p.ws + WS_ED;
    const unsigned char* eu = p.ws + WS_EU;
    const float* scd = (const float*)(p.ws + WS_SCD);
    const float* scu = (const float*)(p.ws + WS_SCU);
    const int* ids = (const int*)(p.ws + WS_IDS);
    const float* gates = (const float*)(p.ws + WS_GATES);
    const float* mod = (const float*)(p.ws + WS_MOD);
    unsigned char* hl = smem + w * 8192;
#pragma unroll 1
    for (int grp = gw; grp < T / 4; grp += NW) {
        const int t0 = grp * 4;
        int lane = lane_id_fresh();
        unsigned key[8];
#pragma unroll
        for (int r = 0; r < 8; ++r) {
            const int tl = r >> 1, k = (r & 1) * 64 + lane;
            key[r] = ((unsigned)ids[(size_t)(t0 + tl) * 128 + k] << 7) | (unsigned)k;
        }
        bitonic_sort128<128>(key, lane);
#pragma unroll
        for (int tl = 0; tl < 4; ++tl) *(u32x4*)(hl + tl * 1088 + lane * 16) = *(const u32x4*)(hq + (size_t)(t0 + tl) * DM + lane * 16);
        const unsigned char* hBp = hl + (lane & 3) * 1088 + 16 * (lane >> 4);
        float aval[8];
#pragma unroll
        for (int r = 0; r < 8; ++r) aval[r] = 0.f;
        {
            u32x4 bA[16], bB[16];
#define DN_LOAD(BUF, BI) do { const bool h1_ = (BI) >= 16; const int sl_ = (((4 * (BI)) & 63) + ((lane & 15) >> 2)) << 2; \
                const unsigned k0_ = (unsigned)__builtin_amdgcn_ds_bpermute(sl_, (int)(h1_ ? key[1] : key[0])), k1_ = (unsigned)__builtin_amdgcn_ds_bpermute(sl_, (int)(h1_ ? key[3] : key[2])); \
                const unsigned k2_ = (unsigned)__builtin_amdgcn_ds_bpermute(sl_, (int)(h1_ ? key[5] : key[4])), k3_ = (unsigned)__builtin_amdgcn_ds_bpermute(sl_, (int)(h1_ ? key[7] : key[6])); \
                const unsigned ek_ = (lane & 2) ? ((lane & 1) ? k3_ : k2_) : ((lane & 1) ? k1_ : k0_); \
                const unsigned char* rp_ = ed + (size_t)(ek_ >> 7) * DM + 16 * (lane >> 4); \
                _Pragma("unroll") for (int i = 0; i < 16; ++i) BUF[i] = *(const u32x4*)(rp_ + 64 * i); } while (0)
#define DN_COMP(BUF, BI) do { f32x4 d_ = {0.f, 0.f, 0.f, 0.f}; \
                _Pragma("unroll") for (int i = 0; i < 16; ++i) { const u32x4 hb_ = *(const u32x4*)(hBp + 64 * i); \
                    d_ = __builtin_amdgcn_mfma_f32_16x16x32_fp8_fp8((long)(((unsigned long long)BUF[i][1] << 32) | BUF[i][0]), (long)(((unsigned long long)hb_[1] << 32) | hb_[0]), d_, 0, 0, 0); \
                    d_ = __builtin_amdgcn_mfma_f32_16x16x32_fp8_fp8((long)(((unsigned long long)BUF[i][3] << 32) | BUF[i][2]), (long)(((unsigned long long)hb_[3] << 32) | hb_[2]), d_, 0, 0, 0); } \
                  \
                const bool mine_ = (lane >> 2) == ((BI) & 15); const bool h1c_ = (BI) >= 16; \
                _Pragma("unroll") for (int tl = 0; tl < 4; ++tl) { \
                    const float v_ = __int_as_float(__builtin_amdgcn_ds_bpermute((16 * (lane & 3) + tl) << 2, __float_as_int(d_[tl]))); \
                    aval[2 * tl] = (mine_ && !h1c_) ? v_ : aval[2 * tl]; aval[2 * tl + 1] = (mine_ && h1c_) ? v_ : aval[2 * tl + 1]; } } while (0)
            DN_LOAD(bA, 0);
#pragma unroll 1
            for (int bi = 0; bi < 32; bi += 2) {
                DN_LOAD(bB, bi + 1); DN_COMP(bA, bi);
                if (bi + 2 < 32) DN_LOAD(bA, bi + 2);
                DN_COMP(bB, bi + 1);
            }
#undef DN_LOAD
#undef DN_COMP
        }
        float cfv[8];
#pragma unroll
        for (int r = 0; r < 8; ++r) {
            const int tl = r >> 1, e = key[r] >> 7, k = key[r] & 127;
            cfv[r] = gates[(size_t)(t0 + tl) * 128 + k] * gelu_exact(aval[r] * hs[t0 + tl] * scd[e]) * scu[e];
        }
        lane = lane_id_fresh();
        f32x2 acc[4][8];
#pragma unroll
        for (int a = 0; a < 4; ++a)
#pragma unroll
            for (int b = 0; b < 8; ++b) acc[a][b] = (f32x2){0.f, 0.f};
        {
            u32x4 rA[4], rB[4], rC[4];
#define UP_LOAD(ROWS, RI) do { const bool h1_ = (RI) >= 64; \
                _Pragma("unroll") for (int tl = 0; tl < 4; ++tl) { const unsigned ent = (unsigned)__builtin_amdgcn_readlane((int)(h1_ ? key[2 * tl + 1] : key[2 * tl]), (RI) & 63); \
                    ROWS[tl] = *(const u32x4*)(eu + (size_t)(ent >> 7) * DM + 16 * lane); } } while (0)
#define UP_COMP(ROWS, RI) do { const bool h1_ = (RI) >= 64; \
                _Pragma("unroll") for (int tl = 0; tl < 4; ++tl) { \
                    const float cf_ = __int_as_float(__builtin_amdgcn_readlane(__float_as_int(h1_ ? cfv[2 * tl + 1] : cfv[2 * tl]), (RI) & 63)); \
                    const f32x2 cf2 = {cf_, cf_}; \
                    _Pragma("unroll") for (int q = 0; q < 4; ++q) { \
                        const f32x2 lo = __builtin_amdgcn_cvt_pk_f32_fp8(ROWS[tl][q], false), hi = __builtin_amdgcn_cvt_pk_f32_fp8(ROWS[tl][q], true); \
                        acc[tl][2 * q] = __builtin_elementwise_fma(lo, cf2, acc[tl][2 * q]); acc[tl][2 * q + 1] = __builtin_elementwise_fma(hi, cf2, acc[tl][2 * q + 1]); } } } while (0)
            UP_LOAD(rA, 0); UP_LOAD(rB, 1);
#pragma unroll 1
            for (int ri = 0; ri < 126; ri += 3) {
                UP_LOAD(rC, ri + 2); UP_COMP(rA, ri);
                UP_LOAD(rA, ri + 3); UP_COMP(rB, ri + 1);
                UP_LOAD(rB, ri + 4); UP_COMP(rC, ri + 2);
            }
            UP_COMP(rA, 126); UP_COMP(rB, 127);
#undef UP_LOAD
#undef UP_COMP
        }
        lane = lane_id_fresh();
        const int b = t0 >> 11;
        float gpost[16], gt[16];
        load_rowP(p.g_post_ffn, lane, gpost);
        load_rowP(mod + b * 6144 + 5120, lane, gt);
#pragma unroll
        for (int tl = 0; tl < 4; ++tl) {
            float y2[16];
#pragma unroll
            for (int q = 0; q < 4; ++q) { y2[4 * q] = acc[tl][2 * q][0]; y2[4 * q + 1] = acc[tl][2 * q][1]; y2[4 * q + 2] = acc[tl][2 * q + 1][0]; y2[4 * q + 3] = acc[tl][2 * q + 1][1]; }
            float ss = 0.f;
#pragma unroll
            for (int i = 0; i < 16; ++i) ss += y2[i] * y2[i];
            const float rstd = rsqrtf(wave_sum_l(ss, lane) * (1.0f / DM) + EPS);
            float x1[16];
            load_rowP(p.out + (size_t)(t0 + tl) * DM, lane, x1);
            float o[16];
#pragma unroll
            for (int i = 0; i < 16; ++i) o[i] = x1[i] + gt[i] * (y2[i] * rstd * gpost[i]);
            store_rowP(p.out + (size_t)(t0 + tl) * DM, lane, o);
        }
    }
}

#ifdef PROBE_RANGE
DI void probe_gather(const Params& p, int range_mask) {
    const int w = __builtin_amdgcn_readfirstlane(opaque_tid() >> 6);
    const int lane = lane_id_fresh();
    const unsigned char* eu = p.ws + WS_EU;
    const unsigned gwv = blockIdx.x * NWAVES + w;
    const unsigned long long t0 = __builtin_amdgcn_s_memrealtime();
    unsigned sink = 0;
    unsigned state = gwv * 2654435761u + 12345u;
    for (int it = 0; it < 512; ++it) {
        u32x4 rows[16];
#pragma unroll
        for (int j = 0; j < 16; ++j) {
            state = state * 1664525u + 1013904223u;
            const unsigned e = (state >> 10) & (unsigned)range_mask;
            rows[j] = *(const u32x4*)(eu + (size_t)e * DM + 16 * lane);
        }
#pragma unroll
        for (int j = 0; j < 16; ++j) sink += rows[j][0] ^ rows[j][1] ^ rows[j][2] ^ rows[j][3];
    }
    asm volatile("" :: "v"(sink));
    const unsigned long long t1 = __builtin_amdgcn_s_memrealtime();
    if (blockIdx.x == 0 && w == 0 && lane == 0) p.out[0] += (float)(t1 - t0) * (1.0f / 10000.0f);
}
#endif
#define XB_TMO      128
#define XB_XCNT(j)  (256  + 64 * (j))
#define XB_XSUB(j)  (1280 + 64 * (j))
#define XB_XGEN(j)  (2304 + 64 * (j))
#define XB_TOP      3328
#define XB_TOPGEN   3392
#define XCD_BAR_WORDS 3456
#define XB_SPIN_CAP (1u << 22)
DI unsigned xb_ld(unsigned* p)              { return __hip_atomic_load(p, __ATOMIC_RELAXED, __HIP_MEMORY_SCOPE_AGENT); }
DI unsigned xb_add(unsigned* p, unsigned v) { return __hip_atomic_fetch_add(p, v, __ATOMIC_RELAXED, __HIP_MEMORY_SCOPE_AGENT); }
DI unsigned xb_xcc_id() { return (unsigned)__builtin_amdgcn_s_getreg((3 << 11) | 20) & 0xFu; }
#define XB_SPIN(cond, bar) do { unsigned _sp = 0; while (cond) { __builtin_amdgcn_s_sleep(1); \
    if ((++_sp & 255u) == 0u) { if (xb_ld(&(bar)[XB_TMO])) break; if (_sp > XB_SPIN_CAP) { atomicAdd(&(bar)[XB_TMO], 1u); break; } } } } while (0)
struct XcdBarrier { unsigned* bar; unsigned x; volatile unsigned* st; };
DI XcdBarrier xcd_barrier_post(unsigned* bar, volatile unsigned* st) {
    XcdBarrier b; b.bar = bar; b.x = xb_xcc_id(); b.st = st;
    if (threadIdx.x == 0) (void)xb_add(&bar[XB_XCNT(b.x)], 1u);
    return b;
}
DI void xcd_barrier_complete(unsigned* bar, unsigned x, unsigned& nloc, unsigned& nx) {
    const unsigned G = gridDim.x;
    unsigned sum, cnt, mine, sp = 0u;
    for (;;) {
        sum = 0u; cnt = 0u; mine = 0u;
#pragma unroll
        for (unsigned j = 0; j < 16; ++j) { const unsigned c = xb_ld(&bar[XB_XCNT(j)]); sum += c; cnt += (c > 0u) ? 1u : 0u; mine = (j == x) ? c : mine; }
        if (sum == G) break;
        __builtin_amdgcn_s_sleep(1);
        if ((++sp & 255u) == 0u) { if (xb_ld(&bar[XB_TMO])) break; if (sp > XB_SPIN_CAP) { atomicAdd(&bar[XB_TMO], 1u); break; } }
    }
    nloc = mine > 0u ? mine : 1u; nx = cnt > 0u ? cnt : 1u;
}
DI void xcd_barrier(const XcdBarrier& b) {
    asm volatile("s_waitcnt vmcnt(0)" ::: "memory");
    __syncthreads();
    if (threadIdx.x == 0) {
        unsigned* bar = b.bar;
        __builtin_amdgcn_s_waitcnt(0);
        unsigned nloc = b.st[0], nx = b.st[1];
        if (nloc == 0u) { xcd_barrier_complete(bar, b.x, nloc, nx); b.st[0] = nloc; b.st[1] = nx; }
        const unsigned old = xb_add(&bar[XB_XSUB(b.x)], 1u);
        const unsigned gen = old / nloc;
        if (old + 1u == (gen + 1u) * nloc) {
            __builtin_amdgcn_fence(__ATOMIC_RELEASE, "agent");
            asm volatile("s_waitcnt vmcnt(0)" ::: "memory");
            const unsigned og = xb_add(&bar[XB_TOP], 1u);
            const unsigned tg = og / nx;
            if (og + 1u == (tg + 1u) * nx) xb_add(&bar[XB_TOPGEN], 1u);
            else XB_SPIN(xb_ld(&bar[XB_TOPGEN]) == tg, bar);
            __builtin_amdgcn_fence(__ATOMIC_ACQUIRE, "agent");
            xb_add(&bar[XB_XGEN(b.x)], 1u);
            asm volatile("s_waitcnt vmcnt(0)" ::: "memory");
        } else {
            XB_SPIN(xb_ld(&bar[XB_XGEN(b.x)]) == gen, bar);
            __builtin_amdgcn_fence(__ATOMIC_ACQUIRE, "agent");
            asm volatile("s_waitcnt vmcnt(0)" ::: "memory");
        }
    }
    __syncthreads();
}

constexpr int LDS_BYTES = 147456;

template <int PHS>
DI void run_phase(const Params& p, unsigned char* smem) {
    if (PHS == 0) phase0(p, smem);
    else if (PHS == 1) phase1(p);
    else if (PHS == 2) gemm8_phase<EPI_PROJ>(p, (const bf16_t*)(p.ws + WS_H), (const bf16_t*)(p.ws + WS_WIN), T, INC, DM, p.ws + WS_PROJ, smem);
    else if (PHS == 3) phase3(p, smem);
    else if (PHS == 4) gemm8_phase<EPI_BF16>(p, (const bf16_t*)(p.ws + WS_YIN), (const bf16_t*)(p.ws + WS_WOUT), T, DM, DM, p.ws + WS_Y, smem);
    else if (PHS == 5) phase5(p);
    else if (PHS == 6) gemm8_phase<EPI_F32>(p, (const bf16_t*)(p.ws + WS_WQF), (const bf16_t*)(p.ws + WS_H), 2048, T, DM, p.ws + WS_SCT, smem);
    else if (PHS == 7) phase7(p);
    else if (PHS == 8) phase8(p, smem);
}

template <int PHS>
__global__ void __launch_bounds__(NTHREADS) k_phase(Params p) {
    __shared__ __attribute__((aligned(16))) unsigned char smem[LDS_BYTES];
    run_phase<PHS>(p, smem);
}

__global__ void __launch_bounds__(NTHREADS) k_mega(Params p) {
    __shared__ __attribute__((aligned(16))) unsigned char smem[LDS_BYTES];
    cg::grid_group grid = cg::this_grid();
    volatile unsigned* st = (volatile unsigned*)(smem + LDS_BYTES - 16);
    if (threadIdx.x == 0) { st[0] = 0u; st[1] = 0u; }
    __syncthreads();
    const XcdBarrier xb = xcd_barrier_post((unsigned*)(p.ws + WS_BAR), st);
#ifndef DUP_MASK
#define DUP_MASK 0
#endif
#define RUNP(k) do { run_phase<k>(p, smem); xcd_barrier(xb); if ((DUP_MASK >> k) & 1) { run_phase<k>(p, smem); xcd_barrier(xb); } } while (0)
    run_phase<0>(p, smem); grid.sync();
    RUNP(1); RUNP(2); RUNP(3); RUNP(4); RUNP(5); RUNP(6); RUNP(7);
    run_phase<8>(p, smem);
#ifdef PROBE_RANGE
    xcd_barrier(xb); probe_gather(p, PROBE_RANGE);
#endif
}

template <int PHS>
static void launch_phase(const Params& p, int grid, hipStream_t stream) {
    hipLaunchKernelGGL(k_phase<PHS>, dim3(grid), dim3(NTHREADS), 0, stream, p);
}

extern "C" void kernel_launch(void* const* d_in, const int* in_sizes, int n_in, void* d_out, int out_size, void* d_ws, size_t ws_size, hipStream_t stream) {
    if (n_in != 21 || out_size != T * DM || ws_size < WS_END) {
        fprintf(stderr, "kernel_launch: unexpected shapes (n_in %d out %d ws %zu need %zu)\n", n_in, out_size, ws_size, (size_t)WS_END);
        return;
    }
    Params p{};
    const float** f = (const float**)&p;
    for (int i = 0; i < 21; ++i) f[i] = (const float*)d_in[i];
    p.out = (float*)d_out; p.ws = (unsigned char*)d_ws;
#if MULTI_LAUNCH
    const int grid = 256;
    launch_phase<0>(p, grid, stream); launch_phase<1>(p, grid, stream); launch_phase<2>(p, grid, stream);
    launch_phase<3>(p, grid, stream); launch_phase<4>(p, grid, stream); launch_phase<5>(p, grid, stream);
    launch_phase<6>(p, grid, stream); launch_phase<7>(p, grid, stream); launch_phase<8>(p, grid, stream);
#else
    static int grid = 0;
    if (!grid) {
        int dev = 0, cus = 0, per_cu = 0;
        (void)hipGetDevice(&dev);
        (void)hipDeviceGetAttribute(&cus, hipDeviceAttributeMultiprocessorCount, dev);
        (void)hipOccupancyMaxActiveBlocksPerMultiprocessor(&per_cu, (const void*)k_mega, NTHREADS, 0);
        if (per_cu < 1) { fprintf(stderr, "kernel_launch: occupancy query says %d blocks per CU\n", per_cu); per_cu = 1; }
        grid = cus;
    }
    (void)hipMemsetAsync((unsigned char*)d_ws + WS_BAR, 0, WS_BAR_BYTES, stream);
    void* args[] = {&p};
    hipError_t e = hipLaunchCooperativeKernel((const void*)k_mega, dim3(grid), dim3(NTHREADS), args, 0, stream);
    if (e != hipSuccess) fprintf(stderr, "cooperative launch failed: %s (grid %d)\n", hipGetErrorString(e), grid);
#endif
}
```

```cpp
#include <hip/hip_runtime.h>
#include <hip/hip_cooperative_groups.h>
#include <stdint.h>
#include <stdio.h>
#include <limits.h>
namespace cg = cooperative_groups;

#ifndef MULTI_LAUNCH
#define MULTI_LAUNCH 0
#endif

#define DI __device__ __forceinline__
typedef unsigned short bf16_t;
typedef short bf16x8 __attribute__((ext_vector_type(8)));
typedef short s16x4 __attribute__((ext_vector_type(4)));
typedef float f32x16 __attribute__((ext_vector_type(16)));
typedef float f32x4 __attribute__((ext_vector_type(4)));
typedef unsigned u32x4 __attribute__((ext_vector_type(4)));
typedef unsigned u32x2 __attribute__((ext_vector_type(2)));

constexpr int DM = 1024, NB = 32, SEQ = 2048, T = NB * SEQ;
constexpr int HD = 64, QH = 8, KVH = 2, WIN = 128;
constexpr int INC = 1792;
constexpr int C_K = 512, C_V = 640, C_U = 768, C_VS = 1280;
constexpr int PH = 8, NKEYS = 128, TOPK = 16, NEXP = 16384;
constexpr float EPS = 1e-6f;
constexpr int NTHREADS = 512, NWAVES = 8;

constexpr size_t WS_MOD   = 0;
constexpr size_t WS_ROPE  = WS_MOD + (size_t)NB * 6144 * 4;
constexpr size_t WS_WIN   = WS_ROPE + (size_t)SEQ * 32 * 8;
constexpr size_t WS_WOUT  = WS_WIN + (size_t)INC * DM * 2;
constexpr size_t WS_WQF   = WS_WOUT + (size_t)DM * DM * 2;
constexpr size_t WS_WS    = WS_WQF + (size_t)2048 * DM * 2;
constexpr size_t WS_ED    = WS_WS + (size_t)8 * 128 * 128 * 2;
constexpr size_t WS_EU    = WS_ED + (size_t)NEXP * DM;
constexpr size_t WS_SCD   = WS_EU + (size_t)NEXP * DM;
constexpr size_t WS_SCU   = WS_SCD + (size_t)NEXP * 4;
constexpr size_t WS_H     = WS_SCU + (size_t)NEXP * 4;
constexpr size_t WS_IDS   = WS_H + (size_t)T * DM * 2;
constexpr size_t WS_GATES = WS_IDS + (size_t)T * 128 * 4;
constexpr size_t WS_BIG   = WS_GATES + (size_t)T * 128 * 4;
constexpr size_t WS_PROJ  = WS_BIG;
constexpr size_t WS_YIN   = WS_PROJ + (size_t)T * INC * 2;
constexpr size_t WS_Y     = WS_YIN + (size_t)T * DM * 2;
constexpr size_t WS_SCT   = WS_BIG;
constexpr size_t WS_BAR   = WS_BIG + (size_t)2048 * T * 4;
constexpr size_t WS_BAR_BYTES = 16384;
constexpr size_t WS_HQ    = WS_BAR + WS_BAR_BYTES;
constexpr size_t WS_HS    = WS_HQ + (size_t)T * DM;
constexpr size_t WS_END   = WS_HS + (size_t)T * 4;

struct Params {
    const float* x; const float* c; const float* w_ada; const float* b_ada;
    const float* g_pre_mix; const float* g_post_mix; const float* g_pre_ffn; const float* g_post_ffn;
    const float* w_in; const float* w_s; const float* b_s; const float* sgu_ln_g; const float* sgu_ln_b;
    const float* sinks; const float* g_att_out; const float* g_sgu_out; const float* w_out;
    const float* w_query; const float* sub_keys; const float* expert_down; const float* expert_up;
    float* out; unsigned char* ws;
};

DI float bf2f(unsigned short u) { return __uint_as_float(((unsigned)u) << 16); }
DI float bflo(unsigned w) { return __uint_as_float(w << 16); }
DI float bfhi(unsigned w) { return __uint_as_float(w & 0xffff0000u); }
typedef __bf16 bf2_t __attribute__((ext_vector_type(2)));
typedef float f32x2 __attribute__((ext_vector_type(2)));
DI unsigned pk2(float lo, float hi) { const f32x2 v = {lo, hi}; return __builtin_bit_cast(unsigned, __builtin_convertvector(v, bf2_t)); }
DI unsigned short f2bf(float x) { return __builtin_bit_cast(unsigned short, (__bf16)x); }
DI float wave_sum(float v) {
#pragma unroll
    for (int o = 1; o < 64; o <<= 1) v += __shfl_xor(v, o);
    return v;
}
DI float gelu_exact(float v) { return 0.5f * v * (1.0f + erff(v * 0.70710678118654752f)); }
DI int opaque_tid() { int t = threadIdx.x; asm volatile("" : "+v"(t)); return t; }
DI int crow(int i, int h) { return (i & 3) + 8 * (i >> 2) + 4 * h; }
#define MFMA32(a, b, c) __builtin_amdgcn_mfma_f32_32x32x16_bf16((a), (b), (c), 0, 0, 0)

DI void p0_mod_item(const Params& p, int item, unsigned char* smem) {
    float* sc = (float*)smem;
    const int tid = opaque_tid(), w = tid >> 6, lane = tid & 63;
    for (int idx = tid; idx < 32 * 1024; idx += NTHREADS) {
        const int k = idx >> 5, b = idx & 31;
        const float v = p.c[b * 1024 + k];
        sc[k * 32 + b] = v / (1.0f + expf(-v));
    }
    __syncthreads();
    const int col = item * 64 + lane;
    float acc[32];
#pragma unroll
    for (int b = 0; b < 32; ++b) acc[b] = 0.f;
    for (int kk = 0; kk < 128; ++kk) {
        const int k = w * 128 + kk;
        const float wv = p.w_ada[(size_t)k * 6144 + col];
        const f32x4* sp = (const f32x4*)(sc + k * 32);
#pragma unroll
        for (int b4 = 0; b4 < 8; ++b4) {
            const f32x4 s = sp[b4];
            acc[4 * b4 + 0] += s[0] * wv; acc[4 * b4 + 1] += s[1] * wv; acc[4 * b4 + 2] += s[2] * wv; acc[4 * b4 + 3] += s[3] * wv;
        }
    }
    __syncthreads();
    float* red = (float*)smem;
#pragma unroll
    for (int b = 0; b < 32; ++b) red[(w * 32 + b) * 64 + lane] = acc[b];
    __syncthreads();
    float* mod = (float*)(p.ws + WS_MOD);
    for (int idx = tid; idx < 32 * 64; idx += NTHREADS) {
        const int b = idx >> 6, l = idx & 63;
        float s = 0.f;
#pragma unroll
        for (int ww = 0; ww < 8; ++ww) s += red[(ww * 32 + b) * 64 + l];
        const int cc = item * 64 + l;
        mod[b * 6144 + cc] = s + p.b_ada[cc];
    }
    __syncthreads();
}

DI void p0_fold_item(const Params& p, int item, unsigned char* smem) {
    const int hp = item >> 5, nt = (item >> 4) & 1, jt = item & 15;
    const int n0 = nt * 64, j0 = jt * 64;
    float* sk = (float*)smem;
    float* wq = sk + 64 * 132;
    const int tid = opaque_tid();
    for (int idx = tid; idx < 64 * 32; idx += NTHREADS) {
        const int r = idx >> 5, c4 = idx & 31;
        const f32x4 a = *(const f32x4*)(p.sub_keys + ((size_t)(hp * 128 + n0 + r) * 128 + c4 * 4));
        *(f32x4*)(sk + r * 132 + c4 * 4) = a;
        const f32x4 b = *(const f32x4*)(p.w_query + ((size_t)(j0 + r) * 2048 + hp * 128 + c4 * 4));
        *(f32x4*)(wq + r * 132 + c4 * 4) = b;
    }
    __syncthreads();
    const int tn = tid & 15, tj = tid >> 4;
    float acc[4][2];
#pragma unroll
    for (int a = 0; a < 4; ++a) { acc[a][0] = 0.f; acc[a][1] = 0.f; }
    for (int d = 0; d < 128; d += 4) {
        f32x4 av[4], bv[2];
#pragma unroll
        for (int a = 0; a < 4; ++a) av[a] = *(const f32x4*)(sk + (tn * 4 + a) * 132 + d);
#pragma unroll
        for (int b = 0; b < 2; ++b) bv[b] = *(const f32x4*)(wq + (tj * 2 + b) * 132 + d);
#pragma unroll
        for (int a = 0; a < 4; ++a)
#pragma unroll
            for (int b = 0; b < 2; ++b)
                acc[a][b] += av[a][0] * bv[b][0] + av[a][1] * bv[b][1] + av[a][2] * bv[b][2] + av[a][3] * bv[b][3];
    }
    bf16_t* wf = (bf16_t*)(p.ws + WS_WQF);
#pragma unroll
    for (int a = 0; a < 4; ++a) {
        const size_t row = (size_t)(hp * 128 + n0 + tn * 4 + a);
        *(unsigned*)(wf + row * 1024 + j0 + tj * 2) = pk2(acc[a][0], acc[a][1]);
    }
    __syncthreads();
}

DI void p0_transpose_item(const float* W, int K, int N, bf16_t* WT, int item, unsigned char* smem, bool permute) {
    const int ntn = N / 64, kb = item / ntn, nb = item % ntn, k0 = kb * 64, n0 = nb * 64;
    float* tile = (float*)smem;
    const int tid = opaque_tid();
    for (int idx = tid; idx < 64 * 64; idx += NTHREADS) {
        const int k = idx >> 6, n = idx & 63;
        tile[k * 65 + n] = W[(size_t)(k0 + k) * N + n0 + n];
    }
    __syncthreads();
    {
        const int n = tid >> 3, k8 = tid & 7;
        const float* s = tile + (k8 * 8) * 65 + n;
        u32x4 o;
        o[0] = pk2(s[0 * 65], s[1 * 65]); o[1] = pk2(s[2 * 65], s[3 * 65]); o[2] = pk2(s[4 * 65], s[5 * 65]); o[3] = pk2(s[6 * 65], s[7 * 65]);
        int nr = n0 + n;
        if (permute) { const int blk = (nr >> 4) & 3; if (blk == 1) nr += 16; else if (blk == 2) nr -= 16; }
        *(u32x4*)(WT + (size_t)nr * K + k0 + k8 * 8) = o;
    }
    __syncthreads();
}

DI void phase0(const Params& p, unsigned char* smem) {
    const int bid = blockIdx.x, G = gridDim.x, tid = opaque_tid();
    for (int it = bid; it < 96; it += G) p0_mod_item(p, it, smem);
    for (int it = G - 1 - bid; it < 512; it += G) p0_fold_item(p, it, smem);
    for (int it = bid; it < 16 * 28; it += G) p0_transpose_item(p.w_in, 1024, INC, (bf16_t*)(p.ws + WS_WIN), it, smem, true);
    for (int it = bid; it < 16 * 16; it += G) p0_transpose_item(p.w_out, 1024, 1024, (bf16_t*)(p.ws + WS_WOUT), it, smem, false);
    {
        const int lane = tid & 63, gw = bid * NWAVES + (tid >> 6), NW = G * NWAVES;
        for (int rr = gw; rr < 2 * NEXP; rr += NW) {
            const int tb = rr >= NEXP, e = rr - tb * NEXP;
            const float* row = (tb ? p.expert_up : p.expert_down) + (size_t)e * DM;
            unsigned char* dst = p.ws + (tb ? WS_EU : WS_ED) + (size_t)e * DM;
            float* scl = (float*)(p.ws + (tb ? WS_SCU : WS_SCD));
            f32x4 v[4]; float am = 0.f;
#pragma unroll
            for (int j = 0; j < 4; ++j) { v[j] = tb ? *(const f32x4*)(row + 256 * j + 4 * lane) : *(const f32x4*)(row + 16 * lane + 4 * j);
#pragma unroll
                for (int i = 0; i < 4; ++i) am = fmaxf(am, fabsf(v[j][i])); }
#pragma unroll
            for (int o = 1; o < 64; o <<= 1) am = fmaxf(am, __shfl_xor(am, o));
            const float sc = am > 0.f ? am * (tb ? (1.0f / 240.0f) : (1.0f / 127.0f)) : 1.0f, inv = 1.0f / sc;
            u32x4 o4;
#pragma unroll
            for (int j = 0; j < 4; ++j) {
                if (tb) {
                    int wv = 0;
                    wv = __builtin_amdgcn_cvt_pk_fp8_f32(v[j][0] * inv, v[j][1] * inv, wv, false);
                    wv = __builtin_amdgcn_cvt_pk_fp8_f32(v[j][2] * inv, v[j][3] * inv, wv, true);
                    o4[j] = (unsigned)wv;
                } else {
                    const int q0 = __float2int_rn(v[j][0] * inv), q1 = __float2int_rn(v[j][1] * inv), q2 = __float2int_rn(v[j][2] * inv), q3 = __float2int_rn(v[j][3] * inv);
                    o4[j] = (unsigned)(q0 & 255) | ((unsigned)(q1 & 255) << 8) | ((unsigned)(q2 & 255) << 16) | ((unsigned)(q3 & 255) << 24);
                }
            }
            *(u32x4*)(dst + 16 * lane) = o4;
            if (lane == 0) scl[e] = sc;
        }
    }
    {
        const int gt = bid * NTHREADS + tid, gsz = G * NTHREADS;
        float* rope = (float*)(p.ws + WS_ROPE);
        for (int i = gt; i < SEQ * 32; i += gsz) {
            const int pos = i >> 5, f = i & 31;
            const float inv = (float)pow(10000.0, -(double)f / 32.0);
            const float ang = (float)pos * inv;
            rope[2 * i] = (float)cos((double)ang); rope[2 * i + 1] = (float)sin((double)ang);
        }
        bf16_t* wsb = (bf16_t*)(p.ws + WS_WS);
        for (int i = gt; i < 8 * 128 * 128; i += gsz) {
            const int t = (i >> 7) & 127, s = i & 127;
            wsb[i] = (s <= t) ? f2bf(p.w_s[i]) : (bf16_t)0;
        }
    }
}

DI void load_row16(const float* row, int lane, float (&v)[16]) {
    const f32x4 a0 = *(const f32x4*)(row + lane * 8), a1 = *(const f32x4*)(row + lane * 8 + 4);
    const f32x4 b0 = *(const f32x4*)(row + 512 + lane * 8), b1 = *(const f32x4*)(row + 512 + lane * 8 + 4);
#pragma unroll
    for (int i = 0; i < 4; ++i) { v[i] = a0[i]; v[4 + i] = a1[i]; v[8 + i] = b0[i]; v[12 + i] = b1[i]; }
}
DI void load_row16_bf(const bf16_t* row, int lane, float (&v)[16]) {
    const u32x4 a = *(const u32x4*)(row + lane * 8), b = *(const u32x4*)(row + 512 + lane * 8);
#pragma unroll
    for (int i = 0; i < 4; ++i) { v[2 * i] = bflo(a[i]); v[2 * i + 1] = bfhi(a[i]); v[8 + 2 * i] = bflo(b[i]); v[8 + 2 * i + 1] = bfhi(b[i]); }
}
DI void store_row16_bf(bf16_t* row, int lane, const float (&v)[16]) {
    u32x4 a, b;
#pragma unroll
    for (int i = 0; i < 4; ++i) { a[i] = pk2(v[2 * i], v[2 * i + 1]); b[i] = pk2(v[8 + 2 * i], v[8 + 2 * i + 1]); }
    *(u32x4*)(row + lane * 8) = a; *(u32x4*)(row + 512 + lane * 8) = b;
}
DI void store_row16(float* row, int lane, const float (&v)[16]) {
    f32x4 a0, a1, b0, b1;
#pragma unroll
    for (int i = 0; i < 4; ++i) { a0[i] = v[i]; a1[i] = v[4 + i]; b0[i] = v[8 + i]; b1[i] = v[12 + i]; }
    *(f32x4*)(row + lane * 8) = a0; *(f32x4*)(row + lane * 8 + 4) = a1; *(f32x4*)(row + 512 + lane * 8) = b0; *(f32x4*)(row + 512 + lane * 8 + 4) = b1;
}

DI void phase1(const Params& p) {
    const int tid = opaque_tid(), lane = tid & 63, gw = blockIdx.x * NWAVES + (tid >> 6), NW = gridDim.x * NWAVES;
    const float* mod = (const float*)(p.ws + WS_MOD);
    bf16_t* h = (bf16_t*)(p.ws + WS_H);
    float g[16]; load_row16(p.g_pre_mix, lane, g);
    for (int t = gw; t < T; t += NW) {
        const int b = t >> 11;
        float v[16], sh[16], sc[16];
        load_row16(p.x + (size_t)t * DM, lane, v);
        load_row16(mod + b * 6144 + 0, lane, sh);
        load_row16(mod + b * 6144 + 1024, lane, sc);
        float ss = 0.f;
#pragma unroll
        for (int i = 0; i < 16; ++i) ss += v[i] * v[i];
        const float rstd = rsqrtf(wave_sum(ss) * (1.0f / DM) + EPS);
        float o[16];
#pragma unroll
        for (int i = 0; i < 16; ++i) o[i] = v[i] * rstd * g[i] * (1.0f + sc[i]) + sh[i];
        store_row16_bf(h + (size_t)t * DM, lane, o);
    }
}

DI void phase5(const Params& p) {
    const int tid = opaque_tid(), lane = tid & 63, gw = blockIdx.x * NWAVES + (tid >> 6), NW = gridDim.x * NWAVES;
    const float* mod = (const float*)(p.ws + WS_MOD);
    const bf16_t* y = (const bf16_t*)(p.ws + WS_Y);
    bf16_t* h = (bf16_t*)(p.ws + WS_H);
    float g1[16], g2[16]; load_row16(p.g_post_mix, lane, g1); load_row16(p.g_pre_ffn, lane, g2);
    for (int t = gw; t < T; t += NW) {
        const int b = t >> 11;
        float xv[16], yv[16], gt[16], sh[16], sc[16];
        load_row16(p.x + (size_t)t * DM, lane, xv);
        load_row16_bf(y + (size_t)t * DM, lane, yv);
        load_row16(mod + b * 6144 + 2048, lane, gt);
        load_row16(mod + b * 6144 + 3072, lane, sh);
        load_row16(mod + b * 6144 + 4096, lane, sc);
        float ss = 0.f;
#pragma unroll
        for (int i = 0; i < 16; ++i) ss += yv[i] * yv[i];
        const float rstd = rsqrtf(wave_sum(ss) * (1.0f / DM) + EPS);
        float x1[16]; float s1 = 0.f;
#pragma unroll
        for (int i = 0; i < 16; ++i) { x1[i] = xv[i] + gt[i] * (yv[i] * rstd * g1[i]); s1 += x1[i] * x1[i]; }
        store_row16(p.out + (size_t)t * DM, lane, x1);
        const float rstd1 = rsqrtf(wave_sum(s1) * (1.0f / DM) + EPS);
        float o[16];
#pragma unroll
        for (int i = 0; i < 16; ++i) o[i] = x1[i] * rstd1 * g2[i] * (1.0f + sc[i]) + sh[i];
        store_row16_bf(h + (size_t)t * DM, lane, o);
        float am = 0.f;
#pragma unroll
        for (int i = 0; i < 16; ++i) am = fmaxf(am, fabsf(o[i]));
#pragma unroll
        for (int of = 1; of < 64; of <<= 1) am = fmaxf(am, __shfl_xor(am, of));
        const float hsc = am > 0.f ? am * (1.0f / 127.0f) : 1.0f, hinv = 1.0f / hsc;
        int qi[16];
#pragma unroll
        for (int i = 0; i < 16; ++i) qi[i] = __float2int_rn(o[i] * hinv) & 255;
        u32x2 qa, qb;
        qa[0] = (unsigned)qi[0] | ((unsigned)qi[1] << 8) | ((unsigned)qi[2] << 16) | ((unsigned)qi[3] << 24);
        qa[1] = (unsigned)qi[4] | ((unsigned)qi[5] << 8) | ((unsigned)qi[6] << 16) | ((unsigned)qi[7] << 24);
        qb[0] = (unsigned)qi[8] | ((unsigned)qi[9] << 8) | ((unsigned)qi[10] << 16) | ((unsigned)qi[11] << 24);
        qb[1] = (unsigned)qi[12] | ((unsigned)qi[13] << 8) | ((unsigned)qi[14] << 16) | ((unsigned)qi[15] << 24);
        unsigned char* hq = p.ws + WS_HQ + (size_t)t * DM;
        *(u32x2*)(hq + lane * 8) = qa; *(u32x2*)(hq + 512 + lane * 8) = qb;
        if (lane == 0) ((float*)(p.ws + WS_HS))[t] = hsc;
    }
}

constexpr int G_BM = 256, G_BN = 128, G_BK = 64, G_LDS_ROW = 144;
constexpr int G_A_BYTES = G_BM * G_LDS_ROW, G_B_BYTES = G_BN * G_LDS_ROW, G_STAGE = G_A_BYTES + G_B_BYTES;
enum { EPI_PROJ = 0, EPI_BF16 = 1, EPI_F32 = 2 };

template <int EPI>
DI void gemm_epilogue(const Params& p, const f32x16 (&acc)[2][2], int m0, int n0, int N, void* Cv, int lane) {
    const int r = lane & 31, h = lane >> 5;
    if (EPI == EPI_F32) {
        float* C = (float*)Cv;
#pragma unroll
        for (int mi = 0; mi < 2; ++mi)
#pragma unroll
            for (int ni = 0; ni < 2; ++ni)
#pragma unroll
                for (int i = 0; i < 16; ++i) C[(size_t)(m0 + mi * 32 + crow(i, h)) * N + n0 + ni * 32 + r] = acc[mi][ni][i];
    } else if (EPI == EPI_BF16) {
        bf16_t* C = (bf16_t*)Cv;
#pragma unroll
        for (int mi = 0; mi < 2; ++mi)
#pragma unroll
            for (int ni = 0; ni < 2; ++ni)
#pragma unroll
                for (int i = 0; i < 16; ++i) C[(size_t)(m0 + mi * 32 + crow(i, h)) * N + n0 + ni * 32 + r] = f2bf(acc[mi][ni][i]);
    } else {
        bf16_t* C = (bf16_t*)Cv;
        const float* rope = (const float*)(p.ws + WS_ROPE);
        const bool is_rope = n0 < C_V, is_gelu = n0 >= C_U;
        const float qs = (n0 < C_K) ? 0.125f : 1.0f;
#pragma unroll
        for (int mi = 0; mi < 2; ++mi)
#pragma unroll
            for (int i = 0; i < 16; ++i) {
                const int row = m0 + mi * 32 + crow(i, h);
                float a = acc[mi][0][i], b = acc[mi][1][i];
                if (is_rope) {
                    const int pos = row & (SEQ - 1);
                    const float cs = rope[(pos * 32 + r) * 2], sn = rope[(pos * 32 + r) * 2 + 1];
                    const float ra = a * cs - b * sn, rb = b * cs + a * sn;
                    a = ra * qs; b = rb * qs;
                } else if (is_gelu) { a = gelu_exact(a); b = gelu_exact(b); }
                C[(size_t)row * N + n0 + r] = f2bf(a);
                C[(size_t)row * N + n0 + 32 + r] = f2bf(b);
            }
    }
}

template <int EPI, bool N_MAJOR>
DI void gemm_phase(const Params& p, const bf16_t* A, const bf16_t* Bt, int M, int N, int K, void* C, unsigned char* smem) {
    const int tid = threadIdx.x, w = tid >> 6, lane = tid & 63, r = lane & 31, h = lane >> 5;
    const int wm = w >> 1, wn = w & 1;
    const int nM = M / G_BM, nN = N / G_BN, total = nM * nN, G = gridDim.x;
    const int per = (total + G - 1) / G;
    int t_lo = blockIdx.x * per, t_hi = t_lo + per; if (t_hi > total) t_hi = total;
    const int nk = K / G_BK;
    for (int t = t_lo; t < t_hi; ++t) {
        int tm, tn;
        if (N_MAJOR) { tn = t / nM; tm = t % nM; } else { tm = t / nN; tn = t % nN; }
        const int bm0 = tm * G_BM, bn0 = tn * G_BN;
        f32x16 acc[2][2];
#pragma unroll
        for (int mi = 0; mi < 2; ++mi)
#pragma unroll
            for (int ni = 0; ni < 2; ++ni)
#pragma unroll
                for (int i = 0; i < 16; ++i) acc[mi][ni][i] = 0.f;
        u32x4 ra[4], rb[2];
#pragma unroll
        for (int i = 0; i < 4; ++i) { const int c = tid + i * NTHREADS; ra[i] = *(const u32x4*)(A + (size_t)(bm0 + (c >> 3)) * K + (c & 7) * 8); }
#pragma unroll
        for (int i = 0; i < 2; ++i) { const int c = tid + i * NTHREADS; rb[i] = *(const u32x4*)(Bt + (size_t)(bn0 + (c >> 3)) * K + (c & 7) * 8); }
#pragma unroll
        for (int i = 0; i < 4; ++i) { const int c = tid + i * NTHREADS; *(u32x4*)(smem + (c >> 3) * G_LDS_ROW + (c & 7) * 16) = ra[i]; }
#pragma unroll
        for (int i = 0; i < 2; ++i) { const int c = tid + i * NTHREADS; *(u32x4*)(smem + G_A_BYTES + (c >> 3) * G_LDS_ROW + (c & 7) * 16) = rb[i]; }
        __syncthreads();
        for (int kt = 0; kt < nk; ++kt) {
            const int cur = kt & 1;
            if (kt + 1 < nk) {
                const int k0 = (kt + 1) * G_BK;
#pragma unroll
                for (int i = 0; i < 4; ++i) { const int c = tid + i * NTHREADS; ra[i] = *(const u32x4*)(A + (size_t)(bm0 + (c >> 3)) * K + k0 + (c & 7) * 8); }
#pragma unroll
                for (int i = 0; i < 2; ++i) { const int c = tid + i * NTHREADS; rb[i] = *(const u32x4*)(Bt + (size_t)(bn0 + (c >> 3)) * K + k0 + (c & 7) * 8); }
            }
            const unsigned char* sa = smem + cur * G_STAGE + (wm * 64 + r) * G_LDS_ROW + h * 16;
            const unsigned char* sb = smem + cur * G_STAGE + G_A_BYTES + (wn * 64 + r) * G_LDS_ROW + h * 16;
#pragma unroll
            for (int ks = 0; ks < 4; ++ks) {
                bf16x8 af[2], bfr[2];
                af[0] = *(const bf16x8*)(sa + ks * 32); af[1] = *(const bf16x8*)(sa + 32 * G_LDS_ROW + ks * 32);
                bfr[0] = *(const bf16x8*)(sb + ks * 32); bfr[1] = *(const bf16x8*)(sb + 32 * G_LDS_ROW + ks * 32);
#pragma unroll
                for (int mi = 0; mi < 2; ++mi)
#pragma unroll
                    for (int ni = 0; ni < 2; ++ni) acc[mi][ni] = MFMA32(af[mi], bfr[ni], acc[mi][ni]);
            }
            if (kt + 1 < nk) {
                unsigned char* st = smem + (cur ^ 1) * G_STAGE;
#pragma unroll
                for (int i = 0; i < 4; ++i) { const int c = tid + i * NTHREADS; *(u32x4*)(st + (c >> 3) * G_LDS_ROW + (c & 7) * 16) = ra[i]; }
#pragma unroll
                for (int i = 0; i < 2; ++i) { const int c = tid + i * NTHREADS; *(u32x4*)(st + G_A_BYTES + (c >> 3) * G_LDS_ROW + (c & 7) * 16) = rb[i]; }
            }
            __syncthreads();
        }
        gemm_epilogue<EPI>(p, acc, bm0 + wm * 64, bn0 + wn * 64, N, C, lane);
    }
}

constexpr int P8_BM = 256, P8_BK = 64, P8_HALF = 128, P8_HT = P8_HALF * P8_BK;
DI int lds_byte(int r, int c) { const int st = (r >> 4) * 2 + (c >> 5), rr = r & 15, cc = c & 31, ob = rr * 64 + cc * 2; return st * 1024 + (ob ^ (((ob >> 9) & 1) << 5)); }
DI void stage_rc(int b, int& R, int& C) { const int st = b / 1024, sb = b % 1024, swz = sb ^ (((sb >> 9) & 1) << 5); R = (st >> 1) * 16 + swz / 64; C = (st & 1) * 32 + (swz % 64) / 2; }
typedef __attribute__((address_space(3))) unsigned char lds_u8;

template <int EPI>
DI void gemm8_epilogue(const Params& p, const f32x4 (&acc)[2][2][4][2], int brow, int bcol, int N, void* Cv, int wr, int wc, int fr, int fq) {
    if (EPI == EPI_F32) {
        float* C = (float*)Cv;
#pragma unroll
        for (int ai = 0; ai < 2; ++ai)
#pragma unroll
            for (int m = 0; m < 4; ++m) {
                float* rp = C + (size_t)(brow + ai * 128 + wr * 64 + m * 16 + fr) * N + bcol + wc * 32 + fq * 4;
#pragma unroll
                for (int bj = 0; bj < 2; ++bj)
#pragma unroll
                    for (int n = 0; n < 2; ++n) *(f32x4*)(rp + bj * 128 + n * 16) = acc[ai][bj][m][n];
            }
    } else if (EPI == EPI_BF16) {
        bf16_t* C = (bf16_t*)Cv;
#pragma unroll
        for (int ai = 0; ai < 2; ++ai)
#pragma unroll
            for (int m = 0; m < 4; ++m) {
                bf16_t* rp = C + (size_t)(brow + ai * 128 + wr * 64 + m * 16 + fr) * N + bcol + wc * 32 + fq * 4;
#pragma unroll
                for (int bj = 0; bj < 2; ++bj)
#pragma unroll
                    for (int n = 0; n < 2; ++n) {
                        const f32x4 v = acc[ai][bj][m][n];
                        u32x2 o; o[0] = pk2(v[0], v[1]); o[1] = pk2(v[2], v[3]);
                        *(u32x2*)(rp + bj * 128 + n * 16) = o;
                    }
            }
    } else {
        bf16_t* C = (bf16_t*)Cv;
        const float* rope = (const float*)(p.ws + WS_ROPE);
        const int d0 = (wc & 1) * 16 + fq * 4;
#pragma unroll
        for (int bj = 0; bj < 2; ++bj) {
            const int hc = bcol + bj * 128 + (wc >> 1) * 64;
            const bool is_rope = hc < C_V, is_gelu = hc >= C_U;
            const float qs = (hc < C_K) ? 0.125f : 1.0f;
#pragma unroll
            for (int ai = 0; ai < 2; ++ai)
#pragma unroll
                for (int m = 0; m < 4; ++m) {
                    const int row = brow + ai * 128 + wr * 64 + m * 16 + fr;
                    f32x4 a = acc[ai][bj][m][0], b = acc[ai][bj][m][1];
                    if (is_rope) {
                        const int pos = row & (SEQ - 1);
                        const f32x4 t0 = *(const f32x4*)(rope + (pos * 32 + d0) * 2), t1 = *(const f32x4*)(rope + (pos * 32 + d0) * 2 + 4);
                        const float cs[4] = {t0[0], t0[2], t1[0], t1[2]}, sn[4] = {t0[1], t0[3], t1[1], t1[3]};
#pragma unroll
                        for (int j = 0; j < 4; ++j) { const float ra = a[j] * cs[j] - b[j] * sn[j], rb = b[j] * cs[j] + a[j] * sn[j]; a[j] = ra * qs; b[j] = rb * qs; }
                    } else if (is_gelu) {
#pragma unroll
                        for (int j = 0; j < 4; ++j) { a[j] = gelu_exact(a[j]); b[j] = gelu_exact(b[j]); }
                    }
                    bf16_t* rp = C + (size_t)row * N + hc + d0;
                    u32x2 oa, ob; oa[0] = pk2(a[0], a[1]); oa[1] = pk2(a[2], a[3]); ob[0] = pk2(b[0], b[1]); ob[1] = pk2(b[2], b[3]);
                    *(u32x2*)(rp) = oa; *(u32x2*)(rp + 32) = ob;
                }
        }
    }
}

template <int EPI>
DI void gemm8_phase(const Params& p, const bf16_t* A, const bf16_t* Bt, int M, int N, int K, void* C, unsigned char* smem) {
    lds_u8* shm = (lds_u8*)smem;
#define SA(b, h) (shm + (((b) * 2 + (h)) * P8_HT) * 2)
#define SB(b, h) (shm + ((4 + (b) * 2 + (h)) * P8_HT) * 2)
#define STAGE(P, BASE, br, kt) do { const char* _sb = (const char*)(BASE) + ((long)(br) * K + (long)(kt) * P8_BK) * 2; \
      __builtin_amdgcn_global_load_lds((const unsigned*)(_sb + voff0), (__attribute__((address_space(3))) unsigned*)((P) + wbase), 16, 0, 0); \
      __builtin_amdgcn_global_load_lds((const unsigned*)(_sb + voff1), (__attribute__((address_space(3))) unsigned*)((P) + wbase + 8192), 16, 0, 0); } while (0)
#define LDA(dst, b, h) _Pragma("unroll") for (int m = 0; m < 4; ++m) _Pragma("unroll") for (int k = 0; k < 2; ++k) \
    dst[m][k] = *reinterpret_cast<const __attribute__((address_space(3))) bf16x8*>(SA(b, h) + lds_byte(wr * 64 + m * 16 + fr, k * 32 + fq * 8))
#define LDB(dst, b, h) _Pragma("unroll") for (int n = 0; n < 2; ++n) _Pragma("unroll") for (int k = 0; k < 2; ++k) \
    dst[n][k] = *reinterpret_cast<const __attribute__((address_space(3))) bf16x8*>(SB(b, h) + lds_byte(wc * 32 + n * 16 + fr, k * 32 + fq * 8))
#define MMA(ai, bj, At_, Bt_) do { __builtin_amdgcn_s_setprio(1); \
    _Pragma("unroll") for (int m = 0; m < 4; ++m) _Pragma("unroll") for (int n = 0; n < 2; ++n) _Pragma("unroll") for (int k = 0; k < 2; ++k) \
      acc[ai][bj][m][n] = __builtin_amdgcn_mfma_f32_16x16x32_bf16(Bt_[n][k], At_[m][k], acc[ai][bj][m][n], 0, 0, 0); \
    __builtin_amdgcn_s_setprio(0); } while (0)
#define WAIT_V(n) asm volatile("s_waitcnt vmcnt(" #n ")" ::: "memory")
#define WAIT_L(n) asm volatile("s_waitcnt lgkmcnt(" #n ")" ::: "memory")
#define BAR __builtin_amdgcn_s_barrier()
#define SCHED __builtin_amdgcn_sched_barrier(0)
    const int nM = M / P8_BM, nN = N / P8_BM, nwg = nM * nN, G = gridDim.x;
    const int tid = opaque_tid();
    const int wid = tid >> 6, lane = tid & 63, wr = wid >> 2, wc = wid & 3, fr = lane & 15, fq = lane >> 4;
    const int nt = K / P8_BK;
    unsigned voff0, voff1;
    const int wbase = __builtin_amdgcn_readfirstlane(tid >> 6) * 1024;
    { int r_, c_; stage_rc(tid * 16, r_, c_); voff0 = (unsigned)(r_ * K + c_) * 2u; stage_rc(tid * 16 + 8192, r_, c_); voff1 = (unsigned)(r_ * K + c_) * 2u; }
    for (int round = 0;; ++round) {
        const long L = (long)round * G + blockIdx.x;
        if (L >= nwg) break;
        int wgid = (int)L;
        { const int q = nwg / 8, r = nwg % 8, xcd = wgid % 8, off = wgid / 8; wgid = (xcd < r ? xcd * (q + 1) : r * (q + 1) + (xcd - r) * q) + off; }
        const int nig = 8 * nN, gid = wgid / nig, fm = gid * 8, gsz = (nM - fm) < 8 ? (nM - fm) : 8;
        const int pm = fm + ((wgid % nig) % gsz), pn = (wgid % nig) / gsz, brow = pm * P8_BM, bcol = pn * P8_BM;
        f32x4 acc[2][2][4][2];
#pragma unroll
        for (int a = 0; a < 2; ++a)
#pragma unroll
            for (int b = 0; b < 2; ++b)
#pragma unroll
                for (int m = 0; m < 4; ++m)
#pragma unroll
                    for (int n = 0; n < 2; ++n) acc[a][b][m][n] = (f32x4){0.f, 0.f, 0.f, 0.f};
        bf16x8 At[4][2], B0[2][2], B1[2][2];
        STAGE(SB(0, 0), Bt, bcol, 0); STAGE(SA(0, 0), A, brow, 0);
        STAGE(SB(0, 1), Bt, bcol + P8_HALF, 0); STAGE(SA(0, 1), A, brow + P8_HALF, 0);
        if (wr == 1) BAR;
        WAIT_V(4); BAR;
        STAGE(SB(1, 0), Bt, bcol, 1); STAGE(SA(1, 0), A, brow, 1); STAGE(SB(1, 1), Bt, bcol + P8_HALF, 1);
        WAIT_V(6); BAR;
        for (int t = 0; t < nt - 2; t += 2) {
            LDB(B0, 0, 0); SCHED; LDA(At, 0, 0); STAGE(SA(1, 1), A, brow + P8_HALF, t + 1);
            WAIT_L(8); BAR; WAIT_L(0); MMA(0, 0, At, B0); BAR; SCHED;
            LDB(B1, 0, 1); STAGE(SB(0, 0), Bt, bcol, t + 2);
            BAR; WAIT_L(0); MMA(0, 1, At, B1); BAR;
            LDA(At, 0, 1); STAGE(SA(0, 0), A, brow, t + 2);
            BAR; WAIT_L(0); MMA(1, 0, At, B0); BAR; SCHED;
            STAGE(SB(0, 1), Bt, bcol + P8_HALF, t + 2);
            WAIT_V(6); BAR; MMA(1, 1, At, B1); BAR;
            LDB(B0, 1, 0); SCHED; LDA(At, 1, 0); STAGE(SA(0, 1), A, brow + P8_HALF, t + 2);
            WAIT_L(8); BAR; WAIT_L(0); MMA(0, 0, At, B0); BAR; SCHED;
            LDB(B1, 1, 1); STAGE(SB(1, 0), Bt, bcol, t + 3);
            BAR; WAIT_L(0); MMA(0, 1, At, B1); BAR;
            LDA(At, 1, 1); STAGE(SA(1, 0), A, brow, t + 3);
            BAR; WAIT_L(0); MMA(1, 0, At, B0); BAR; SCHED;
            STAGE(SB(1, 1), Bt, bcol + P8_HALF, t + 3);
            WAIT_V(6); BAR; MMA(1, 1, At, B1); BAR;
        }
        { LDB(B0, 0, 0); LDA(At, 0, 0); STAGE(SA(1, 1), A, brow + P8_HALF, nt - 1);
          BAR; WAIT_L(0); MMA(0, 0, At, B0); BAR;
          LDB(B1, 0, 1); BAR; WAIT_L(0); MMA(0, 1, At, B1); BAR;
          LDA(At, 0, 1); WAIT_V(4); BAR; WAIT_L(0); MMA(1, 0, At, B0); MMA(1, 1, At, B1); BAR; }
        { LDB(B0, 1, 0); LDA(At, 1, 0); WAIT_V(2); BAR; WAIT_L(0); MMA(0, 0, At, B0); BAR;
          LDB(B1, 1, 1); WAIT_V(0); BAR; WAIT_L(0); MMA(0, 1, At, B1); BAR;
          LDA(At, 1, 1); BAR; WAIT_L(0); MMA(1, 0, At, B0); MMA(1, 1, At, B1); BAR; }
        if (wr == 0) BAR;
        gemm8_epilogue<EPI>(p, acc, brow, bcol, N, C, wr, wc, fr, fq);
    }
#undef SA
#undef SB
#undef STAGE
#undef LDA
#undef LDB
#undef MMA
}

constexpr int A_KROW = 144;
constexpr int A_VROW = 520;
constexpr int A_KS = 0;
constexpr int A_VT = 2 * 256 * A_KROW;
constexpr int S_VROW = 272;
constexpr int A_RED = 140288;
constexpr int A_LDS = A_RED + 2 * 8 * 32 * 4;

DI void head_norm_store(const f32x16 (&o)[2], const float* gvec, bf16_t* yrow, float* red, int w, int lane) {
    const int r = lane & 31, h = lane >> 5;
    float ss = 0.f;
#pragma unroll
    for (int dt = 0; dt < 2; ++dt)
#pragma unroll
        for (int i = 0; i < 16; ++i) ss += o[dt][i] * o[dt][i];
    ss += __shfl_xor(ss, 32);
    if (lane < 32) red[w * 32 + r] = ss;
    __syncthreads();
    float tot = 0.f;
#pragma unroll
    for (int ww = 0; ww < 8; ++ww) tot += red[ww * 32 + r];
    const float rstd = rsqrtf(tot * (1.0f / 512.0f) + EPS);
#pragma unroll
    for (int dt = 0; dt < 2; ++dt)
#pragma unroll
        for (int g4 = 0; g4 < 4; ++g4) {
            const int d = dt * 32 + 8 * g4 + 4 * h;
            const f32x4 gv = *(const f32x4*)(gvec + d);
            u32x2 pk;
            pk[0] = pk2(o[dt][4 * g4 + 0] * rstd * gv[0], o[dt][4 * g4 + 1] * rstd * gv[1]);
            pk[1] = pk2(o[dt][4 * g4 + 2] * rstd * gv[2], o[dt][4 * g4 + 3] * rstd * gv[3]);
            *(u32x2*)(yrow + d) = pk;
        }
}

DI bf16x8 pack8(const f32x16& x, int s) {
    u32x4 q;
    q[0] = pk2(x[8 * s + 0], x[8 * s + 1]); q[1] = pk2(x[8 * s + 2], x[8 * s + 3]);
    q[2] = pk2(x[8 * s + 4], x[8 * s + 5]); q[3] = pk2(x[8 * s + 6], x[8 * s + 7]);
    return __builtin_bit_cast(bf16x8, q);
}

DI void phase3(const Params& p, unsigned char* smem) {
    const int tid = opaque_tid(), w = tid >> 6, lane = tid & 63, r = lane & 31, h = lane >> 5;
    const bf16_t* proj = (const bf16_t*)(p.ws + WS_PROJ);
    const bf16_t* wsb = (const bf16_t*)(p.ws + WS_WS);
    bf16_t* yin = (bf16_t*)(p.ws + WS_YIN);
    float* red = (float*)(smem + A_RED);
    for (int item = blockIdx.x; item < NB * 16; item += gridDim.x) {
        const int nblk = item & 15;
        const int tok0 = item * 128;
        for (int c = tid; c < 2 * 256 * 8; c += NTHREADS) {
            const int g = c >> 11, key = (c >> 3) & 255, kc = c & 7;
            u32x4 kv = {0u, 0u, 0u, 0u}, vv = {0u, 0u, 0u, 0u};
            if (nblk > 0 || key >= 128) {
                const size_t base = (size_t)(tok0 - 128 + key) * INC + g * 64 + kc * 8;
                kv = *(const u32x4*)(proj + base + C_K);
                vv = *(const u32x4*)(proj + base + C_V);
            }
            *(u32x4*)(smem + A_KS + (g * 256 + key) * A_KROW + kc * 16) = kv;
            bf16_t* vt = (bf16_t*)(smem + A_VT + (g * 64 + kc * 8) * A_VROW) + key;
#pragma unroll
            for (int i = 0; i < 4; ++i) {
                vt[(2 * i) * (A_VROW / 2)] = (bf16_t)(vv[i] & 0xffffu);
                vt[(2 * i + 1) * (A_VROW / 2)] = (bf16_t)(vv[i] >> 16);
            }
        }
        __syncthreads();
        {
            const int g = w >> 2;
            const float sink = p.sinks[w];
            const unsigned char* kbase = smem + A_KS + (g * 256) * A_KROW;
            const unsigned char* vbase = smem + A_VT + (g * 64) * A_VROW;
            for (int qt = 0; qt < 4; ++qt) {
                const int tq = tok0 + qt * 32 + r;
                bf16x8 bq[4];
#pragma unroll
                for (int s = 0; s < 4; ++s) bq[s] = *(const bf16x8*)(proj + (size_t)tq * INC + w * 64 + s * 16 + h * 8);
                f32x16 sacc[5];
#pragma unroll
                for (int kt = 0; kt < 5; ++kt) {
#pragma unroll
                    for (int i = 0; i < 16; ++i) sacc[kt][i] = 0.f;
                    const unsigned char* kp = kbase + (qt * 32 + kt * 32 + r) * A_KROW + h * 16;
#pragma unroll
                    for (int s = 0; s < 4; ++s) {
                        const bf16x8 ka = *(const bf16x8*)(kp + s * 32);
                        sacc[kt] = MFMA32(ka, bq[s], sacc[kt]);
                    }
                }
                float mx = -INFINITY;
#pragma unroll
                for (int kt = 0; kt < 5; ++kt)
#pragma unroll
                    for (int i = 0; i < 16; ++i) {
                        const int diff = kt * 32 + crow(i, h) - r;
                        bool valid = (diff >= 1) && (diff <= 128);
                        if (nblk == 0) valid = valid && (qt * 32 + kt * 32 + crow(i, h) >= 128);
                        const float sv = valid ? sacc[kt][i] : -INFINITY;
                        sacc[kt][i] = sv;
                        mx = fmaxf(mx, sv);
                    }
                mx = fmaxf(mx, __shfl_xor(mx, 32));
                mx = fmaxf(mx, sink);
                float lsum = 0.f;
#pragma unroll
                for (int kt = 0; kt < 5; ++kt)
#pragma unroll
                    for (int i = 0; i < 16; ++i) { const float e = __expf(sacc[kt][i] - mx); sacc[kt][i] = e; lsum += e; }
                lsum += __shfl_xor(lsum, 32);
                lsum += __expf(sink - mx);
                const float inv_l = 1.0f / lsum;
                f32x16 o[2];
#pragma unroll
                for (int dt = 0; dt < 2; ++dt)
#pragma unroll
                    for (int i = 0; i < 16; ++i) o[dt][i] = 0.f;
#pragma unroll
                for (int kt = 0; kt < 5; ++kt)
#pragma unroll
                    for (int s = 0; s < 2; ++s) {
                        const bf16x8 pb = pack8(sacc[kt], s);
                        const int key0 = qt * 32 + kt * 32 + 16 * s + 4 * h;
#pragma unroll
                        for (int dt = 0; dt < 2; ++dt) {
                            const unsigned char* vp = vbase + (dt * 32 + r) * A_VROW + key0 * 2;
                            const s16x4 lo = *(const s16x4*)(vp), hi = *(const s16x4*)(vp + 16);
                            const bf16x8 va = __builtin_shufflevector(lo, hi, 0, 1, 2, 3, 4, 5, 6, 7);
                            o[dt] = MFMA32(va, pb, o[dt]);
                        }
                    }
#pragma unroll
                for (int dt = 0; dt < 2; ++dt)
#pragma unroll
                    for (int i = 0; i < 16; ++i) o[dt][i] *= inv_l;
                head_norm_store(o, p.g_att_out + w * 64, yin + (size_t)tq * DM + w * 64, red + (qt & 1) * 256, w, lane);
            }
        }
        __syncthreads();
        for (int rr = tid; rr < 128 * 8; rr += NTHREADS) {
            const int s = rr >> 3, hs = rr & 7;
            const bf16_t* src = proj + (size_t)(tok0 + s) * INC + C_VS + hs * 64;
            float v[64];
#pragma unroll
            for (int c = 0; c < 8; ++c) {
                const u32x4 q = *(const u32x4*)(src + c * 8);
#pragma unroll
                for (int i = 0; i < 4; ++i) { v[c * 8 + 2 * i] = bflo(q[i]); v[c * 8 + 2 * i + 1] = bfhi(q[i]); }
            }
            float mu = 0.f;
#pragma unroll
            for (int i = 0; i < 64; ++i) mu += v[i];
            mu *= (1.0f / 64.0f);
            float var = 0.f;
#pragma unroll
            for (int i = 0; i < 64; ++i) { const float d = v[i] - mu; var += d * d; }
            const float rstd = rsqrtf(var * (1.0f / 64.0f) + EPS);
            bf16_t* dst = (bf16_t*)(smem + (hs * 64) * S_VROW) + s;
#pragma unroll
            for (int i = 0; i < 64; ++i) {
                const float yv = (v[i] - mu) * rstd * p.sgu_ln_g[hs * 64 + i] + p.sgu_ln_b[hs * 64 + i];
                dst[i * (S_VROW / 2)] = f2bf(yv);
            }
        }
        __syncthreads();
        {
            const unsigned char* vb = smem + (w * 64) * S_VROW;
            for (int tt = 0; tt < 4; ++tt) {
                const int tl = tt * 32 + r;
                f32x16 o[2];
#pragma unroll
                for (int dt = 0; dt < 2; ++dt)
#pragma unroll
                    for (int i = 0; i < 16; ++i) o[dt][i] = 0.f;
                const bf16_t* wrow = wsb + (size_t)(w * 128 + tl) * 128 + h * 8;
                const int nks = 2 * (tt + 1);
                for (int ks = 0; ks < nks; ++ks) {
                    const bf16x8 wb = *(const bf16x8*)(wrow + ks * 16);
#pragma unroll
                    for (int dt = 0; dt < 2; ++dt) {
                        const bf16x8 va = *(const bf16x8*)(vb + (dt * 32 + r) * S_VROW + (ks * 16 + h * 8) * 2);
                        o[dt] = MFMA32(va, wb, o[dt]);
                    }
                }
                const float bias = p.b_s[w * 128 + tl];
                const bf16_t* urow = proj + (size_t)(tok0 + tl) * INC + C_U + w * 64;
#pragma unroll
                for (int dt = 0; dt < 2; ++dt)
#pragma unroll
                    for (int g4 = 0; g4 < 4; ++g4) {
                        const u32x2 uu = *(const u32x2*)(urow + dt * 32 + 8 * g4 + 4 * h);
                        o[dt][4 * g4 + 0] = (o[dt][4 * g4 + 0] + bias) * bflo(uu[0]);
                        o[dt][4 * g4 + 1] = (o[dt][4 * g4 + 1] + bias) * bfhi(uu[0]);
                        o[dt][4 * g4 + 2] = (o[dt][4 * g4 + 2] + bias) * bflo(uu[1]);
                        o[dt][4 * g4 + 3] = (o[dt][4 * g4 + 3] + bias) * bfhi(uu[1]);
                    }
                head_norm_store(o, p.g_sgu_out + w * 64, yin + (size_t)(tok0 + tl) * DM + 512 + w * 64, red + (tt & 1) * 256, w, lane);
            }
        }
        __syncthreads();
    }
}

DI int f2key(float f) { const int b = __float_as_int(f); return b ^ ((b >> 31) & 0x7fffffff); }
DI float key2f(int k) { return __int_as_float(k ^ ((k >> 31) & 0x7fffffff)); }

DI void phase7(const Params& p) {
    const float* scT = (const float*)(p.ws + WS_SCT);
    int* ids = (int*)(p.ws + WS_IDS);
    float* gates = (float*)(p.ws + WS_GATES);
    const int gsz = gridDim.x * NTHREADS;
    for (int idx = blockIdx.x * NTHREADS + opaque_tid(); idx < T * PH; idx += gsz) {
        const int tok = idx & (T - 1), hd = idx >> 16;
        int a0[16], a1[16];
#pragma unroll
        for (int i = 0; i < 16; ++i) { a0[i] = INT_MIN; a1[i] = INT_MIN; }
        const float* s0 = scT + (size_t)(hd * 256) * T + tok;
        const float* s1 = s0 + (size_t)128 * T;
#pragma unroll 8
        for (int n = 0; n < 128; ++n) {
            int v0 = (f2key(s0[(size_t)n * T]) & ~127) | (127 - n);
            int v1 = (f2key(s1[(size_t)n * T]) & ~127) | (127 - n);
#pragma unroll
            for (int i = 0; i < 16; ++i) {
                const int m0 = max(a0[i], v0); v0 = min(a0[i], v0); a0[i] = m0;
                const int m1 = max(a1[i], v1); v1 = min(a1[i], v1); a1[i] = m1;
            }
        }
        float ts[16]; int tp[16];
#pragma unroll
        for (int i = 0; i < 16; ++i) { ts[i] = -INFINITY; tp[i] = 0; }
#pragma unroll
        for (int i = 0; i < 16; ++i) {
            const float vi = key2f(a0[i] & ~127);
            const int ni = 127 - (a0[i] & 127);
#pragma unroll
            for (int j = 0; j < 16; ++j) {
                if ((i + 1) * (j + 1) <= 16) {
                    float v = vi + key2f(a1[j] & ~127);
                    int pl = ni * 128 + (127 - (a1[j] & 127));
#pragma unroll
                    for (int k = 0; k < 16; ++k) {
                        const bool gt = v > ts[k];
                        const float nv = gt ? ts[k] : v; const int np = gt ? tp[k] : pl;
                        ts[k] = gt ? v : ts[k]; tp[k] = gt ? pl : tp[k];
                        v = nv; pl = np;
                    }
                }
            }
        }
        float e[16], sum = 0.f;
#pragma unroll
        for (int k = 0; k < 16; ++k) { e[k] = __expf(ts[k] - ts[0]); sum += e[k]; }
        const float inv = 1.0f / sum;
        int* ip = ids + (size_t)tok * 128 + hd * 16;
        float* gp = gates + (size_t)tok * 128 + hd * 16;
#pragma unroll
        for (int k4 = 0; k4 < 4; ++k4) {
            int4 iv = make_int4(tp[4 * k4], tp[4 * k4 + 1], tp[4 * k4 + 2], tp[4 * k4 + 3]);
            *(int4*)(ip + 4 * k4) = iv;
            f32x4 gv = {e[4 * k4] * inv, e[4 * k4 + 1] * inv, e[4 * k4 + 2] * inv, e[4 * k4 + 3] * inv};
            *(f32x4*)(gp + 4 * k4) = gv;
        }
    }
}

DI void load_rowP(const float* row, int lane, float (&v)[16]) {
#pragma unroll
    for (int j = 0; j < 4; ++j) { const f32x4 a = *(const f32x4*)(row + 256 * j + 4 * lane);
#pragma unroll
        for (int i = 0; i < 4; ++i) v[4 * j + i] = a[i]; }
}
DI void store_rowP(float* row, int lane, const float (&v)[16]) {
#pragma unroll
    for (int j = 0; j < 4; ++j) { f32x4 a;
#pragma unroll
        for (int i = 0; i < 4; ++i) a[i] = v[4 * j + i];
        *(f32x4*)(row + 256 * j + 4 * lane) = a; }
}
template <int M> DI int shxi(int v, int lane) {
    if constexpr (M < 32) return __builtin_amdgcn_ds_swizzle(v, (M << 10) | 0x1f);
    else return __builtin_amdgcn_ds_bpermute((lane ^ 32) << 2, v);
}
template <int M> DI float shxf(float v, int lane) { return __int_as_float(shxi<M>(__float_as_int(v), lane)); }
DI float wave_sum_l(float v, int lane) {
    v += shxf<1>(v, lane); v += shxf<2>(v, lane); v += shxf<4>(v, lane); v += shxf<8>(v, lane); v += shxf<16>(v, lane); v += shxf<32>(v, lane);
    return v;
}
DI int lane_id_fresh() { int l; asm volatile("v_mbcnt_lo_u32_b32 %0, -1, 0\n\tv_mbcnt_hi_u32_b32 %0, -1, %0" : "=v"(l)); return l; }
template <int K, int J>
DI void bitonic_step128(unsigned (&key)[8], int lane) {
    if constexpr (J >= 64) {
#pragma unroll
        for (int t = 0; t < 4; ++t) {
            const unsigned lo = min(key[2 * t], key[2 * t + 1]), hi = max(key[2 * t], key[2 * t + 1]);
            key[2 * t] = lo; key[2 * t + 1] = hi;
        }
    } else {
        const bool lower = (lane & J) == 0;
#pragma unroll
        for (int r = 0; r < 8; ++r) {
            const unsigned other = (unsigned)shxi<J>((int)key[r], lane);
            const bool up = (K >= 128) ? true : ((K == 64) ? ((r & 1) == 0) : ((lane & K) == 0));
            const unsigned mn = min(key[r], other), mx = max(key[r], other);
            key[r] = (lower == up) ? mn : mx;
        }
    }
}
template <int K, int J>
DI void bitonic_merge128(unsigned (&key)[8], int lane) {
    bitonic_step128<K, J>(key, lane);
    if constexpr (J > 1) bitonic_merge128<K, J / 2>(key, lane);
}
template <int K>
DI void bitonic_sort128(unsigned (&key)[8], int lane) {
    if constexpr (K > 2) bitonic_sort128<K / 2>(key, lane);
    bitonic_merge128<K, K / 2>(key, lane);
}

DI int reduce8i(const int (&part)[8], int lane) {
    int q4[4];
#pragma unroll
    for (int i = 0; i < 4; ++i) {
        const bool up = (lane & 32) != 0;
        const int send = up ? part[i] : part[i + 4];
        const int keep = up ? part[i + 4] : part[i];
        q4[i] = keep + shxi<32>(send, lane);
    }
    int q2[2];
#pragma unroll
    for (int i = 0; i < 2; ++i) {
        const bool up = (lane & 16) != 0;
        const int send = up ? q4[i] : q4[i + 2];
        const int keep = up ? q4[i + 2] : q4[i];
        q2[i] = keep + shxi<16>(send, lane);
    }
    const bool up = (lane & 8) != 0;
    const int send = up ? q2[0] : q2[1];
    const int keep = up ? q2[1] : q2[0];
    int s1 = keep + shxi<8>(send, lane);
    s1 += shxi<4>(s1, lane); s1 += shxi<2>(s1, lane); s1 += shxi<1>(s1, lane);
    return s1;
}

DI void phase8(const Params& p, unsigned char* smem) {
    const int w = __builtin_amdgcn_readfirstlane(opaque_tid() >> 6);
    const unsigned char* hq = p.ws + WS_HQ;
    const float* hs = (const float*)(p.ws + WS_HS);
    const unsigned char* ed = p.ws + WS_ED;
    const unsigned char* eu = p.ws + WS_EU;
    const float* scd = (const float*)(p.ws + WS_SCD);
    const float* scu = (const float*)(p.ws + WS_SCU);
    const int* ids = (const int*)(p.ws + WS_IDS);
    const float* gates = (const float*)(p.ws + WS_GATES);
    const float* mod = (const float*)(p.ws + WS_MOD);
    unsigned char* hl = smem + w * 8192;
    unsigned* wq = (unsigned*)(p.ws + WS_BAR) + 3584;
#pragma unroll 1
    for (;;) {
        int grp = 0;
        if (lane_id_fresh() == 0) grp = (int)__hip_atomic_fetch_add(wq, 1u, __ATOMIC_RELAXED, __HIP_MEMORY_SCOPE_AGENT);
        grp = __builtin_amdgcn_readfirstlane(grp);
        if (grp >= T / 4) break;
        const int t0 = grp * 4;
        int lane = lane_id_fresh();
        unsigned key[8];
#pragma unroll
        for (int r = 0; r < 8; ++r) {
            const int tl = r >> 1, k = (r & 1) * 64 + lane;
            key[r] = ((unsigned)ids[(size_t)(t0 + tl) * 128 + k] << 7) | (unsigned)k;
        }
        bitonic_sort128<128>(key, lane);
        u32x4 hq4[4];
#pragma unroll
        for (int tl = 0; tl < 4; ++tl) hq4[tl] = *(const u32x4*)(hq + (size_t)(t0 + tl) * DM + lane * 16);
        float aval[8];
#pragma unroll
        for (int r = 0; r < 8; ++r) aval[r] = 0.f;
        {
            u32x4 bA[8], bB[8], bC[8];
#define DN_LOAD(BUF, BI) do { const bool h1_ = (BI) >= 32; \
                _Pragma("unroll") for (int j = 0; j < 8; ++j) { const unsigned ent = (unsigned)__builtin_amdgcn_readlane((int)(h1_ ? key[2 * (j & 3) + 1] : key[2 * (j & 3)]), ((2 * (BI)) & 63) + (j >> 2)); \
                    BUF[j] = *(const u32x4*)(ed + (size_t)(ent >> 7) * DM + 16 * lane); } } while (0)
#define DN_COMP(BUF, BI) do { int part[8]; \
                _Pragma("unroll") for (int j = 0; j < 8; ++j) { int a_ = 0; \
                    _Pragma("unroll") for (int q = 0; q < 4; ++q) a_ = __builtin_amdgcn_sdot4((int)BUF[j][q], (int)hq4[j & 3][q], a_, false); \
                    part[j] = a_; } \
                const float s1 = (float)reduce8i(part, lane);                                      \
                const bool mine_ = (lane >> 1) == ((BI) & 31); const bool h1c_ = (BI) >= 32; \
                _Pragma("unroll") for (int tl = 0; tl < 4; ++tl) { \
                    const float v_ = __int_as_float(__builtin_amdgcn_ds_bpermute((8 * (4 * (lane & 1) + tl)) << 2, __float_as_int(s1))); \
                    aval[2 * tl] = (mine_ && !h1c_) ? v_ : aval[2 * tl]; aval[2 * tl + 1] = (mine_ && h1c_) ? v_ : aval[2 * tl + 1]; } } while (0)
            DN_LOAD(bA, 0); DN_LOAD(bB, 1);
#pragma unroll 1
            for (int bi = 0; bi < 63; bi += 3) {
                DN_LOAD(bC, bi + 2); DN_COMP(bA, bi);
                DN_LOAD(bA, bi + 3); DN_COMP(bB, bi + 1);
                if (bi + 4 < 64) DN_LOAD(bB, bi + 4);
                DN_COMP(bC, bi + 2);
            }
            DN_COMP(bA, 63);
#undef DN_LOAD
#undef DN_COMP
        }
        float cfv[8];
#pragma unroll
        for (int r = 0; r < 8; ++r) {
            const int tl = r >> 1, e = key[r] >> 7, k = key[r] & 127;
            cfv[r] = gates[(size_t)(t0 + tl) * 128 + k] * gelu_exact(aval[r] * hs[t0 + tl] * scd[e]) * scu[e];
        }
        lane = lane_id_fresh();
        f32x2 acc[4][8];
#pragma unroll
        for (int a = 0; a < 4; ++a)
#pragma unroll
            for (int b = 0; b < 8; ++b) acc[a][b] = (f32x2){0.f, 0.f};
        {
            u32x4 rA[4], rB[4], rC[4];
#define UP_LOAD(ROWS, RI) do { const bool h1_ = (RI) >= 64; \
                _Pragma("unroll") for (int tl = 0; tl < 4; ++tl) { const unsigned ent = (unsigned)__builtin_amdgcn_readlane((int)(h1_ ? key[2 * tl + 1] : key[2 * tl]), (RI) & 63); \
                    ROWS[tl] = *(const u32x4*)(eu + (size_t)(ent >> 7) * DM + 16 * lane); } } while (0)
#define UP_COMP(ROWS, RI) do { const bool h1_ = (RI) >= 64; \
                _Pragma("unroll") for (int tl = 0; tl < 4; ++tl) { \
                    const float cf_ = __int_as_float(__builtin_amdgcn_readlane(__float_as_int(h1_ ? cfv[2 * tl + 1] : cfv[2 * tl]), (RI) & 63)); \
                    const f32x2 cf2 = {cf_, cf_}; \
                    _Pragma("unroll") for (int q = 0; q < 4; ++q) { \
                        const f32x2 lo = __builtin_amdgcn_cvt_pk_f32_fp8(ROWS[tl][q], false), hi = __builtin_amdgcn_cvt_pk_f32_fp8(ROWS[tl][q], true); \
                        acc[tl][2 * q] = __builtin_elementwise_fma(lo, cf2, acc[tl][2 * q]); acc[tl][2 * q + 1] = __builtin_elementwise_fma(hi, cf2, acc[tl][2 * q + 1]); } } } while (0)
            UP_LOAD(rA, 0); UP_LOAD(rB, 1);
#pragma unroll 1
            for (int ri = 0; ri < 126; ri += 3) {
                UP_LOAD(rC, ri + 2); UP_COMP(rA, ri);
                UP_LOAD(rA, ri + 3); UP_COMP(rB, ri + 1);
                UP_LOAD(rB, ri + 4); UP_COMP(rC, ri + 2);
            }
            UP_COMP(rA, 126); UP_COMP(rB, 127);
#undef UP_LOAD
#undef UP_COMP
        }
        lane = lane_id_fresh();
        const int b = t0 >> 11;
        float gpost[16], gt[16];
        load_rowP(p.g_post_ffn, lane, gpost);
        load_rowP(mod + b * 6144 + 5120, lane, gt);
#pragma unroll
        for (int tl = 0; tl < 4; ++tl) {
            float y2[16];
#pragma unroll
            for (int q = 0; q < 4; ++q) { y2[4 * q] = acc[tl][2 * q][0]; y2[4 * q + 1] = acc[tl][2 * q][1]; y2[4 * q + 2] = acc[tl][2 * q + 1][0]; y2[4 * q + 3] = acc[tl][2 * q + 1][1]; }
            float ss = 0.f;
#pragma unroll
            for (int i = 0; i < 16; ++i) ss += y2[i] * y2[i];
            const float rstd = rsqrtf(wave_sum_l(ss, lane) * (1.0f / DM) + EPS);
            float x1[16];
            load_rowP(p.out + (size_t)(t0 + tl) * DM, lane, x1);
            float o[16];
#pragma unroll
            for (int i = 0; i < 16; ++i) o[i] = x1[i] + gt[i] * (y2[i] * rstd * gpost[i]);
            store_rowP(p.out + (size_t)(t0 + tl) * DM, lane, o);
        }
    }
}

#ifdef PROBE_RANGE
DI void probe_gather(const Params& p, int range_mask) {
    const int w = __builtin_amdgcn_readfirstlane(opaque_tid() >> 6);
    const int lane = lane_id_fresh();
    const unsigned char* eu = p.ws + WS_EU;
    const unsigned gwv = blockIdx.x * NWAVES + w;
    const unsigned long long t0 = __builtin_amdgcn_s_memrealtime();
    unsigned sink = 0;
    unsigned state = gwv * 2654435761u + 12345u;
    for (int it = 0; it < 512; ++it) {
        u32x4 rows[16];
#pragma unroll
        for (int j = 0; j < 16; ++j) {
            state = state * 1664525u + 1013904223u;
            const unsigned e = (state >> 10) & (unsigned)range_mask;
            rows[j] = *(const u32x4*)(eu + (size_t)e * DM + 16 * lane);
        }
#pragma unroll
        for (int j = 0; j < 16; ++j) sink += rows[j][0] ^ rows[j][1] ^ rows[j][2] ^ rows[j][3];
    }
    asm volatile("" :: "v"(sink));
    const unsigned long long t1 = __builtin_amdgcn_s_memrealtime();
    if (blockIdx.x == 0 && w == 0 && lane == 0) p.out[0] += (float)(t1 - t0) * (1.0f / 10000.0f);
}
#endif
#define XB_TMO      128
#define XB_XCNT(j)  (256  + 64 * (j))
#define XB_XSUB(j)  (1280 + 64 * (j))
#define XB_XGEN(j)  (2304 + 64 * (j))
#define XB_TOP      3328
#define XB_TOPGEN   3392
#define XCD_BAR_WORDS 3456
#define XB_SPIN_CAP (1u << 22)
DI unsigned xb_ld(unsigned* p)              { return __hip_atomic_load(p, __ATOMIC_RELAXED, __HIP_MEMORY_SCOPE_AGENT); }
DI unsigned xb_add(unsigned* p, unsigned v) { return __hip_atomic_fetch_add(p, v, __ATOMIC_RELAXED, __HIP_MEMORY_SCOPE_AGENT); }
DI unsigned xb_xcc_id() { return (unsigned)__builtin_amdgcn_s_getreg((3 << 11) | 20) & 0xFu; }
#define XB_SPIN(cond, bar) do { unsigned _sp = 0; while (cond) { __builtin_amdgcn_s_sleep(1); \
    if ((++_sp & 255u) == 0u) { if (xb_ld(&(bar)[XB_TMO])) break; if (_sp > XB_SPIN_CAP) { atomicAdd(&(bar)[XB_TMO], 1u); break; } } } } while (0)
struct XcdBarrier { unsigned* bar; unsigned x; volatile unsigned* st; };
DI XcdBarrier xcd_barrier_post(unsigned* bar, volatile unsigned* st) {
    XcdBarrier b; b.bar = bar; b.x = xb_xcc_id(); b.st = st;
    if (threadIdx.x == 0) (void)xb_add(&bar[XB_XCNT(b.x)], 1u);
    return b;
}
DI void xcd_barrier_complete(unsigned* bar, unsigned x, unsigned& nloc, unsigned& nx) {
    const unsigned G = gridDim.x;
    unsigned sum, cnt, mine, sp = 0u;
    for (;;) {
        sum = 0u; cnt = 0u; mine = 0u;
#pragma unroll
        for (unsigned j = 0; j < 16; ++j) { const unsigned c = xb_ld(&bar[XB_XCNT(j)]); sum += c; cnt += (c > 0u) ? 1u : 0u; mine = (j == x) ? c : mine; }
        if (sum == G) break;
        __builtin_amdgcn_s_sleep(1);
        if ((++sp & 255u) == 0u) { if (xb_ld(&bar[XB_TMO])) break; if (sp > XB_SPIN_CAP) { atomicAdd(&bar[XB_TMO], 1u); break; } }
    }
    nloc = mine > 0u ? mine : 1u; nx = cnt > 0u ? cnt : 1u;
}
DI void xcd_barrier(const XcdBarrier& b) {
    asm volatile("s_waitcnt vmcnt(0)" ::: "memory");
    __syncthreads();
    if (threadIdx.x == 0) {
        unsigned* bar = b.bar;
        __builtin_amdgcn_s_waitcnt(0);
        unsigned nloc = b.st[0], nx = b.st[1];
        if (nloc == 0u) { xcd_barrier_complete(bar, b.x, nloc, nx); b.st[0] = nloc; b.st[1] = nx; }
        const unsigned old = xb_add(&bar[XB_XSUB(b.x)], 1u);
        const unsigned gen = old / nloc;
        if (old + 1u == (gen + 1u) * nloc) {
            __builtin_amdgcn_fence(__ATOMIC_RELEASE, "agent");
            asm volatile("s_waitcnt vmcnt(0)" ::: "memory");
            const unsigned og = xb_add(&bar[XB_TOP], 1u);
            const unsigned tg = og / nx;
            if (og + 1u == (tg + 1u) * nx) xb_add(&bar[XB_TOPGEN], 1u);
            else XB_SPIN(xb_ld(&bar[XB_TOPGEN]) == tg, bar);
            __builtin_amdgcn_fence(__ATOMIC_ACQUIRE, "agent");
            xb_add(&bar[XB_XGEN(b.x)], 1u);
            asm volatile("s_waitcnt vmcnt(0)" ::: "memory");
        } else {
            XB_SPIN(xb_ld(&bar[XB_XGEN(b.x)]) == gen, bar);
            __builtin_amdgcn_fence(__ATOMIC_ACQUIRE, "agent");
            asm volatile("s_waitcnt vmcnt(0)" ::: "memory");
        }
    }
    __syncthreads();
}

constexpr int LDS_BYTES = 147456;

template <int PHS>
DI void run_phase(const Params& p, unsigned char* smem) {
    if (PHS == 0) phase0(p, smem);
    else if (PHS == 1) phase1(p);
    else if (PHS == 2) gemm8_phase<EPI_PROJ>(p, (const bf16_t*)(p.ws + WS_H), (const bf16_t*)(p.ws + WS_WIN), T, INC, DM, p.ws + WS_PROJ, smem);
    else if (PHS == 3) phase3(p, smem);
    else if (PHS == 4) gemm8_phase<EPI_BF16>(p, (const bf16_t*)(p.ws + WS_YIN), (const bf16_t*)(p.ws + WS_WOUT), T, DM, DM, p.ws + WS_Y, smem);
    else if (PHS == 5) phase5(p);
    else if (PHS == 6) gemm8_phase<EPI_F32>(p, (const bf16_t*)(p.ws + WS_WQF), (const bf16_t*)(p.ws + WS_H), 2048, T, DM, p.ws + WS_SCT, smem);
    else if (PHS == 7) phase7(p);
    else if (PHS == 8) phase8(p, smem);
}

template <int PHS>
__global__ void __launch_bounds__(NTHREADS) k_phase(Params p) {
    __shared__ __attribute__((aligned(16))) unsigned char smem[LDS_BYTES];
    run_phase<PHS>(p, smem);
}

__global__ void __launch_bounds__(NTHREADS) k_mega(Params p) {
    __shared__ __attribute__((aligned(16))) unsigned char smem[LDS_BYTES];
    cg::grid_group grid = cg::this_grid();
    volatile unsigned* st = (volatile unsigned*)(smem + LDS_BYTES - 16);
    if (threadIdx.x == 0) { st[0] = 0u; st[1] = 0u; }
    __syncthreads();
    const XcdBarrier xb = xcd_barrier_post((unsigned*)(p.ws + WS_BAR), st);
#ifndef DUP_MASK
#define DUP_MASK 0
#endif
#define RUNP(k) do { run_phase<k>(p, smem); xcd_barrier(xb); if ((DUP_MASK >> k) & 1) { run_phase<k>(p, smem); xcd_barrier(xb); } } while (0)
    run_phase<0>(p, smem); grid.sync();
    RUNP(1); RUNP(2); RUNP(3); RUNP(4); RUNP(5); RUNP(6); RUNP(7);
    run_phase<8>(p, smem);
#ifdef PROBE_RANGE
    xcd_barrier(xb); probe_gather(p, PROBE_RANGE);
#endif
}

template <int PHS>
static void launch_phase(const Params& p, int grid, hipStream_t stream) {
    hipLaunchKernelGGL(k_phase<PHS>, dim3(grid), dim3(NTHREADS), 0, stream, p);
}

extern "C" void kernel_launch(void* const* d_in, const int* in_sizes, int n_in, void* d_out, int out_size, void* d_ws, size_t ws_size, hipStream_t stream) {
    if (n_in != 21 || out_size != T * DM || ws_size < WS_END) {
        fprintf(stderr, "kernel_launch: unexpected shapes (n_in %d out %d ws %zu need %zu)\n", n_in, out_size, ws_size, (size_t)WS_END);
        return;
    }
    Params p{};
    const float** f = (const float**)&p;
    for (int i = 0; i < 21; ++i) f[i] = (const float*)d_in[i];
    p.out = (float*)d_out; p.ws = (unsigned char*)d_ws;
#if MULTI_LAUNCH
    const int grid = 256;
    launch_phase<0>(p, grid, stream); launch_phase<1>(p, grid, stream); launch_phase<2>(p, grid, stream);
    launch_phase<3>(p, grid, stream); launch_phase<4>(p, grid, stream); launch_phase<5>(p, grid, stream);
    launch_phase<6>(p, grid, stream); launch_phase<7>(p, grid, stream); launch_phase<8>(p, grid, stream);
#else
    static int grid = 0;
    if (!grid) {
        int dev = 0, cus = 0, per_cu = 0;
        (void)hipGetDevice(&dev);
        (void)hipDeviceGetAttribute(&cus, hipDeviceAttributeMultiprocessorCount, dev);
        (void)hipOccupancyMaxActiveBlocksPerMultiprocessor(&per_cu, (const void*)k_mega, NTHREADS, 0);
        if (per_cu < 1) { fprintf(stderr, "kernel_launch: occupancy query says %d blocks per CU\n", per_cu); per_cu = 1; }
        grid = cus;
    }
    (void)hipMemsetAsync((unsigned char*)d_ws + WS_BAR, 0, WS_BAR_BYTES, stream);
    void* args[] = {&p};
    hipError_t e = hipLaunchCooperativeKernel((const void*)k_mega, dim3(grid), dim3(NTHREADS), args, 0, stream);
    if (e != hipSuccess) fprintf(stderr, "cooperative launch failed: %s (grid %d)\n", hipGetErrorString(e), grid);
#endif
}
```

```cpp
#include <hip/hip_runtime.h>
#include <stdint.h>
#include <stdio.h>
#include <limits.h>

#define DI __device__ __forceinline__
typedef _Float16 h16x2 __attribute__((ext_vector_type(2)));
typedef unsigned short bf16_t;
typedef short bf16x8 __attribute__((ext_vector_type(8)));
typedef short s16x4 __attribute__((ext_vector_type(4)));
typedef float f32x16 __attribute__((ext_vector_type(16)));
typedef float f32x4 __attribute__((ext_vector_type(4)));
typedef unsigned u32x4 __attribute__((ext_vector_type(4)));
typedef int i32x4 __attribute__((ext_vector_type(4)));
typedef unsigned u32x2 __attribute__((ext_vector_type(2)));

constexpr int DM = 1024, NB = 32, SEQ = 2048, T = NB * SEQ;
constexpr int HD = 64, QH = 8, KVH = 2, WIN = 128;
constexpr int INC = 1792;
constexpr int C_K = 512, C_V = 640, C_U = 768, C_VS = 1280;
constexpr int PH = 8, NKEYS = 128, TOPK = 16, NEXP = 16384;
constexpr float EPS = 1e-6f;
constexpr int NTHREADS = 512, NWAVES = 8;

constexpr size_t WS_MOD   = 0;
constexpr size_t WS_ROPE  = WS_MOD + (size_t)NB * 6144 * 4;
constexpr size_t WS_WIN   = WS_ROPE + (size_t)SEQ * 32 * 8;
constexpr size_t WS_WOUT  = WS_WIN + (size_t)INC * DM * 2;
constexpr size_t WS_WQF   = WS_WOUT + (size_t)DM * DM * 2;
constexpr size_t WS_WS    = WS_WQF + (size_t)2048 * DM * 2;
constexpr size_t WS_ED    = WS_WS + (size_t)8 * 128 * 128 * 2;
constexpr size_t WS_EU    = WS_ED + (size_t)NEXP * DM;
constexpr size_t WS_SCD   = WS_EU + (size_t)NEXP * DM;
constexpr size_t WS_SCU   = WS_SCD + (size_t)NEXP * 4;
constexpr size_t WS_H     = WS_SCU + (size_t)NEXP * 4;
constexpr size_t WS_IDS   = WS_H + (size_t)T * DM * 2;
constexpr size_t WS_GATES = WS_IDS + (size_t)T * 128 * 4;
constexpr size_t WS_BIG   = WS_GATES + (size_t)T * 128 * 4;
constexpr size_t WS_PROJ  = WS_BIG;
constexpr size_t WS_YIN   = WS_PROJ + (size_t)T * INC * 2;
constexpr size_t WS_Y     = WS_YIN + (size_t)T * DM * 2;
constexpr size_t WS_SCT   = WS_BIG;
constexpr size_t WS_BAR   = WS_BIG + (size_t)2048 * T * 4;
constexpr size_t WS_BAR_BYTES = 16384;
constexpr size_t WS_HQ    = WS_BAR + WS_BAR_BYTES;
constexpr size_t WS_HS    = WS_HQ + (size_t)T * DM;
constexpr size_t WS_X1    = WS_HS + (size_t)T * 4;
constexpr size_t WS_SWIN  = WS_X1 + (size_t)T * DM * 2;
constexpr size_t WS_SWQF  = WS_SWIN + (size_t)INC * 4;
constexpr size_t WS_H1S   = WS_SWQF + (size_t)2048 * 4;
constexpr size_t WS_SWD   = WS_H1S + (size_t)T * 4;
constexpr size_t WS_RSW   = WS_SWD + (size_t)NEXP * 4;
constexpr size_t WS_END   = WS_RSW + (size_t)8 * 128 * 4;
constexpr size_t WS_WINF  = WS_BIG;
constexpr size_t WS_WQFF  = WS_WINF + (size_t)INC * DM * 4;

struct Params {
    const float* x; const float* c; const float* w_ada; const float* b_ada;
    const float* g_pre_mix; const float* g_post_mix; const float* g_pre_ffn; const float* g_post_ffn;
    const float* w_in; const float* w_s; const float* b_s; const float* sgu_ln_g; const float* sgu_ln_b;
    const float* sinks; const float* g_att_out; const float* g_sgu_out; const float* w_out;
    const float* w_query; const float* sub_keys; const float* expert_down; const float* expert_up;
    float* out; unsigned char* ws;
    int wid; int pad_;
};

DI float bf2f(unsigned short u) { return __uint_as_float(((unsigned)u) << 16); }
DI float bflo(unsigned w) { return __uint_as_float(w << 16); }
DI float bfhi(unsigned w) { return __uint_as_float(w & 0xffff0000u); }
typedef __bf16 bf2_t __attribute__((ext_vector_type(2)));
typedef float f32x2 __attribute__((ext_vector_type(2)));
DI unsigned pk2(float lo, float hi) { const f32x2 v = {lo, hi}; return __builtin_bit_cast(unsigned, __builtin_convertvector(v, bf2_t)); }
DI unsigned short f2bf(float x) { return __builtin_bit_cast(unsigned short, (__bf16)x); }
DI float wave_sum(float v) {
#define DPPF0(x, ctrl) __int_as_float(__builtin_amdgcn_update_dpp(0, __float_as_int(x), (ctrl), 0xf, 0xf, true))
    v += DPPF0(v, 0xB1); v += DPPF0(v, 0x4E); v += DPPF0(v, 0x141); v += DPPF0(v, 0x140);
#undef DPPF0
    { const auto r = __builtin_amdgcn_permlane16_swap(__float_as_uint(v), __float_as_uint(v), false, false); v = __uint_as_float(r[0]) + __uint_as_float(r[1]); }
    { const auto r = __builtin_amdgcn_permlane32_swap(__float_as_uint(v), __float_as_uint(v), false, false); v = __uint_as_float(r[0]) + __uint_as_float(r[1]); }
    return v;
}
DI float xor32_sum(float v) { const auto r = __builtin_amdgcn_permlane32_swap(__float_as_uint(v), __float_as_uint(v), false, false); return __uint_as_float(r[0]) + __uint_as_float(r[1]); }
DI float xor32_max(float v) { const auto r = __builtin_amdgcn_permlane32_swap(__float_as_uint(v), __float_as_uint(v), false, false); return fmaxf(__uint_as_float(r[0]), __uint_as_float(r[1])); }
DI float gelu_exact(float v) { return 0.5f * v * (1.0f + erff(v * 0.70710678118654752f)); }
DI f32x2 gelu_pk(f32x2 v) {
    f32x2 a; a[0] = fminf(fabsf(v[0]), 6.0f); a[1] = fminf(fabsf(v[1]), 6.0f);
    f32x2 q = a * (-0.000471244808f) + 0.00706394956f; q = q * a + (-0.0517577948f); q = q * a + (-0.460092465f); q = q * a + (-1.15072754f); q = q * a + (-1.00004939f);
    f32x2 e; e[0] = __builtin_amdgcn_exp2f(q[0]); e[1] = __builtin_amdgcn_exp2f(q[1]);
    const f32x2 m = a * e;
    f32x2 o; o[0] = fmaxf(v[0], 0.f) - m[0]; o[1] = fmaxf(v[1], 0.f) - m[1]; return o;
}
DI float gelu_as(float v) {
    const float a = fminf(fabsf(v), 6.0f);
    float q = a * (-0.000471244808f) + 0.00706394956f; q = q * a + (-0.0517577948f); q = q * a + (-0.460092465f); q = q * a + (-1.15072754f); q = q * a + (-1.00004939f);
    return fmaxf(v, 0.f) - a * __builtin_amdgcn_exp2f(q);
}
DI int lane_id_fresh() { int l; asm volatile("v_mbcnt_lo_u32_b32 %0, -1, 0\n\tv_mbcnt_hi_u32_b32 %0, -1, %0" : "=v"(l)); return l; }
DI int opaque_tid(const Params& p) { return p.wid * 64 + lane_id_fresh(); }
DI int crow(int i, int h) { return (i & 3) + 8 * (i >> 2) + 4 * h; }
#define MFMA32(a, b, c) __builtin_amdgcn_mfma_f32_32x32x16_bf16((a), (b), (c), 0, 0, 0)

DI void p0_mod_item(const Params& p, int item, unsigned char* smem) {
    float* sc = (float*)smem;
    const int tid = opaque_tid(p), w = tid >> 6, lane = tid & 63, cl = lane & 31, ks = w * 2 + (lane >> 5);
    const int col = item * 32 + cl;
    float wv[64];
#pragma unroll
    for (int kk = 0; kk < 64; ++kk) wv[kk] = p.w_ada[(size_t)(ks * 64 + kk) * 6144 + col];
    {
        const int kk = lane & 15, bb = lane >> 4;
#pragma unroll 8
        for (int it = 0; it < 64; ++it) {
            const int g = it * 8 + w, b = (g & 7) * 4 + bb, k = (g >> 3) * 16 + kk;
            const float v = p.c[b * 1024 + k];
            sc[k * 36 + b] = v / (1.0f + __expf(-v));
        }
    }
    __syncthreads();
    float acc[32];
#pragma unroll
    for (int b = 0; b < 32; ++b) acc[b] = 0.f;
#pragma unroll
    for (int kk = 0; kk < 64; ++kk) {
        const f32x4* sp = (const f32x4*)(sc + (ks * 64 + kk) * 36);
#pragma unroll
        for (int b4 = 0; b4 < 8; ++b4) {
            const f32x4 s = sp[b4];
            acc[4 * b4 + 0] += s[0] * wv[kk]; acc[4 * b4 + 1] += s[1] * wv[kk]; acc[4 * b4 + 2] += s[2] * wv[kk]; acc[4 * b4 + 3] += s[3] * wv[kk];
        }
    }
    __syncthreads();
    float* red = (float*)smem;
#pragma unroll
    for (int b = 0; b < 32; ++b) red[(ks * 32 + b) * 32 + cl] = acc[b];
    __syncthreads();
    float* mod = (float*)(p.ws + WS_MOD);
    for (int idx = tid; idx < 32 * 32; idx += NTHREADS) {
        const int b = idx >> 5, l = idx & 31;
        float s = 0.f;
#pragma unroll
        for (int q = 0; q < 16; ++q) s += red[(q * 32 + b) * 32 + l];
        const int cc = item * 32 + l;
        mod[b * 6144 + cc] = s + p.b_ada[cc];
    }
    __syncthreads();
}

DI void p0_fold_item(const Params& p, int item, unsigned char* smem) {
    const int hp = item >> 5, nt = (item >> 4) & 1, jt = item & 15;
    const int n0 = nt * 64, j0 = jt * 64;
    float* sk = (float*)smem;
    float* wq = sk + 64 * 132;
    const int tid = opaque_tid(p);
    for (int idx = tid; idx < 64 * 32; idx += NTHREADS) {
        const int r = idx >> 5, c4 = idx & 31;
        const f32x4 a = *(const f32x4*)(p.sub_keys + ((size_t)(hp * 128 + n0 + r) * 128 + c4 * 4));
        *(f32x4*)(sk + r * 132 + c4 * 4) = a;
        const f32x4 b = *(const f32x4*)(p.w_query + ((size_t)(j0 + r) * 2048 + hp * 128 + c4 * 4));
        *(f32x4*)(wq + r * 132 + c4 * 4) = b;
    }
    __syncthreads();
    const int tn = tid & 15, tj = tid >> 4;
    float acc[4][2];
#pragma unroll
    for (int a = 0; a < 4; ++a) { acc[a][0] = 0.f; acc[a][1] = 0.f; }
    for (int d = 0; d < 128; d += 4) {
        f32x4 av[4], bv[2];
#pragma unroll
        for (int a = 0; a < 4; ++a) av[a] = *(const f32x4*)(sk + (tn * 4 + a) * 132 + d);
#pragma unroll
        for (int b = 0; b < 2; ++b) bv[b] = *(const f32x4*)(wq + (tj * 2 + b) * 132 + d);
#pragma unroll
        for (int a = 0; a < 4; ++a)
#pragma unroll
            for (int b = 0; b < 2; ++b)
                acc[a][b] += av[a][0] * bv[b][0] + av[a][1] * bv[b][1] + av[a][2] * bv[b][2] + av[a][3] * bv[b][3];
    }
    float* wf = (float*)(p.ws + WS_WQFF);
#pragma unroll
    for (int a = 0; a < 4; ++a) {
        const size_t row = (size_t)(hp * 128 + n0 + tn * 4 + a);
        *(f32x2*)(wf + row * 1024 + j0 + tj * 2) = (f32x2){acc[a][0], acc[a][1]};
    }
    __syncthreads();
}

DI void p0_transpose_item(const Params& p, const float* W, int K, int N, bf16_t* WT, int item, unsigned char* smem, bool permute) {
    const int ntn = N / 64, kb = item / ntn, nb = item % ntn, k0 = kb * 64, n0 = nb * 64;
    float* tile = (float*)smem;
    const int tid = opaque_tid(p);
    for (int idx = tid; idx < 64 * 64; idx += NTHREADS) {
        const int k = idx >> 6, n = idx & 63;
        tile[k * 65 + n] = W[(size_t)(k0 + k) * N + n0 + n];
    }
    __syncthreads();
    {
        const int n = tid >> 3, k8 = tid & 7;
        const float* s = tile + (k8 * 8) * 65 + n;
        u32x4 o;
        o[0] = pk2(s[0 * 65], s[1 * 65]); o[1] = pk2(s[2 * 65], s[3 * 65]); o[2] = pk2(s[4 * 65], s[5 * 65]); o[3] = pk2(s[6 * 65], s[7 * 65]);
        int nr = n0 + n;
        if (permute) {
            const int blk = (nr >> 4) & 3; if (blk == 1) nr += 16; else if (blk == 2) nr -= 16;
            float* wt32 = (float*)(p.ws + WS_WINF) + (size_t)nr * K + k0 + k8 * 8;
            *(f32x4*)(wt32) = (f32x4){s[0 * 65], s[1 * 65], s[2 * 65], s[3 * 65]};
            *(f32x4*)(wt32 + 4) = (f32x4){s[4 * 65], s[5 * 65], s[6 * 65], s[7 * 65]};
        } else *(u32x4*)(WT + (size_t)nr * K + k0 + k8 * 8) = o;
    }
    __syncthreads();
}

DI void phase0(const Params& p, unsigned char* smem) {
    const int bid = blockIdx.x, G = gridDim.x, tid = opaque_tid(p);
    for (int it = bid; it < 192; it += G) p0_mod_item(p, it, smem);
    for (int it = G - 1 - bid; it < 512; it += G) p0_fold_item(p, it, smem);
    for (int it = bid; it < 16 * 28; it += G) p0_transpose_item(p, p.w_in, 1024, INC, (bf16_t*)(p.ws + WS_WIN), it, smem, true);
    for (int it = bid; it < 16 * 16; it += G) p0_transpose_item(p, p.w_out, 1024, 1024, (bf16_t*)(p.ws + WS_WOUT), it, smem, false);
    {
        const int lane = tid & 63, gw = bid * NWAVES + (tid >> 6), NW = G * NWAVES;
#pragma unroll 2
        for (int rr = gw; rr < 2 * NEXP; rr += NW) {
            const int tb = rr >= NEXP, e = rr - tb * NEXP;
            const float* row = (tb ? p.expert_up : p.expert_down) + (size_t)e * DM;
            float* scl = (float*)(p.ws + (tb ? WS_SCU : WS_SCD));
            f32x4 v[4]; float am = 0.f;
#pragma unroll
            for (int j = 0; j < 4; ++j) { v[j] = *(const f32x4*)(row + 256 * j + 4 * lane);
#pragma unroll
                for (int i = 0; i < 4; ++i) am = fmaxf(am, fabsf(v[j][i])); }
#pragma unroll
            for (int o = 1; o < 64; o <<= 1) am = fmaxf(am, __shfl_xor(am, o));
            const float sc = am > 0.f ? am * 0.1f : 1.0f, inv = 1.0f / sc;
            if (tb) {
                u32x2 o2 = {0u, 0u};
#pragma unroll
                for (int j = 0; j < 4; ++j)
#pragma unroll
                    for (int i = 0; i < 4; ++i) {
                        const int q = min(max(__float2int_rn(v[j][i] * inv), -8), 7);
                        o2[j >> 1] |= (unsigned)((i & 1) ? (q & 15) : (q + 8)) << (4 * (4 * (j & 1) + i));
                    }
                *(u32x2*)(p.ws + WS_EU + (size_t)e * (DM / 2) + 8 * lane) = o2;
            } else {
                u32x2 o2 = {0u, 0u}; int rs = 0;
#pragma unroll
                for (int j = 0; j < 4; ++j)
#pragma unroll
                    for (int i = 0; i < 4; ++i) {
                        const int q = min(max(__float2int_rn(v[j][i] * inv), -8), 7);
                        rs += q;
                        o2[j >> 1] |= (unsigned)(q & 15) << (4 * (4 * (j & 1) + i));
                    }
#pragma unroll
                for (int o = 1; o < 64; o <<= 1) rs += __shfl_xor(rs, o);
                *(u32x2*)(p.ws + WS_ED + (size_t)e * (DM / 2) + 8 * lane) = o2;
                if (lane == 0) ((float*)(p.ws + WS_SWD))[e] = (float)rs;
            }
            if (lane == 0) scl[e] = sc;
        }
    }
    {
        const int gt = bid * NTHREADS + tid, gsz = G * NTHREADS;
        float* rope = (float*)(p.ws + WS_ROPE);
        for (int i = gt; i < SEQ * 32; i += gsz) {
            const int pos = i >> 5, f = i & 31;
            const float inv = exp2f(-(float)f * (13.287712379549449f / 32.0f));
            const float ang = (float)pos * inv;
            float sn, cs; sincosf(ang, &sn, &cs);
            rope[2 * i] = cs; rope[2 * i + 1] = sn;
        }
        bf16_t* wsb = (bf16_t*)(p.ws + WS_WS);
        for (int i = gt; i < 8 * 128 * 128; i += gsz) {
            const int t = (i >> 7) & 127, s = i & 127;
            wsb[i] = (s <= t) ? f2bf(p.w_s[i]) : (bf16_t)0;
        }
        {
            const int lane = tid & 63, gwv = bid * NWAVES + (tid >> 6);
            if (gwv < 8 * 128) {
                const int t = gwv & 127;
                float sm = (lane <= t ? bf2f(f2bf(p.w_s[gwv * 128 + lane])) : 0.f) + (lane + 64 <= t ? bf2f(f2bf(p.w_s[gwv * 128 + 64 + lane])) : 0.f);
                sm = wave_sum(sm);
                if (lane == 0) ((float*)(p.ws + WS_RSW))[gwv] = sm;
            }
        }
    }
}

DI void load_row16(const float* row, int lane, float (&v)[16]) {
    const f32x4 a0 = *(const f32x4*)(row + lane * 8), a1 = *(const f32x4*)(row + lane * 8 + 4);
    const f32x4 b0 = *(const f32x4*)(row + 512 + lane * 8), b1 = *(const f32x4*)(row + 512 + lane * 8 + 4);
#pragma unroll
    for (int i = 0; i < 4; ++i) { v[i] = a0[i]; v[4 + i] = a1[i]; v[8 + i] = b0[i]; v[12 + i] = b1[i]; }
}
DI void load_row16_bf(const bf16_t* row, int lane, float (&v)[16]) {
    const u32x4 a = *(const u32x4*)(row + lane * 8), b = *(const u32x4*)(row + 512 + lane * 8);
#pragma unroll
    for (int i = 0; i < 4; ++i) { v[2 * i] = bflo(a[i]); v[2 * i + 1] = bfhi(a[i]); v[8 + 2 * i] = bflo(b[i]); v[8 + 2 * i + 1] = bfhi(b[i]); }
}
DI void store_row16_bf(bf16_t* row, int lane, const float (&v)[16]) {
    u32x4 a, b;
#pragma unroll
    for (int i = 0; i < 4; ++i) { a[i] = pk2(v[2 * i], v[2 * i + 1]); b[i] = pk2(v[8 + 2 * i], v[8 + 2 * i + 1]); }
    *(u32x4*)(row + lane * 8) = a; *(u32x4*)(row + 512 + lane * 8) = b;
}
DI void store_row16(float* row, int lane, const float (&v)[16]) {
    f32x4 a0, a1, b0, b1;
#pragma unroll
    for (int i = 0; i < 4; ++i) { a0[i] = v[i]; a1[i] = v[4 + i]; b0[i] = v[8 + i]; b1[i] = v[12 + i]; }
    *(f32x4*)(row + lane * 8) = a0; *(f32x4*)(row + lane * 8 + 4) = a1; *(f32x4*)(row + 512 + lane * 8) = b0; *(f32x4*)(row + 512 + lane * 8 + 4) = b1;
}

DI void load_rowP(const float* row, int lane, float (&v)[16]) {
#pragma unroll
    for (int j = 0; j < 4; ++j) { const f32x4 a = *(const f32x4*)(row + 256 * j + 4 * lane);
#pragma unroll
        for (int i = 0; i < 4; ++i) v[4 * j + i] = a[i]; }
}
DI void store_rowP_nt(float* row, int lane, const float (&v)[16]) {
#pragma unroll
    for (int j = 0; j < 4; ++j) { f32x4 a;
#pragma unroll
        for (int i = 0; i < 4; ++i) a[i] = v[4 * j + i];
        __builtin_nontemporal_store(a, (f32x4*)(row + 256 * j + 4 * lane)); }
}
DI void store_rowP(float* row, int lane, const float (&v)[16]) {
#pragma unroll
    for (int j = 0; j < 4; ++j) { f32x4 a;
#pragma unroll
        for (int i = 0; i < 4; ++i) a[i] = v[4 * j + i];
        *(f32x4*)(row + 256 * j + 4 * lane) = a; }
}
DI void load_rowP_bf(const bf16_t* row, int lane, float (&v)[16]) {
#pragma unroll
    for (int j = 0; j < 4; ++j) { const u32x2 a = *(const u32x2*)(row + 256 * j + 4 * lane); v[4 * j] = bflo(a[0]); v[4 * j + 1] = bfhi(a[0]); v[4 * j + 2] = bflo(a[1]); v[4 * j + 3] = bfhi(a[1]); }
}
DI void store_rowP_bf(bf16_t* row, int lane, const float (&v)[16]) {
#pragma unroll
    for (int j = 0; j < 4; ++j) { u32x2 a; a[0] = pk2(v[4 * j], v[4 * j + 1]); a[1] = pk2(v[4 * j + 2], v[4 * j + 3]); *(u32x2*)(row + 256 * j + 4 * lane) = a; }
}
#define DPPF(v, ctrl) __int_as_float(__builtin_amdgcn_update_dpp(0, __float_as_int(v), (ctrl), 0xf, 0xf, true))
DI float wave_sum_fast(float v, int lane) {
    v += DPPF(v, 0xB1); v += DPPF(v, 0x4E); v += DPPF(v, 0x141); v += DPPF(v, 0x140);
    { const auto r = __builtin_amdgcn_permlane16_swap(__float_as_uint(v), __float_as_uint(v), false, false); v = __uint_as_float(r[0]) + __uint_as_float(r[1]); }
    { const auto r = __builtin_amdgcn_permlane32_swap(__float_as_uint(v), __float_as_uint(v), false, false); v = __uint_as_float(r[0]) + __uint_as_float(r[1]); }
    return v;
}
DI float wave_max_fast(float v, int lane) {
    v = fmaxf(v, DPPF(v, 0xB1)); v = fmaxf(v, DPPF(v, 0x4E)); v = fmaxf(v, DPPF(v, 0x141)); v = fmaxf(v, DPPF(v, 0x140));
    { const auto r = __builtin_amdgcn_permlane16_swap(__float_as_uint(v), __float_as_uint(v), false, false); v = fmaxf(__uint_as_float(r[0]), __uint_as_float(r[1])); }
    { const auto r = __builtin_amdgcn_permlane32_swap(__float_as_uint(v), __float_as_uint(v), false, false); v = fmaxf(__uint_as_float(r[0]), __uint_as_float(r[1])); }
    return v;
}
DI int wave_sum_fast_i(int v) {
    v += __builtin_amdgcn_update_dpp(0, v, 0xB1, 0xf, 0xf, true); v += __builtin_amdgcn_update_dpp(0, v, 0x4E, 0xf, 0xf, true);
    v += __builtin_amdgcn_update_dpp(0, v, 0x141, 0xf, 0xf, true); v += __builtin_amdgcn_update_dpp(0, v, 0x140, 0xf, 0xf, true);
    { const auto r = __builtin_amdgcn_permlane16_swap((unsigned)v, (unsigned)v, false, false); v = (int)(r[0] + r[1]); }
    { const auto r = __builtin_amdgcn_permlane32_swap((unsigned)v, (unsigned)v, false, false); v = (int)(r[0] + r[1]); }
    return v;
}
DI void quant_row_i8(const float (&v)[16], int lane, unsigned char* dst, float* scale_out) {
    float am = 0.f;
#pragma unroll
    for (int i = 0; i < 16; ++i) am = fmaxf(am, fabsf(v[i]));
    am = wave_max_fast(am, lane);
    const float sc = am > 0.f ? am * (1.0f / 127.0f) : 1.0f, inv = 1.0f / sc;
    u32x4 o;
#pragma unroll
    for (int q = 0; q < 4; ++q) {
        const int q0 = __float2int_rn(v[4 * q] * inv), q1 = __float2int_rn(v[4 * q + 1] * inv), q2 = __float2int_rn(v[4 * q + 2] * inv), q3 = __float2int_rn(v[4 * q + 3] * inv);
        o[q] = (unsigned)(q0 & 255) | ((unsigned)(q1 & 255) << 8) | ((unsigned)(q2 & 255) << 16) | ((unsigned)(q3 & 255) << 24);
    }
    *(u32x4*)(dst + 16 * lane) = o;
    if (lane == 0) *scale_out = sc;
}
DI void phase1(const Params& p) {
    const int tid = opaque_tid(p), lane = tid & 63, gw = blockIdx.x * NWAVES + (tid >> 6), NW = gridDim.x * NWAVES;
    for (int rr = gw; rr < INC + 2048; rr += NW) {
        const bool fq_ = rr >= INC; const int row = fq_ ? rr - INC : rr;
        float v[16];
        load_rowP((const float*)(p.ws + (fq_ ? WS_WQFF : WS_WINF)) + (size_t)row * DM, lane, v);
        quant_row_i8(v, lane, p.ws + (fq_ ? WS_WQF : WS_WIN) + (size_t)row * DM, (float*)(p.ws + (fq_ ? WS_SWQF : WS_SWIN)) + row);
    }
    const float* mod = (const float*)(p.ws + WS_MOD);
    unsigned char* hq1 = p.ws + WS_H;
    float* hs1 = (float*)(p.ws + WS_H1S);
    const int per = T / NW;
    if (per * NW != T || (SEQ % per) != 0) return;
    const int tb = gw * per, b = tb >> 11;
    float g[16], sh[16], sc[16];
    load_rowP(p.g_pre_mix, lane, g); load_rowP(mod + b * 6144, lane, sh); load_rowP(mod + b * 6144 + 1024, lane, sc);
#pragma unroll
    for (int i = 0; i < 16; ++i) g[i] *= (1.0f + sc[i]);
    float v[16], nx[16];
    load_rowP(p.x + (size_t)tb * DM, lane, v);
#pragma unroll 1
    for (int k = 0; k < per; ++k) {
        const int t = tb + k;
        if (k + 1 < per) load_rowP(p.x + (size_t)(t + 1) * DM, lane, nx);
        float ss = 0.f;
#pragma unroll
        for (int i = 0; i < 16; ++i) ss += v[i] * v[i];
        const float rstd = rsqrtf(wave_sum_fast(ss, lane) * (1.0f / DM) + EPS);
        float o[16];
#pragma unroll
        for (int i = 0; i < 16; ++i) o[i] = v[i] * rstd * g[i] + sh[i];
        quant_row_i8(o, lane, hq1 + (size_t)t * DM, hs1 + t);
#pragma unroll
        for (int i = 0; i < 16; ++i) v[i] = nx[i];
    }
}

DI void phase5(const Params& p) {
    const int tid = opaque_tid(p), lane = tid & 63, gw = blockIdx.x * NWAVES + (tid >> 6), NW = gridDim.x * NWAVES;
    const float* mod = (const float*)(p.ws + WS_MOD);
    const bf16_t* y = (const bf16_t*)(p.ws + WS_Y);
    const int per = T / NW;
    if (per * NW != T || (SEQ % per) != 0) return;
    const int tb = gw * per, b = tb >> 11;
    float g1[16], g2[16], sh[16];
    {
        float gt[16], sc[16];
        load_rowP(p.g_post_mix, lane, g1); load_rowP(p.g_pre_ffn, lane, g2);
        load_rowP(mod + b * 6144 + 2048, lane, gt); load_rowP(mod + b * 6144 + 3072, lane, sh); load_rowP(mod + b * 6144 + 4096, lane, sc);
#pragma unroll
        for (int i = 0; i < 16; ++i) { g1[i] *= gt[i]; g2[i] *= (1.0f + sc[i]); }
    }
    float xv[16], yv[16], nxv[16], nyv[16];
    load_rowP(p.x + (size_t)tb * DM, lane, xv); load_rowP_bf(y + (size_t)tb * DM, lane, yv);
#pragma unroll 1
    for (int k = 0; k < per; ++k) {
        const int t = tb + k;
        if (k + 1 < per) { load_rowP(p.x + (size_t)(t + 1) * DM, lane, nxv); load_rowP_bf(y + (size_t)(t + 1) * DM, lane, nyv); }
        float ss = 0.f;
#pragma unroll
        for (int i = 0; i < 16; ++i) ss += yv[i] * yv[i];
        const float rstd = rsqrtf(wave_sum(ss) * (1.0f / DM) + EPS);
        float x1[16]; float s1 = 0.f;
#pragma unroll
        for (int i = 0; i < 16; ++i) { x1[i] = xv[i] + g1[i] * (yv[i] * rstd); s1 += x1[i] * x1[i]; }
        store_rowP_bf((bf16_t*)(p.ws + WS_X1) + (size_t)t * DM, lane, x1);
        const float rstd1 = rsqrtf(wave_sum(s1) * (1.0f / DM) + EPS);
        float o[16];
#pragma unroll
        for (int i = 0; i < 16; ++i) o[i] = x1[i] * rstd1 * g2[i] + sh[i];
#pragma unroll
        for (int i = 0; i < 16; ++i) { xv[i] = nxv[i]; yv[i] = nyv[i]; }
        quant_row_i8(o, lane, p.ws + WS_HQ + (size_t)t * DM, (float*)(p.ws + WS_HS) + t);
    }
}

enum { EPI_PROJ = 0, EPI_BF16 = 1, EPI_TOPK = 3 };

DI int f2key(float f) { const int b = __float_as_int(f); return b ^ ((b >> 31) & 0x7fffffff); }
DI float key2f(int k) { return __int_as_float(k ^ ((k >> 31) & 0x7fffffff)); }

DI void cex(int& a, int& b) { const int mx = max(a, b), mn = min(a, b); a = mx; b = mn; }
DI void sort16_desc(int (&v)[16]) {
#define CX(a, b) cex(v[a], v[b])
    CX(0, 13); CX(1, 12); CX(2, 15); CX(3, 14); CX(4, 8); CX(5, 6); CX(7, 11); CX(9, 10);
    CX(0, 5); CX(1, 7); CX(2, 9); CX(3, 4); CX(6, 13); CX(8, 14); CX(10, 15); CX(11, 12);
    CX(0, 1); CX(2, 3); CX(4, 5); CX(6, 8); CX(7, 9); CX(10, 11); CX(12, 13); CX(14, 15);
    CX(0, 2); CX(1, 3); CX(4, 10); CX(5, 11); CX(6, 7); CX(8, 9); CX(12, 14); CX(13, 15);
    CX(1, 2); CX(3, 12); CX(4, 6); CX(5, 7); CX(8, 10); CX(9, 11); CX(13, 14);
    CX(1, 4); CX(2, 6); CX(5, 8); CX(7, 10); CX(9, 13); CX(11, 14);
    CX(2, 4); CX(3, 6); CX(9, 12); CX(11, 13);
    CX(3, 5); CX(6, 8); CX(7, 9); CX(10, 12);
    CX(3, 4); CX(5, 6); CX(7, 8); CX(9, 10); CX(11, 12);
    CX(6, 7); CX(8, 9);
#undef CX
}
DI void merge_sorted16(int (&top)[16], const int (&v)[16]) {
#pragma unroll
    for (int i = 0; i < 16; ++i) top[i] = max(top[i], v[15 - i]);
#pragma unroll
    for (int j = 8; j > 0; j >>= 1)
#pragma unroll
        for (int i = 0; i < 16; ++i) { const int l = i ^ j; if (l > i) cex(top[i], top[l]); }
}
DI void merge_top16(int (&top)[16], int (&v)[16]) {
    sort16_desc(v);
#pragma unroll
    for (int i = 0; i < 16; ++i) top[i] = max(top[i], v[15 - i]);
#pragma unroll
    for (int j = 8; j > 0; j >>= 1)
#pragma unroll
        for (int i = 0; i < 16; ++i) { const int l = i ^ j; if (l > i) cex(top[i], top[l]); }
}

typedef unsigned short u16x2_t __attribute__((ext_vector_type(2)));
DI unsigned pkmax(unsigned a, unsigned b) { return __builtin_bit_cast(unsigned, __builtin_elementwise_max(__builtin_bit_cast(u16x2_t, a), __builtin_bit_cast(u16x2_t, b))); }
DI unsigned pkmin(unsigned a, unsigned b) { return __builtin_bit_cast(unsigned, __builtin_elementwise_min(__builtin_bit_cast(u16x2_t, a), __builtin_bit_cast(u16x2_t, b))); }
DI void pcex(unsigned& a, unsigned& b) { const unsigned mx = pkmax(a, b), mn = pkmin(a, b); a = mx; b = mn; }
DI void psort16_desc(unsigned (&v)[16]) {
#define CX(a, b) pcex(v[a], v[b])
    CX(0, 13); CX(1, 12); CX(2, 15); CX(3, 14); CX(4, 8); CX(5, 6); CX(7, 11); CX(9, 10);
    CX(0, 5); CX(1, 7); CX(2, 9); CX(3, 4); CX(6, 13); CX(8, 14); CX(10, 15); CX(11, 12);
    CX(0, 1); CX(2, 3); CX(4, 5); CX(6, 8); CX(7, 9); CX(10, 11); CX(12, 13); CX(14, 15);
    CX(0, 2); CX(1, 3); CX(4, 10); CX(5, 11); CX(6, 7); CX(8, 9); CX(12, 14); CX(13, 15);
    CX(1, 2); CX(3, 12); CX(4, 6); CX(5, 7); CX(8, 10); CX(9, 11); CX(13, 14);
    CX(1, 4); CX(2, 6); CX(5, 8); CX(7, 10); CX(9, 13); CX(11, 14);
    CX(2, 4); CX(3, 6); CX(9, 12); CX(11, 13);
    CX(3, 5); CX(6, 8); CX(7, 9); CX(10, 12);
    CX(3, 4); CX(5, 6); CX(7, 8); CX(9, 10); CX(11, 12);
    CX(6, 7); CX(8, 9);
#undef CX
}
DI void pmerge_top16(unsigned (&top)[16], unsigned (&v)[16]) {
    psort16_desc(v);
#pragma unroll
    for (int i = 0; i < 16; ++i) top[i] = pkmax(top[i], v[15 - i]);
#pragma unroll
    for (int j = 8; j > 0; j >>= 1)
#pragma unroll
        for (int i = 0; i < 16; ++i) { const int l = i ^ j; if (l > i) pcex(top[i], top[l]); }
}

DI constexpr int cand_cnt(int i) { return 16 / (i + 1); }
DI constexpr int cand_off(int i) { int o = 0; for (int k = 0; k < i; ++k) o += 16 / (k + 1); return o; }
DI int mux16(const int (&a)[16], int idx) {
    int t8[8], t4[4], t2[2];
    const int m0 = -(idx & 1), m1 = -((idx >> 1) & 1), m2 = -((idx >> 2) & 1), m3 = -((idx >> 3) & 1);
#pragma unroll
    for (int k = 0; k < 8; ++k) t8[k] = a[2 * k] ^ ((a[2 * k] ^ a[2 * k + 1]) & m0);
#pragma unroll
    for (int k = 0; k < 4; ++k) t4[k] = t8[2 * k] ^ ((t8[2 * k] ^ t8[2 * k + 1]) & m1);
#pragma unroll
    for (int k = 0; k < 2; ++k) t2[k] = t4[2 * k] ^ ((t4[2 * k] ^ t4[2 * k + 1]) & m2);
    return t2[0] ^ ((t2[0] ^ t2[1]) & m3);
}
DI void topk_second_level(const int (&a0)[16], const int (&a1)[16], int* ip, float* gp, bool desc, int swz) {
    int v0[16], v1[16], e0[16], e1[16];
#pragma unroll
    for (int i = 0; i < 16; ++i) { v0[i] = a0[i] >> 7; v1[i] = a1[i] >> 7; e0[i] = (127 - (a0[i] & 127)) << 7; e1[i] = 127 - (a1[i] & 127); }
    int top[16];
    {
        int blk[4][16];
#pragma unroll
        for (int i = 0; i < 16; ++i)
#pragma unroll
            for (int j = 0; j < 16; ++j)
                if (j < cand_cnt(i)) blk[(cand_off(i) + j) >> 4][(cand_off(i) + j) & 15] = ((v0[i] + v1[j]) << 16) | e0[i] | e1[j];
#pragma unroll
        for (int c = 50; c < 64; ++c) blk[c >> 4][c & 15] = INT_MIN;
        sort16_desc(blk[0]);
#pragma unroll
        for (int i = 0; i < 16; ++i) top[i] = blk[0][i];
        merge_top16(top, blk[1]); merge_top16(top, blk[2]); merge_top16(top, blk[3]);
    }
    float e[16], sum = 0.f;
    const float tmax = (float)(top[0] >> 16);
#pragma unroll
    for (int k = 0; k < 16; ++k) { e[k] = __expf(((float)(top[k] >> 16) - tmax) * (1.0f / 64.0f)); sum += e[k]; }
    const float inv = 1.0f / sum;
#pragma unroll
    for (int k4 = 0; k4 < 4; ++k4) {
        const f32x4 gv = {e[4 * k4] * inv, e[4 * k4 + 1] * inv, e[4 * k4 + 2] * inv, e[4 * k4 + 3] * inv};
        *(f32x4*)(gp + ((k4 ^ swz) * 4)) = gv;
    }
    int sid[16];
#pragma unroll
    for (int k = 0; k < 16; ++k) sid[k] = ((top[k] & 0x3fff) << 4) | k;
    sort16_desc(sid);
#pragma unroll
    for (int k4 = 0; k4 < 4; ++k4) {
        if (desc) *(int4*)(ip + ((k4 ^ swz) * 4)) = make_int4(sid[4 * k4], sid[4 * k4 + 1], sid[4 * k4 + 2], sid[4 * k4 + 3]);
        else *(int4*)(ip + ((k4 ^ swz) * 4)) = make_int4(sid[15 - 4 * k4], sid[14 - 4 * k4], sid[13 - 4 * k4], sid[12 - 4 * k4]);
    }
}

constexpr int A_FAC = 140288;
constexpr int A_SS = A_FAC + 256 * 2 * 4;
constexpr int P8_BM = 256, P8_BK = 64, P8_HALF = 128, P8_HT = P8_HALF * P8_BK;
DI int lds_byte(int r, int c) { const int st = (r >> 4) * 2 + (c >> 5), rr = r & 15, cc = c & 31, ob = rr * 64 + cc * 2; return st * 1024 + (ob ^ (((ob >> 9) & 1) << 5)); }
DI void stage_rc(int b, int& R, int& C) { const int st = b / 1024, sb = b % 1024, swz = sb ^ (((sb >> 9) & 1) << 5); R = (st >> 1) * 16 + swz / 64; C = (st & 1) * 32 + (swz % 64) / 2; }
typedef __attribute__((address_space(3))) unsigned char lds_u8;

template <int EPI, bool I8>
DI void gemm8_epilogue(const Params& p, const f32x4 (&acc_in)[2][2][4][2], int brow, int bcol, int N, void* Cv, int wr, int wc, int fr, int fq, unsigned char* smem, int tid) {
    f32x4 acc[2][2][4][2];
    if (I8 && EPI != EPI_TOPK) {
        const float* srow = (const float*)(p.ws + (EPI == EPI_TOPK ? WS_SWQF : WS_H1S));
        const float* scol = (const float*)(p.ws + (EPI == EPI_TOPK ? WS_HS : WS_SWIN));
        f32x4 cs[2][2];
#pragma unroll
        for (int bj = 0; bj < 2; ++bj)
#pragma unroll
            for (int n = 0; n < 2; ++n) cs[bj][n] = *(const f32x4*)(scol + bcol + bj * 128 + wc * 32 + n * 16 + fq * 4);
#pragma unroll
        for (int ai = 0; ai < 2; ++ai)
#pragma unroll
            for (int m = 0; m < 4; ++m) {
                const float rs = srow[brow + ai * 128 + wr * 64 + m * 16 + fr];
#pragma unroll
                for (int bj = 0; bj < 2; ++bj)
#pragma unroll
                    for (int n = 0; n < 2; ++n) {
                        const i32x4 iv = __builtin_bit_cast(i32x4, acc_in[ai][bj][m][n]);
#pragma unroll
                        for (int j = 0; j < 4; ++j) acc[ai][bj][m][n][j] = (float)iv[j] * (rs * cs[bj][n][j]);
                    }
            }
    } else if (!I8) {
#pragma unroll
        for (int ai = 0; ai < 2; ++ai)
#pragma unroll
            for (int bj = 0; bj < 2; ++bj)
#pragma unroll
                for (int m = 0; m < 4; ++m)
#pragma unroll
                    for (int n = 0; n < 2; ++n) acc[ai][bj][m][n] = acc_in[ai][bj][m][n];
    }
    if (EPI == EPI_TOPK) {
        short* S16 = (short*)smem;
        int* X = (int*)smem;
        asm volatile("" : "+v"(tid), "+v"(fr), "+v"(fq), "+v"(wr), "+v"(wc));
        const int tt = tid & 255, hh = __builtin_amdgcn_readfirstlane(tid >> 8);
        {
            const float* srow = (const float*)(p.ws + WS_SWQF);
            const float* scol = (const float*)(p.ws + WS_HS);
            f32x4 cs[2][2];
#pragma unroll
            for (int bj = 0; bj < 2; ++bj)
#pragma unroll
                for (int n = 0; n < 2; ++n) cs[bj][n] = *(const f32x4*)(scol + bcol + bj * 128 + wc * 32 + n * 16 + fq * 4);
#pragma unroll
            for (int ai = 0; ai < 2; ++ai)
#pragma unroll
                for (int m = 0; m < 4; ++m) {
                    const float rs64 = srow[brow + ai * 128 + wr * 64 + m * 16 + fr] * 64.0f;
                    const int idc = 127 - (wr * 64 + m * 16 + fr);
#pragma unroll
                    for (int bj = 0; bj < 2; ++bj)
#pragma unroll
                        for (int n = 0; n < 2; ++n) {
                            const i32x4 iv = __builtin_bit_cast(i32x4, acc_in[ai][bj][m][n]);
#pragma unroll
                            for (int j = 0; j < 4; ++j) {
                                const float y = __builtin_amdgcn_fmed3f(__builtin_fmaf((float)iv[j] * cs[bj][n][j], rs64, 128.5f), 0.0f, 511.5f);
                                S16[(bj * 128 + wc * 32 + n * 16 + fq * 4 + j) * 264 + ai * 128 + wr * 64 + m * 16 + fr] = (short)(((int)y << 7) | idc);
                            }
                        }
                }
        }
        __syncthreads();
        int part[16];
        {
            const u32x4* rowp = (const u32x4*)(S16 + tt * 264 + hh * 128);
            unsigned ptop[16];
#pragma unroll
            for (int blk = 0; blk < 4; ++blk) {
                unsigned v[16];
#pragma unroll
                for (int q = 0; q < 4; ++q) { const u32x4 qa = rowp[4 * blk + q]; v[4 * q] = qa[0]; v[4 * q + 1] = qa[1]; v[4 * q + 2] = qa[2]; v[4 * q + 3] = qa[3]; }
                if (blk == 0) { psort16_desc(v);
#pragma unroll
                    for (int i = 0; i < 16; ++i) ptop[i] = v[i]; }
                else pmerge_top16(ptop, v);
            }
            int odd[16];
#pragma unroll
            for (int i = 0; i < 16; ++i) { part[i] = (int)(ptop[i] & 0xffffu); odd[i] = (int)(ptop[i] >> 16); }
            merge_sorted16(part, odd);
        }
        unsigned* X2 = (unsigned*)(smem + 135168) + tt * 8;
        if (hh == 1) {
            *(u32x4*)(X2) = (u32x4){(unsigned)part[0] | ((unsigned)part[1] << 16), (unsigned)part[2] | ((unsigned)part[3] << 16), (unsigned)part[4] | ((unsigned)part[5] << 16), (unsigned)part[6] | ((unsigned)part[7] << 16)};
            *(u32x4*)(X2 + 4) = (u32x4){(unsigned)part[8] | ((unsigned)part[9] << 16), (unsigned)part[10] | ((unsigned)part[11] << 16), (unsigned)part[12] | ((unsigned)part[13] << 16), (unsigned)part[14] | ((unsigned)part[15] << 16)};
        }
        __syncthreads();
        if (hh == 0) {
            int a1[16];
            {
                const u32x4 ua = *(const u32x4*)(X2), ub = *(const u32x4*)(X2 + 4);
#pragma unroll
                for (int q = 0; q < 4; ++q) { a1[2 * q] = (int)(ua[q] & 0xffffu); a1[2 * q + 1] = (int)(ua[q] >> 16); a1[8 + 2 * q] = (int)(ub[q] & 0xffffu); a1[8 + 2 * q + 1] = (int)(ub[q] >> 16); }
            }
            topk_second_level(part, a1, (int*)(smem + 32768) + tt * 16, (float*)(smem + 49152) + tt * 16, ((brow >> 8) & 1) != 0, (tt >> 1) & 3);
        }
        __syncthreads();
        {
            const int hd = brow >> 8, lane_ = tt & 63, tw0 = tt & ~63, cc = lane_ & 3;
            const int* rows_ = (const int*)(smem + (hh ? 49152 : 32768));
            int* gb_ = (int*)(p.ws + (hh ? WS_GATES : WS_IDS));
#pragma unroll
            for (int i = 0; i < 4; ++i) {
                const int tl_ = tw0 + 16 * i + (lane_ >> 2), pc = (cc ^ ((tl_ >> 1) & 3)) * 4;
                *(int4*)(gb_ + (size_t)(bcol + tl_) * 128 + hd * 16 + cc * 4) = *(const int4*)(rows_ + tl_ * 16 + pc);
            }
        }
        __syncthreads();
    } else if (EPI == EPI_BF16) {
        bf16_t* C = (bf16_t*)Cv;
#pragma unroll
        for (int ai = 0; ai < 2; ++ai)
#pragma unroll
            for (int m = 0; m < 4; ++m) {
                bf16_t* rp = C + (size_t)(brow + ai * 128 + wr * 64 + m * 16 + fr) * N + bcol + wc * 32 + fq * 4;
                const float rs_ = ((const float*)(smem + A_FAC))[(ai * 128 + wr * 64 + m * 16 + fr) * 2 + 1];
#pragma unroll
                for (int bj = 0; bj < 2; ++bj)
#pragma unroll
                    for (int n = 0; n < 2; ++n) {
                        const f32x4 v = acc[ai][bj][m][n] * rs_;
                        u32x2 o; o[0] = pk2(v[0], v[1]); o[1] = pk2(v[2], v[3]);
                        *(u32x2*)(rp + bj * 128 + n * 16) = o;
                    }
            }
    } else {
        bf16_t* C = (bf16_t*)Cv;
        const float* rope = (const float*)(p.ws + WS_ROPE);
        const int d0 = (wc & 1) * 16 + fq * 4;
#pragma unroll
        for (int bj = 0; bj < 2; ++bj) {
            const int hc = bcol + bj * 128 + (wc >> 1) * 64;
            const bool is_rope = hc < C_V, is_gelu = hc >= C_U;
            const float qs = (hc < C_K) ? 0.125f : 1.0f;
#pragma unroll
            for (int ai = 0; ai < 2; ++ai)
#pragma unroll
                for (int m = 0; m < 4; ++m) {
                    const int row = brow + ai * 128 + wr * 64 + m * 16 + fr;
                    f32x4 a = acc[ai][bj][m][0], b = acc[ai][bj][m][1];
                    if (is_rope) {
                        const int pos = row & (SEQ - 1);
                        const f32x4 t0 = *(const f32x4*)(rope + (pos * 32 + d0) * 2), t1 = *(const f32x4*)(rope + (pos * 32 + d0) * 2 + 4);
                        const float cs[4] = {t0[0], t0[2], t1[0], t1[2]}, sn[4] = {t0[1], t0[3], t1[1], t1[3]};
#pragma unroll
                        for (int j = 0; j < 4; ++j) { const float ra = a[j] * cs[j] - b[j] * sn[j], rb = b[j] * cs[j] + a[j] * sn[j]; a[j] = ra * qs; b[j] = rb * qs; }
                    } else if (is_gelu) {
                        const f32x2 a01 = gelu_pk((f32x2){a[0], a[1]}), a23 = gelu_pk((f32x2){a[2], a[3]}), b01 = gelu_pk((f32x2){b[0], b[1]}), b23 = gelu_pk((f32x2){b[2], b[3]});
                        a = (f32x4){a01[0], a01[1], a23[0], a23[1]}; b = (f32x4){b01[0], b01[1], b23[0], b23[1]};
                    }
                    bf16_t* rp = C + (size_t)row * N + hc + d0;
                    u32x2 oa, ob; oa[0] = pk2(a[0], a[1]); oa[1] = pk2(a[2], a[3]); ob[0] = pk2(b[0], b[1]); ob[1] = pk2(b[2], b[3]);
                    *(u32x2*)(rp) = oa; *(u32x2*)(rp + 32) = ob;
                }
        }
    }
}

template <int EPI, bool I8, int PANEL>
DI void gemm8_phase(const Params& p, const void* Av, const void* Btv, int M, int N, int K, void* C, unsigned char* smem) {
    const unsigned char* A = (const unsigned char*)Av; const unsigned char* Bt = (const unsigned char*)Btv;
    constexpr int ESZ = I8 ? 1 : 2, BKE = I8 ? 128 : 64;
    lds_u8* shm = (lds_u8*)smem;
#define SA(b, h) (shm + (((b) * 2 + (h)) * P8_HT) * 2)
#define SB(b, h) (shm + ((4 + (b) * 2 + (h)) * P8_HT) * 2)
#define STAGE(P, BASE, br, kt) do { const char* _sb = (const char*)(BASE) + ((long)(br) * K + (long)(kt) * BKE) * ESZ; \
      __builtin_amdgcn_global_load_lds((const unsigned*)(_sb + voff0), (__attribute__((address_space(3))) unsigned*)((P) + wbase), 16, 0, 0); \
      __builtin_amdgcn_global_load_lds((const unsigned*)(_sb + voff1), (__attribute__((address_space(3))) unsigned*)((P) + wbase + 8192), 16, 0, 0); } while (0)
#define LDA(dst, b, h) _Pragma("unroll") for (int m = 0; m < 4; ++m) _Pragma("unroll") for (int k = 0; k < 2; ++k) \
    dst[m][k] = *reinterpret_cast<const __attribute__((address_space(3))) bf16x8*>(SA(b, h) + lds_byte(wr * 64 + m * 16 + fr, k * 32 + fq * 8))
#define LDB(dst, b, h) _Pragma("unroll") for (int n = 0; n < 2; ++n) _Pragma("unroll") for (int k = 0; k < 2; ++k) \
    dst[n][k] = *reinterpret_cast<const __attribute__((address_space(3))) bf16x8*>(SB(b, h) + lds_byte(wc * 32 + n * 16 + fr, k * 32 + fq * 8))
#define MMA(ai, bj, At_, Bt_) do { __builtin_amdgcn_s_setprio(1); \
    _Pragma("unroll") for (int m = 0; m < 4; ++m) _Pragma("unroll") for (int n = 0; n < 2; ++n) _Pragma("unroll") for (int k = 0; k < 2; ++k) \
      acc[ai][bj][m][n] = I8 ? __builtin_bit_cast(f32x4, __builtin_amdgcn_mfma_i32_16x16x64_i8(__builtin_bit_cast(i32x4, Bt_[n][k]), __builtin_bit_cast(i32x4, At_[m][k]), __builtin_bit_cast(i32x4, acc[ai][bj][m][n]), 0, 0, 0)) \
                             : __builtin_amdgcn_mfma_f32_16x16x32_bf16(Bt_[n][k], At_[m][k], acc[ai][bj][m][n], 0, 0, 0); \
    __builtin_amdgcn_s_setprio(0); } while (0)
#define WAIT_V(n) asm volatile("s_waitcnt vmcnt(" #n ")" ::: "memory")
#define WAIT_L(n) asm volatile("s_waitcnt lgkmcnt(" #n ")" ::: "memory")
#define BAR __builtin_amdgcn_s_barrier()
#define SCHED __builtin_amdgcn_sched_barrier(0)
    const int nM = M / P8_BM, nN = N / P8_BM, nwg = nM * nN, G = gridDim.x;
    const int tid = opaque_tid(p);
    const int wid = tid >> 6, lane = tid & 63, wr = wid >> 2, wc = wid & 3, fr = lane & 15, fq = lane >> 4;
    const int nt = K / BKE;
    unsigned voff0, voff1;
    const int wbase = __builtin_amdgcn_readfirstlane(tid >> 6) * 1024;
    { int r_, c_; stage_rc(tid * 16, r_, c_); voff0 = (unsigned)(r_ * K * ESZ + c_ * 2); stage_rc(tid * 16 + 8192, r_, c_); voff1 = (unsigned)(r_ * K * ESZ + c_ * 2); }
    for (int round = 0;; ++round) {
        const long L = (long)round * G + blockIdx.x;
        if (PANEL == 0 && L >= nwg) break;
        int pm, pn;
        if (PANEL == 1) { pn = (round + (int)blockIdx.x) % nN; pm = (round / nN) * G + blockIdx.x; if (pm >= nM) break; }
        else if (PANEL == 2) { pm = (round + (int)blockIdx.x) % nM; pn = (round / nM) * G + blockIdx.x; if (pn >= nN) break; }
        else {
            int wgid = (int)L;
            { const int q = nwg / 8, r = nwg % 8, xcd = wgid % 8, off = wgid / 8; wgid = (xcd < r ? xcd * (q + 1) : r * (q + 1) + (xcd - r) * q) + off; }
            const int nig = 8 * nN, gid = wgid / nig, fm = gid * 8, gsz = (nM - fm) < 8 ? (nM - fm) : 8;
            pm = fm + ((wgid % nig) % gsz); pn = (wgid % nig) / gsz;
        }
        const int brow = pm * P8_BM, bcol = pn * P8_BM;
        f32x4 acc[2][2][4][2];
#pragma unroll
        for (int a = 0; a < 2; ++a)
#pragma unroll
            for (int b = 0; b < 2; ++b)
#pragma unroll
                for (int m = 0; m < 4; ++m)
#pragma unroll
                    for (int n = 0; n < 2; ++n) acc[a][b][m][n] = (f32x4){0.f, 0.f, 0.f, 0.f};
        bf16x8 At[4][2], B0[2][2], B1[2][2];
        STAGE(SB(0, 0), Bt, bcol, 0); STAGE(SA(0, 0), A, brow, 0);
        STAGE(SB(0, 1), Bt, bcol + P8_HALF, 0); STAGE(SA(0, 1), A, brow + P8_HALF, 0);
        if (wr == 1) BAR;
        WAIT_V(4); BAR;
        STAGE(SB(1, 0), Bt, bcol, 1); STAGE(SA(1, 0), A, brow, 1); STAGE(SB(1, 1), Bt, bcol + P8_HALF, 1);
        WAIT_V(6); BAR;
        for (int t = 0; t < nt - 2; t += 2) {
            if (EPI == EPI_BF16 && t == 8) {
                const float* fac_ = (const float*)(smem + A_FAC);
#pragma unroll
                for (int ai = 0; ai < 2; ++ai)
#pragma unroll
                    for (int m = 0; m < 4; ++m) {
                        const float rr_ = fac_[(ai * 128 + wr * 64 + m * 16 + fr) * 2];
#pragma unroll
                        for (int bj = 0; bj < 2; ++bj)
#pragma unroll
                            for (int n = 0; n < 2; ++n) acc[ai][bj][m][n] *= rr_;
                    }
                WAIT_L(0);
            }
            LDB(B0, 0, 0); SCHED; LDA(At, 0, 0); STAGE(SA(1, 1), A, brow + P8_HALF, t + 1);
            WAIT_L(8); BAR; WAIT_L(0); MMA(0, 0, At, B0); BAR; SCHED;
            LDB(B1, 0, 1); STAGE(SB(0, 0), Bt, bcol, t + 2);
            BAR; WAIT_L(0); MMA(0, 1, At, B1); BAR;
            LDA(At, 0, 1); STAGE(SA(0, 0), A, brow, t + 2);
            BAR; WAIT_L(0); MMA(1, 0, At, B0); BAR; SCHED;
            STAGE(SB(0, 1), Bt, bcol + P8_HALF, t + 2);
            WAIT_V(6); BAR; MMA(1, 1, At, B1); BAR;
            LDB(B0, 1, 0); SCHED; LDA(At, 1, 0); STAGE(SA(0, 1), A, brow + P8_HALF, t + 2);
            WAIT_L(8); BAR; WAIT_L(0); MMA(0, 0, At, B0); BAR; SCHED;
            LDB(B1, 1, 1); STAGE(SB(1, 0), Bt, bcol, t + 3);
            BAR; WAIT_L(0); MMA(0, 1, At, B1); BAR;
            LDA(At, 1, 1); STAGE(SA(1, 0), A, brow, t + 3);
            BAR; WAIT_L(0); MMA(1, 0, At, B0); BAR; SCHED;
            STAGE(SB(1, 1), Bt, bcol + P8_HALF, t + 3);
            WAIT_V(6); BAR; MMA(1, 1, At, B1); BAR;
        }
        { LDB(B0, 0, 0); LDA(At, 0, 0); STAGE(SA(1, 1), A, brow + P8_HALF, nt - 1);
          BAR; WAIT_L(0); MMA(0, 0, At, B0); BAR;
          LDB(B1, 0, 1); BAR; WAIT_L(0); MMA(0, 1, At, B1); BAR;
          LDA(At, 0, 1); WAIT_V(4); BAR; WAIT_L(0); MMA(1, 0, At, B0); MMA(1, 1, At, B1); BAR; }
        { LDB(B0, 1, 0); LDA(At, 1, 0); WAIT_V(2); BAR; WAIT_L(0); MMA(0, 0, At, B0); BAR;
          LDB(B1, 1, 1); WAIT_V(0); BAR; WAIT_L(0); MMA(0, 1, At, B1); BAR;
          LDA(At, 1, 1); BAR; WAIT_L(0); MMA(1, 0, At, B0); MMA(1, 1, At, B1); BAR; }
        if (wr == 0) BAR;
        gemm8_epilogue<EPI, I8>(p, acc, brow, bcol, N, C, wr, wc, fr, fq, smem, tid);
    }
#undef SA
#undef SB
#undef STAGE
#undef LDA
#undef LDB
#undef MMA
}

constexpr int A_KROW = 144;
constexpr int A_VROW = 520;
constexpr int A_KS = 0;
constexpr int A_VT = 2 * 256 * A_KROW;
constexpr int S_VROW = 272;
constexpr int A_LDS = A_SS + 8 * 128 * 4;

DI void head_store(const f32x16 (&o)[2], const float* gvec, bf16_t* yrow, float* ssw, int lane) {
    const int r = lane & 31, h = lane >> 5;
    float ss = 0.f;
#pragma unroll
    for (int dt = 0; dt < 2; ++dt)
#pragma unroll
        for (int i = 0; i < 16; ++i) ss += o[dt][i] * o[dt][i];
    ss = xor32_sum(ss);
    if (lane < 32) ssw[r] = ss;
#pragma unroll
    for (int dt = 0; dt < 2; ++dt)
#pragma unroll
        for (int q = 0; q < 2; ++q) {
            const int d = dt * 32 + 16 * h + 8 * q;
            const f32x4 ga = *(const f32x4*)(gvec + d), gb = *(const f32x4*)(gvec + d + 4);
            u32x4 pk;
            pk[0] = pk2(o[dt][8 * q + 0] * ga[0], o[dt][8 * q + 1] * ga[1]);
            pk[1] = pk2(o[dt][8 * q + 2] * ga[2], o[dt][8 * q + 3] * ga[3]);
            pk[2] = pk2(o[dt][8 * q + 4] * gb[0], o[dt][8 * q + 5] * gb[1]);
            pk[3] = pk2(o[dt][8 * q + 6] * gb[2], o[dt][8 * q + 7] * gb[3]);
            *(u32x4*)(yrow + d) = pk;
        }
}

DI bf16x8 pack8(const f32x16& x, int s) {
    u32x4 q;
    q[0] = pk2(x[8 * s + 0], x[8 * s + 1]); q[1] = pk2(x[8 * s + 2], x[8 * s + 3]);
    q[2] = pk2(x[8 * s + 4], x[8 * s + 5]); q[3] = pk2(x[8 * s + 6], x[8 * s + 7]);
    return __builtin_bit_cast(bf16x8, q);
}

DI void phase3(const Params& p, unsigned char* smem) {
    const int w = p.wid;
    const bf16_t* proj = (const bf16_t*)(p.ws + WS_PROJ);
    const bf16_t* wsb = (const bf16_t*)(p.ws + WS_WS);
    bf16_t* yin = (bf16_t*)(p.ws + WS_YIN);
    float* ssb = (float*)(smem + A_SS);
    float* fac = (float*)(smem + A_FAC);
    const int ipb = (NB * 16 + (int)gridDim.x - 1) / (int)gridDim.x;
#pragma unroll 1
    for (int item = blockIdx.x * ipb; item < NB * 16 && item < (blockIdx.x + 1) * ipb; ++item) {
        const int tid = opaque_tid(p), lane = tid & 63, r = lane & 31, h = lane >> 5;
        const int nblk = item & 15;
        const int tok0 = item * 128;
        for (int c = tid; c < 2 * 256 * 8; c += NTHREADS) {
            const int g = c >> 11, key = (c >> 3) & 255, kc = c & 7;
            u32x4 kv = {0u, 0u, 0u, 0u}, vv = {0u, 0u, 0u, 0u};
            if (nblk > 0 || key >= 128) {
                const size_t base = (size_t)(tok0 - 128 + key) * INC + g * 64 + kc * 8;
                kv = *(const u32x4*)(proj + base + C_K);
                vv = *(const u32x4*)(proj + base + C_V);
            }
            *(u32x4*)(smem + A_KS + (g * 256 + key) * A_KROW + kc * 16) = kv;
            *(u32x4*)(smem + A_VT + (g * 256 + key) * 128 + kc * 16) = vv;
        }
        __syncthreads();
        {
            const int g = w >> 2;
            const float sink = p.sinks[w];
            bf16x8 bq[4];
            {
                const int l0 = lane_id_fresh();
#pragma unroll
                for (int s = 0; s < 4; ++s) bq[s] = *(const bf16x8*)(proj + (size_t)(tok0 + (l0 & 31)) * INC + w * 64 + s * 16 + (l0 >> 5) * 8);
            }
#pragma unroll 1
            for (int qt = 0; qt < 4; ++qt) {
                const int lane = lane_id_fresh(), r = lane & 31, h = lane >> 5;
                const int tq = tok0 + qt * 32 + r;
                const unsigned char* kbase = smem + A_KS + (g * 256) * A_KROW;
                const unsigned char* vbase = smem + A_VT + (g * 256) * 128 + (((lane & 15) >> 2) + 4 * h) * 128 + (16 * (lane & 1) + 8 * ((lane >> 4) & 1) + 4 * ((lane >> 1) & 1)) * 2;
                f32x16 sacc[5];
#pragma unroll
                for (int kt = 0; kt < 5; ++kt) {
#pragma unroll
                    for (int i = 0; i < 16; ++i) sacc[kt][i] = 0.f;
                    const unsigned char* kp = kbase + (qt * 32 + kt * 32 + r) * A_KROW + h * 16;
#pragma unroll
                    for (int s = 0; s < 4; ++s) {
                        const bf16x8 ka = *(const bf16x8*)(kp + s * 32);
                        sacc[kt] = MFMA32(ka, bq[s], sacc[kt]);
                    }
                }
                if (qt + 1 < 4) {
#pragma unroll
                    for (int s = 0; s < 4; ++s) bq[s] = *(const bf16x8*)(proj + (size_t)(tq + 32) * INC + w * 64 + s * 16 + h * 8);
                }
                float mx = -INFINITY;
                if (nblk == 0) {
#pragma unroll
                    for (int kt = 0; kt < 5; ++kt)
#pragma unroll
                        for (int i = 0; i < 16; ++i) {
                            const int c = crow(i, h);
                            const bool valid = ((kt == 0) ? (c > r) : (kt == 4 ? (c <= r) : true)) && (qt * 32 + kt * 32 + c >= 128);
                            const float sv = valid ? sacc[kt][i] : -INFINITY;
                            sacc[kt][i] = sv;
                            mx = fmaxf(mx, sv);
                        }
                } else {
#pragma unroll
                    for (int kt = 0; kt < 5; ++kt)
#pragma unroll
                        for (int i = 0; i < 16; ++i) {
                            const int c = crow(i, h);
                            if (kt == 0) sacc[kt][i] = (c > r) ? sacc[kt][i] : -INFINITY;
                            if (kt == 4) sacc[kt][i] = (c <= r) ? sacc[kt][i] : -INFINITY;
                            mx = fmaxf(mx, sacc[kt][i]);
                        }
                }
                mx = xor32_max(mx);
                mx = fmaxf(mx, sink);
                const float mxl = mx * 1.44269504089f;
                float lsum = 0.f;
#pragma unroll
                for (int kt = 0; kt < 5; ++kt)
#pragma unroll
                    for (int i = 0; i < 16; ++i) { const float e = __builtin_amdgcn_exp2f(__builtin_fmaf(sacc[kt][i], 1.44269504089f, -mxl)); sacc[kt][i] = e; lsum += e; }
                lsum = xor32_sum(lsum);
                lsum += __builtin_amdgcn_exp2f(__builtin_fmaf(sink, 1.44269504089f, -mxl));
                const float inv_l = 1.0f / lsum;
                f32x16 o[2];
#pragma unroll
                for (int dt = 0; dt < 2; ++dt)
#pragma unroll
                    for (int i = 0; i < 16; ++i) o[dt][i] = 0.f;
#pragma unroll
                for (int kt = 0; kt < 5; ++kt)
#pragma unroll
                    for (int s = 0; s < 2; ++s) {
                        const bf16x8 pb = pack8(sacc[kt], s);
                        const int key0 = qt * 32 + kt * 32 + 16 * s;
#pragma unroll
                        for (int dt = 0; dt < 2; ++dt) {
                            const unsigned char* vp = vbase + key0 * 128 + dt * 64;
                            const s16x4 lo = __builtin_amdgcn_ds_read_tr16_b64_v4i16((__attribute__((address_space(3))) s16x4*)(vp));
                            const s16x4 hi = __builtin_amdgcn_ds_read_tr16_b64_v4i16((__attribute__((address_space(3))) s16x4*)(vp + 8 * 128));
                            const bf16x8 va = __builtin_shufflevector(lo, hi, 0, 1, 2, 3, 4, 5, 6, 7);
                            o[dt] = MFMA32(va, pb, o[dt]);
                        }
                    }
#pragma unroll
                for (int dt = 0; dt < 2; ++dt)
#pragma unroll
                    for (int i = 0; i < 16; ++i) o[dt][i] *= inv_l;
                head_store(o, p.g_att_out + w * 64, yin + (size_t)tq * DM + w * 64, ssb + w * 128 + qt * 32, lane);
            }
        }
        __syncthreads();
        const int il = item - blockIdx.x * ipb;
        if (tid < 128) {
            float tot = 0.f;
#pragma unroll
            for (int ww = 0; ww < 8; ++ww) tot += ssb[ww * 128 + tid];
            fac[(il * 128 + tid) * 2] = rsqrtf(tot * (1.0f / 512.0f) + EPS);
        }
        for (int rr = tid; rr < 128 * 8; rr += NTHREADS) {
            const int s = rr >> 3, hs = rr & 7;
            const bf16_t* src = proj + (size_t)(tok0 + s) * INC + C_VS + hs * 64;
            float v[64];
#pragma unroll
            for (int c = 0; c < 8; ++c) {
                const u32x4 q = *(const u32x4*)(src + c * 8);
#pragma unroll
                for (int i = 0; i < 4; ++i) { v[c * 8 + 2 * i] = bflo(q[i]); v[c * 8 + 2 * i + 1] = bfhi(q[i]); }
            }
            float mu = 0.f;
#pragma unroll
            for (int i = 0; i < 64; ++i) mu += v[i];
            mu *= (1.0f / 64.0f);
            float var = 0.f;
#pragma unroll
            for (int i = 0; i < 64; ++i) { const float d = v[i] - mu; var += d * d; }
            const float rstd = rsqrtf(var * (1.0f / 64.0f) + EPS);
            unsigned char* dst = smem + (hs * 128 + s) * 128;
#pragma unroll
            for (int c = 0; c < 8; ++c) {
                float yv[8];
#pragma unroll
                for (int i = 0; i < 8; ++i) yv[i] = (v[c * 8 + i] - mu) * rstd;
                u32x4 o4; o4[0] = pk2(yv[0], yv[1]); o4[1] = pk2(yv[2], yv[3]); o4[2] = pk2(yv[4], yv[5]); o4[3] = pk2(yv[6], yv[7]);
                *(u32x4*)(dst + c * 16) = o4;
            }
        }
        __syncthreads();
        {
            const unsigned char* vb = smem + (w * 128) * 128 + (((lane & 15) >> 2) + 8 * h) * 128 + (16 * (lane & 1) + 8 * ((lane >> 4) & 1) + 4 * ((lane >> 1) & 1)) * 2;
            bf16x8 wfr[8]; u32x4 uu[2][2]; float bias, rsw;
            const float* rswp = (const float*)(p.ws + WS_RSW);
            f32x4 lng[2][4], lnb[2][4];
#pragma unroll
            for (int dt = 0; dt < 2; ++dt)
#pragma unroll
                for (int g4 = 0; g4 < 4; ++g4) { lng[dt][g4] = *(const f32x4*)(p.sgu_ln_g + w * 64 + dt * 32 + 16 * h + 4 * g4); lnb[dt][g4] = *(const f32x4*)(p.sgu_ln_b + w * 64 + dt * 32 + 16 * h + 4 * g4); }
#define SGU_LOAD_W(TT) do { const bf16_t* wrow_ = wsb + (size_t)(w * 128 + (TT) * 32 + r) * 128 + h * 8; \
                _Pragma("unroll") for (int ks = 0; ks < 8; ++ks) if (ks < 2 * ((TT) + 1)) wfr[ks] = *(const bf16x8*)(wrow_ + ks * 16); } while (0)
#define SGU_LOAD_U(TT) do { const bf16_t* urow_ = proj + (size_t)(tok0 + (TT) * 32 + r) * INC + C_U + w * 64; \
                _Pragma("unroll") for (int dt = 0; dt < 2; ++dt) _Pragma("unroll") for (int q = 0; q < 2; ++q) uu[dt][q] = *(const u32x4*)(urow_ + dt * 32 + 16 * h + 8 * q); \
                bias = p.b_s[w * 128 + (TT) * 32 + r]; rsw = rswp[w * 128 + (TT) * 32 + r]; } while (0)
            SGU_LOAD_W(0); SGU_LOAD_U(0);
#pragma unroll
            for (int tt = 0; tt < 4; ++tt) {
                const int tl = tt * 32 + r;
                f32x16 o[2];
#pragma unroll
                for (int dt = 0; dt < 2; ++dt)
#pragma unroll
                    for (int i = 0; i < 16; ++i) o[dt][i] = 0.f;
#pragma unroll
                for (int ks = 0; ks < 8; ++ks) {
                    if (ks < 2 * (tt + 1)) {
#pragma unroll
                        for (int dt = 0; dt < 2; ++dt) {
                            const unsigned char* vp = vb + (ks * 16) * 128 + dt * 64;
                            const s16x4 lo = __builtin_amdgcn_ds_read_tr16_b64_v4i16((__attribute__((address_space(3))) s16x4*)(vp));
                            const s16x4 hi = __builtin_amdgcn_ds_read_tr16_b64_v4i16((__attribute__((address_space(3))) s16x4*)(vp + 4 * 128));
                            const bf16x8 va = __builtin_shufflevector(lo, hi, 0, 1, 2, 3, 4, 5, 6, 7);
                            o[dt] = MFMA32(va, wfr[ks], o[dt]);
                        }
                    }
                }
                if (tt < 3) SGU_LOAD_W(tt + 1);
#pragma unroll
                for (int dt = 0; dt < 2; ++dt)
#pragma unroll
                    for (int g4 = 0; g4 < 4; ++g4) {
                        o[dt][4 * g4 + 0] = (o[dt][4 * g4 + 0] * lng[dt][g4][0] + (lnb[dt][g4][0] * rsw + bias)) * bflo(uu[dt][g4 >> 1][(g4 & 1) * 2 + 0]);
                        o[dt][4 * g4 + 1] = (o[dt][4 * g4 + 1] * lng[dt][g4][1] + (lnb[dt][g4][1] * rsw + bias)) * bfhi(uu[dt][g4 >> 1][(g4 & 1) * 2 + 0]);
                        o[dt][4 * g4 + 2] = (o[dt][4 * g4 + 2] * lng[dt][g4][2] + (lnb[dt][g4][2] * rsw + bias)) * bflo(uu[dt][g4 >> 1][(g4 & 1) * 2 + 1]);
                        o[dt][4 * g4 + 3] = (o[dt][4 * g4 + 3] * lng[dt][g4][3] + (lnb[dt][g4][3] * rsw + bias)) * bfhi(uu[dt][g4 >> 1][(g4 & 1) * 2 + 1]);
                    }
                if (tt < 3) SGU_LOAD_U(tt + 1);
                head_store(o, p.g_sgu_out + w * 64, yin + (size_t)(tok0 + tl) * DM + 512 + w * 64, ssb + w * 128 + tt * 32, lane);
            }
#undef SGU_LOAD_W
#undef SGU_LOAD_U
        }
        __syncthreads();
        if (tid < 128) {
            float tot = 0.f;
#pragma unroll
            for (int ww = 0; ww < 8; ++ww) tot += ssb[ww * 128 + tid];
            const float rs = rsqrtf(tot * (1.0f / 512.0f) + EPS), ra = fac[(il * 128 + tid) * 2];
            fac[(il * 128 + tid) * 2] = ra / rs; fac[(il * 128 + tid) * 2 + 1] = rs;
        }
    }
}

template <int M> DI int shxi(int v, int lane) {
    if constexpr (M == 1) return __builtin_amdgcn_update_dpp(0, v, 0xB1, 0xf, 0xf, true);
    else if constexpr (M == 2) return __builtin_amdgcn_update_dpp(0, v, 0x4E, 0xf, 0xf, true);
    else if constexpr (M == 8) return __builtin_amdgcn_update_dpp(0, v, 0x128, 0xf, 0xf, true);
    else if constexpr (M == 16) { const auto r = __builtin_amdgcn_permlane16_swap((unsigned)v, (unsigned)v, false, false); return (int)((lane & 16) ? r[0] : r[1]); }
    else if constexpr (M == 32) { const auto r = __builtin_amdgcn_permlane32_swap((unsigned)v, (unsigned)v, false, false); return (int)((lane & 32) ? r[0] : r[1]); }
    else return __builtin_amdgcn_ds_swizzle(v, (M << 10) | 0x1f);
}
template <int M> DI float shxf(float v, int lane) { return __int_as_float(shxi<M>(__float_as_int(v), lane)); }
DI float wave_sum_l(float v, int lane) {
    v += shxf<1>(v, lane); v += shxf<2>(v, lane); v += shxf<4>(v, lane); v += shxf<8>(v, lane); v += shxf<16>(v, lane); v += shxf<32>(v, lane);
    return v;
}
template <int K, int J>
DI void bitonic_step128(unsigned (&key)[8], int lane) {
    if constexpr (J >= 64) {
#pragma unroll
        for (int t = 0; t < 4; ++t) {
            const unsigned lo = min(key[2 * t], key[2 * t + 1]), hi = max(key[2 * t], key[2 * t + 1]);
            key[2 * t] = lo; key[2 * t + 1] = hi;
        }
    } else {
        const bool lower = (lane & J) == 0;
#pragma unroll
        for (int r = 0; r < 8; ++r) {
            const unsigned other = (unsigned)shxi<J>((int)key[r], lane);
            const bool up = (K >= 128) ? true : ((K == 64) ? ((r & 1) == 0) : ((lane & K) == 0));
            const unsigned mn = min(key[r], other), mx = max(key[r], other);
            key[r] = (lower == up) ? mn : mx;
        }
    }
}
template <int K, int J>
DI void bitonic_merge128(unsigned (&key)[8], int lane) {
    bitonic_step128<K, J>(key, lane);
    if constexpr (J > 1) bitonic_merge128<K, J / 2>(key, lane);
}
template <int K>
DI void bitonic_sort128(unsigned (&key)[8], int lane) {
    if constexpr (K > 2) bitonic_sort128<K / 2>(key, lane);
    bitonic_merge128<K, K / 2>(key, lane);
}

DI unsigned pick(unsigned a, unsigned b, bool second) { const unsigned m = 0u - (unsigned)second; return a ^ ((a ^ b) & m); }
DI unsigned mk_key(unsigned idv, unsigned i) { return ((idv >> 4) << 7) | (i & 0x70u) | (idv & 15u); }
DI int reduce8i(const int (&part)[8], int lane) {
    int q4[4];
#pragma unroll
    for (int i = 0; i < 4; ++i) { const auto r = __builtin_amdgcn_permlane32_swap((unsigned)part[i], (unsigned)part[i + 4], false, false); q4[i] = (int)(r[0] + r[1]); }
    int q2[2];
#pragma unroll
    for (int i = 0; i < 2; ++i) { const auto r = __builtin_amdgcn_permlane16_swap((unsigned)q4[i], (unsigned)q4[i + 2], false, false); q2[i] = (int)(r[0] + r[1]); }
    const bool up = (lane & 8) != 0;
    const int send = up ? q2[0] : q2[1];
    const int keep = up ? q2[1] : q2[0];
    int s1 = keep + __builtin_amdgcn_update_dpp(0, send, 0x128, 0xf, 0xf, true);
    s1 += __builtin_amdgcn_update_dpp(0, s1, 0xB1, 0xf, 0xf, true);
    s1 += __builtin_amdgcn_update_dpp(0, s1, 0x4E, 0xf, 0xf, true);
    s1 += __builtin_amdgcn_update_dpp(0, s1, 0x141, 0xf, 0xf, true);
    return s1;
}

DI void phase8(const Params& p, unsigned char* smem) {
    const int w = __builtin_amdgcn_readfirstlane(opaque_tid(p) >> 6);
    const unsigned char* hq = p.ws + WS_HQ;
    const float* hs = (const float*)(p.ws + WS_HS);
    const unsigned char* ed = p.ws + WS_ED;
    const unsigned char* eu = p.ws + WS_EU;
    const float* scd = (const float*)(p.ws + WS_SCD);
    const float* scu = (const float*)(p.ws + WS_SCU);
    const float* swd = (const float*)(p.ws + WS_SWD);
    const int* ids = (const int*)(p.ws + WS_IDS);
    const float* gates = (const float*)(p.ws + WS_GATES);
    const float* mod = (const float*)(p.ws + WS_MOD);
    float* tabA = (float*)smem;
    unsigned* tabB = (unsigned*)(smem + NEXP * 4);
    {
        const int tid0 = opaque_tid(p);
#pragma unroll 4
        for (int i = tid0; i < NEXP; i += NTHREADS) {
            tabA[i] = scd[i];
            tabB[i] = ((unsigned)f2bf(scu[i]) << 16) | ((unsigned)(int)swd[i] & 0xffffu);
        }
        __syncthreads();
    }
    const int gw = blockIdx.x * NWAVES + w, NW = gridDim.x * NWAVES;
    unsigned nkey[8]; u32x4 hbn[4];
    {
        const int l0 = lane_id_fresh();
#pragma unroll
        for (int r = 0; r < 8; ++r) nkey[r] = gw < T / 4 ? mk_key((unsigned)ids[(size_t)(gw * 4 + (r >> 1)) * 128 + (r & 1) * 64 + l0], (unsigned)((r & 1) * 64 + l0)) : 0u;
#pragma unroll
        for (int tl = 0; tl < 4; ++tl) hbn[tl] = gw < T / 4 ? *(const u32x4*)(hq + (size_t)(gw * 4 + tl) * DM + l0 * 16) : (u32x4){0u, 0u, 0u, 0u};
    }
#pragma unroll 1
    for (int grp = gw; grp < T / 4; grp += NW) {
        const int t0 = grp * 4;
        int lane = lane_id_fresh();
        unsigned lane8 = 8u * (unsigned)lane;
        unsigned key[8];
#pragma unroll
        for (int r = 0; r < 8; ++r) key[r] = nkey[r];
        bitonic_merge128<32, 16>(key, lane); bitonic_merge128<64, 32>(key, lane); bitonic_merge128<128, 64>(key, lane);
        unsigned koff[8];
#pragma unroll
        for (int r = 0; r < 8; ++r) koff[r] = (key[r] >> 7) << 9;
        u32x4 hq4[4];
#pragma unroll
        for (int tl = 0; tl < 4; ++tl) {
            const u32x4 hb = hbn[tl];
            unsigned ch[4], cl[4];
#pragma unroll
            for (int j = 0; j < 4; ++j) {
                unsigned x = (hb[j] >> 4) & 0x0f0f0f0fu; x = (x | (x >> 4)) & 0x00ff00ffu; ch[j] = (x | (x >> 8)) & 0xffffu;
                unsigned y = (hb[j] & 0x0f0f0f0fu) ^ 0x08080808u; y = (y | (y >> 4)) & 0x00ff00ffu; cl[j] = (y | (y >> 8)) & 0xffffu;
            }
            hq4[tl] = (u32x4){ch[0] | (ch[1] << 16), ch[2] | (ch[3] << 16), cl[0] | (cl[1] << 16), cl[2] | (cl[3] << 16)};
        }
        float aval[8];
#pragma unroll
        for (int r = 0; r < 8; ++r) aval[r] = 0.f;
        {
            u32x2 bA[8], bB[8], bC[8], bD[8];
#define DN_LOAD(BUF, H, BH) do { \
                _Pragma("unroll") for (int j = 0; j < 8; ++j) { const unsigned eo_ = (unsigned)__builtin_amdgcn_readlane((int)koff[2 * (j & 3) + (H)], 2 * (BH) + (j >> 2)); \
                    BUF[j] = *(const u32x2*)(ed + (eo_ + lane8)); } } while (0)
#define DN_COMP(BUF, H, BH) do { int part[8]; \
                _Pragma("unroll") for (int j = 0; j < 8; ++j) { \
                    int a_ = __builtin_amdgcn_sdot8((int)BUF[j][1], (int)hq4[j & 3][1], __builtin_amdgcn_sdot8((int)BUF[j][0], (int)hq4[j & 3][0], zero_v, false), false) << 4;     \
                    a_ = __builtin_amdgcn_sdot8((int)BUF[j][1], (int)hq4[j & 3][3], __builtin_amdgcn_sdot8((int)BUF[j][0], (int)hq4[j & 3][2], a_, false), false);                    \
                    part[j] = a_; } \
                const int s1 = reduce8i(part, lane);                                               \
                stg = ((lane & 7) == ((BH) & 7)) ? s1 : stg; } while (0)
#define DN_DIST(H, G8) do { \
                _Pragma("unroll") for (int tl = 0; tl < 4; ++tl) { \
                    const int v_ = __builtin_amdgcn_ds_bpermute((8 * (4 * (lane & 1) + tl) + ((lane >> 1) & 7)) << 2, stg); \
                    aval[2 * tl + (H)] = ((lane >> 4) == (G8)) ? (float)v_ : aval[2 * tl + (H)]; } } while (0)
#define DN_LOOP(H) do { \
                _Pragma("unroll 1") for (int b4 = 0; b4 < 28; b4 += 4) { \
                    DN_LOAD(bD, H, b4 + 3); DN_COMP(bA, H, b4); \
                    DN_LOAD(bA, H, b4 + 4); DN_COMP(bB, H, b4 + 1); \
                    DN_LOAD(bB, H, b4 + 5); DN_COMP(bC, H, b4 + 2); \
                    DN_LOAD(bC, H, b4 + 6); DN_COMP(bD, H, b4 + 3); \
                    if (b4 & 4) DN_DIST(H, b4 >> 3); } } while (0)
            int stg = 0;
            int zero_v; asm volatile("v_mov_b32 %0, 0" : "=v"(zero_v));
            DN_LOAD(bA, 0, 0); DN_LOAD(bB, 0, 1); DN_LOAD(bC, 0, 2);
            DN_LOOP(0);
            DN_LOAD(bD, 0, 31); DN_COMP(bA, 0, 28);
            DN_LOAD(bA, 1, 0);  DN_COMP(bB, 0, 29);
            DN_LOAD(bB, 1, 1);  DN_COMP(bC, 0, 30);
            DN_LOAD(bC, 1, 2);  DN_COMP(bD, 0, 31);
            DN_DIST(0, 3);
            DN_LOOP(1);
            DN_LOAD(bD, 1, 31); DN_COMP(bA, 1, 28);
            DN_COMP(bB, 1, 29); DN_COMP(bC, 1, 30); DN_COMP(bD, 1, 31);
            DN_DIST(1, 3);
#undef DN_LOAD
#undef DN_COMP
#undef DN_DIST
#undef DN_LOOP
        }
        float cfv[8];
#pragma unroll
        for (int r = 0; r < 8; ++r) {
            const int tl = r >> 1, e = key[r] >> 7, k = key[r] & 127;
            const unsigned tb_ = tabB[e];
            cfv[r] = gates[(size_t)(t0 + tl) * 128 + k] * gelu_as((aval[r] + 8.0f * (float)(short)(tb_ & 0xffffu)) * hs[t0 + tl] * tabA[e]) * __uint_as_float(tb_ & 0xffff0000u);
        }
        lane = lane_id_fresh(); lane8 = 8u * (unsigned)lane;
        float st[4]; int s8[4];
        unsigned cfp[8];
#pragma unroll
        for (int tl = 0; tl < 4; ++tl) {
            const float m = wave_max_fast(fmaxf(fabsf(cfv[2 * tl]), fabsf(cfv[2 * tl + 1])), lane);
            const float stv = m > 0.f ? m * (1.0f / 127.0f) : 1.0f;
            st[tl] = __int_as_float(__builtin_amdgcn_readfirstlane(__float_as_int(stv)));
            const float inv = 1.0f / stv;
            int ssum = 0;
#pragma unroll
            for (int h = 0; h < 2; ++h) {
                const int cq = __float2int_rn(cfv[2 * tl + h] * inv);
                ssum += cq;
                const unsigned b0 = (unsigned)cq & 255u;
                const unsigned b1 = (unsigned)__builtin_amdgcn_update_dpp(0, (int)b0, 0x101, 0xf, 0xf, true), b2 = (unsigned)__builtin_amdgcn_update_dpp(0, (int)b0, 0x102, 0xf, 0xf, true),
                               b3 = (unsigned)__builtin_amdgcn_update_dpp(0, (int)b0, 0x103, 0xf, 0xf, true);
                cfp[2 * tl + h] = b0 | (b1 << 8) | (b2 << 16) | (b3 << 24);
            }
            ssum = wave_sum_fast_i(ssum);
            s8[tl] = __builtin_amdgcn_readfirstlane(8 * ssum);
        }
        int acc[4][16];
#pragma unroll
        for (int a = 0; a < 4; ++a)
#pragma unroll
            for (int b = 0; b < 16; ++b) acc[a][b] = 0;
        {
            u32x2 rA[16], rB[16];
#define UP_LOAD4(ROWS, H, GH, TL) do { \
                _Pragma("unroll") for (int r = 0; r < 4; ++r) { const unsigned eo_ = (unsigned)__builtin_amdgcn_readlane((int)koff[2 * (TL) + (H)], 4 * (GH) + r); \
                    ROWS[4 * (TL) + r] = *(const u32x2*)(eu + (eo_ + lane8)); } } while (0)
#define UP_COMP4(ROWS, H, GH, tl) do { \
                    const int cv_ = __builtin_amdgcn_readlane((int)cfp[2 * tl + (H)], 4 * (GH)); \
                    _Pragma("unroll") for (int d = 0; d < 2; ++d) { \
                        const unsigned ra_ = ROWS[4 * tl][d], rb_ = ROWS[4 * tl + 1][d], rc_ = ROWS[4 * tl + 2][d], rd_ = ROWS[4 * tl + 3][d]; \
                        const unsigned abl_ = __builtin_amdgcn_perm(rb_, ra_, 0x05010400u), abh_ = __builtin_amdgcn_perm(rb_, ra_, 0x07030602u); \
                        const unsigned cdl_ = __builtin_amdgcn_perm(rd_, rc_, 0x05010400u), cdh_ = __builtin_amdgcn_perm(rd_, rc_, 0x07030602u); \
                        const unsigned t0_ = __builtin_amdgcn_perm(cdl_, abl_, 0x05040100u), t1_ = __builtin_amdgcn_perm(cdl_, abl_, 0x07060302u); \
                        const unsigned t2_ = __builtin_amdgcn_perm(cdh_, abh_, 0x05040100u), t3_ = __builtin_amdgcn_perm(cdh_, abh_, 0x07060302u); \
                        acc[tl][8 * d + 0] = __builtin_amdgcn_sdot4((int)(t0_ & 0x0f0f0f0fu), cv_, acc[tl][8 * d + 0], false); \
                        acc[tl][8 * d + 1] = __builtin_amdgcn_sdot4((int)t0_, cv_, acc[tl][8 * d + 1], false); \
                        acc[tl][8 * d + 2] = __builtin_amdgcn_sdot4((int)(t1_ & 0x0f0f0f0fu), cv_, acc[tl][8 * d + 2], false); \
                        acc[tl][8 * d + 3] = __builtin_amdgcn_sdot4((int)t1_, cv_, acc[tl][8 * d + 3], false); \
                        acc[tl][8 * d + 4] = __builtin_amdgcn_sdot4((int)(t2_ & 0x0f0f0f0fu), cv_, acc[tl][8 * d + 4], false); \
                        acc[tl][8 * d + 5] = __builtin_amdgcn_sdot4((int)t2_, cv_, acc[tl][8 * d + 5], false); \
                        acc[tl][8 * d + 6] = __builtin_amdgcn_sdot4((int)(t3_ & 0x0f0f0f0fu), cv_, acc[tl][8 * d + 6], false); \
                        acc[tl][8 * d + 7] = __builtin_amdgcn_sdot4((int)t3_, cv_, acc[tl][8 * d + 7], false); } } while (0)
#define UP_STEP(ROWS, H, GH, HN, GN, REFILL) do { \
                UP_COMP4(ROWS, H, GH, 0); if (REFILL) UP_LOAD4(ROWS, HN, GN, 0); \
                UP_COMP4(ROWS, H, GH, 1); if (REFILL) UP_LOAD4(ROWS, HN, GN, 1); \
                UP_COMP4(ROWS, H, GH, 2); if (REFILL) UP_LOAD4(ROWS, HN, GN, 2); \
                UP_COMP4(ROWS, H, GH, 3); if (REFILL) UP_LOAD4(ROWS, HN, GN, 3); } while (0)
            UP_LOAD4(rA, 0, 0, 0); UP_LOAD4(rA, 0, 0, 1); UP_LOAD4(rA, 0, 0, 2); UP_LOAD4(rA, 0, 0, 3);
            UP_LOAD4(rB, 0, 1, 0); UP_LOAD4(rB, 0, 1, 1); UP_LOAD4(rB, 0, 1, 2); UP_LOAD4(rB, 0, 1, 3);
#pragma unroll 1
            for (int g2 = 0; g2 < 14; g2 += 2) { UP_STEP(rA, 0, g2, 0, g2 + 2, true); UP_STEP(rB, 0, g2 + 1, 0, g2 + 3, true); }
            UP_STEP(rA, 0, 14, 1, 0, true); UP_STEP(rB, 0, 15, 1, 1, true);
#pragma unroll 1
            for (int g2 = 0; g2 < 14; g2 += 2) { UP_STEP(rA, 1, g2, 1, g2 + 2, true); UP_STEP(rB, 1, g2 + 1, 1, g2 + 3, true); }
            UP_STEP(rA, 1, 14, 1, 0, false); UP_STEP(rB, 1, 15, 1, 0, false);
#undef UP_LOAD4
#undef UP_COMP4
#undef UP_STEP
        }
        lane = lane_id_fresh();
        const int b = t0 >> 11;
        float gpost[16], gt[16];
        u32x2 x1p[4][4];
        load_rowP(p.g_post_ffn, lane, gpost);
        load_rowP(mod + b * 6144 + 5120, lane, gt);
#pragma unroll
        for (int tl = 0; tl < 4; ++tl)
#pragma unroll
            for (int j = 0; j < 4; ++j) x1p[tl][j] = *(const u32x2*)((const bf16_t*)(p.ws + WS_X1) + (size_t)(t0 + tl) * DM + 256 * j + 4 * lane);
        {
            const int ng = grp + NW;
            if (ng < T / 4) {
#pragma unroll
                for (int r = 0; r < 8; ++r) nkey[r] = mk_key((unsigned)ids[(size_t)(ng * 4 + (r >> 1)) * 128 + (r & 1) * 64 + lane], (unsigned)((r & 1) * 64 + lane));
#pragma unroll
                for (int tl = 0; tl < 4; ++tl) hbn[tl] = *(const u32x4*)(hq + (size_t)(ng * 4 + tl) * DM + lane * 16);
            }
        }
        float o[4][16];
#pragma unroll
        for (int tl = 0; tl < 4; ++tl) {
            float y2[16];
#pragma unroll
            for (int k = 0; k < 16; ++k) y2[k] = (k & 1) ? (float)(acc[tl][k] - acc[tl][k - 1]) * (st[tl] * (1.0f / 16.0f)) : (float)(acc[tl][k] - s8[tl]) * st[tl];
            float ss = 0.f;
#pragma unroll
            for (int i = 0; i < 16; ++i) ss += y2[i] * y2[i];
            const float rstd = rsqrtf(wave_sum_fast(ss, lane) * (1.0f / DM) + EPS);
            float x1[16];
#pragma unroll
            for (int j = 0; j < 4; ++j) { const u32x2 a = x1p[tl][j]; x1[4 * j] = bflo(a[0]); x1[4 * j + 1] = bfhi(a[0]); x1[4 * j + 2] = bflo(a[1]); x1[4 * j + 3] = bfhi(a[1]); }
#pragma unroll
            for (int i = 0; i < 16; ++i) o[tl][i] = x1[i] + gt[i] * (y2[i] * rstd * gpost[i]);
        }
#pragma unroll
        for (int r = 0; r < 8; ++r) asm volatile("" : "+v"(nkey[r]));
#pragma unroll
        for (int tl = 0; tl < 4; ++tl) asm volatile("" : "+v"(hbn[tl]));
        __builtin_amdgcn_sched_barrier(0);
#pragma unroll
        for (int tl = 0; tl < 4; ++tl) store_rowP_nt(p.out + (size_t)(t0 + tl) * DM, lane, o[tl]);
    }
}

#define XB_TMO      128
#define XB_XCNT(j)  (256  + 64 * (j))
#define XB_XSUB(j)  (1280 + 64 * (j))
#define XB_XGEN(j)  (2304 + 64 * (j))
#define XB_TOP      3328
#define XB_TOPGEN   3392
#define XCD_BAR_WORDS 3456
#define XB_SPIN_CAP (1u << 22)
DI unsigned xb_ld(unsigned* p)              { return __hip_atomic_load(p, __ATOMIC_RELAXED, __HIP_MEMORY_SCOPE_AGENT); }
DI unsigned xb_add(unsigned* p, unsigned v) { return __hip_atomic_fetch_add(p, v, __ATOMIC_RELAXED, __HIP_MEMORY_SCOPE_AGENT); }
DI unsigned xb_xcc_id() { return (unsigned)__builtin_amdgcn_s_getreg((3 << 11) | 20) & 0xFu; }
#define XB_SPIN(cond, bar) do { unsigned _sp = 0; while (cond) { __builtin_amdgcn_s_sleep(1); \
    if ((++_sp & 255u) == 0u) { if (xb_ld(&(bar)[XB_TMO])) break; if (_sp > XB_SPIN_CAP) { atomicAdd(&(bar)[XB_TMO], 1u); break; } } } } while (0)
struct XcdBarrier { unsigned* bar; unsigned x; volatile unsigned* st; };
DI XcdBarrier xcd_barrier_post(const Params& p, unsigned* bar, volatile unsigned* st) {
    XcdBarrier b; b.bar = bar; b.x = xb_xcc_id(); b.st = st;
    if (opaque_tid(p) == 0) (void)xb_add(&bar[XB_XCNT(b.x)], 1u);
    return b;
}
DI void xcd_barrier_complete(unsigned* bar, unsigned x, unsigned& nloc, unsigned& nx) {
    const unsigned G = gridDim.x;
    unsigned sum, cnt, mine, sp = 0u;
    for (;;) {
        sum = 0u; cnt = 0u; mine = 0u;
#pragma unroll
        for (unsigned j = 0; j < 16; ++j) { const unsigned c = xb_ld(&bar[XB_XCNT(j)]); sum += c; cnt += (c > 0u) ? 1u : 0u; mine = (j == x) ? c : mine; }
        if (sum == G) break;
        __builtin_amdgcn_s_sleep(1);
        if ((++sp & 255u) == 0u) { if (xb_ld(&bar[XB_TMO])) break; if (sp > XB_SPIN_CAP) { atomicAdd(&bar[XB_TMO], 1u); break; } }
    }
    nloc = mine > 0u ? mine : 1u; nx = cnt > 0u ? cnt : 1u;
}
DI void xcd_barrier(const Params& p, const XcdBarrier& b) {
    asm volatile("s_waitcnt vmcnt(0)" ::: "memory");
    __syncthreads();
    if (opaque_tid(p) == 0) {
        unsigned* bar = b.bar;
        __builtin_amdgcn_s_waitcnt(0);
        unsigned nloc = b.st[0], nx = b.st[1];
        if (nloc == 0u) { xcd_barrier_complete(bar, b.x, nloc, nx); b.st[0] = nloc; b.st[1] = nx; }
        const unsigned old = xb_add(&bar[XB_XSUB(b.x)], 1u);
        const unsigned gen = old / nloc;
        if (old + 1u == (gen + 1u) * nloc) {
            __builtin_amdgcn_fence(__ATOMIC_RELEASE, "agent");
            asm volatile("s_waitcnt vmcnt(0)" ::: "memory");
            const unsigned og = xb_add(&bar[XB_TOP], 1u);
            const unsigned tg = og / nx;
            if (og + 1u == (tg + 1u) * nx) xb_add(&bar[XB_TOPGEN], 1u);
            else XB_SPIN(xb_ld(&bar[XB_TOPGEN]) == tg, bar);
            __builtin_amdgcn_fence(__ATOMIC_ACQUIRE, "agent");
            xb_add(&bar[XB_XGEN(b.x)], 1u);
            asm volatile("s_waitcnt vmcnt(0)" ::: "memory");
        } else {
            XB_SPIN(xb_ld(&bar[XB_XGEN(b.x)]) == gen, bar);
            __builtin_amdgcn_fence(__ATOMIC_ACQUIRE, "agent");
            asm volatile("s_waitcnt vmcnt(0)" ::: "memory");
        }
    }
    __syncthreads();
}

constexpr int LDS_BYTES = 147456;

template <int PHS>
DI void run_phase(const Params& p, unsigned char* smem) {
    if (PHS == 0) phase0(p, smem);
    else if (PHS == 1) phase1(p);
    else if (PHS == 2) gemm8_phase<EPI_PROJ, true, 0>(p, p.ws + WS_H, p.ws + WS_WIN, T, INC, DM, p.ws + WS_PROJ, smem);
    else if (PHS == 3) phase3(p, smem);
    else if (PHS == 4) gemm8_phase<EPI_BF16, false, 1>(p, p.ws + WS_YIN, p.ws + WS_WOUT, T, DM, DM, p.ws + WS_Y, smem);
    else if (PHS == 5) phase5(p);
    else if (PHS == 6) gemm8_phase<EPI_TOPK, true, 2>(p, p.ws + WS_WQF, p.ws + WS_HQ, 2048, T, DM, p.ws + WS_SCT, smem);
    else if (PHS == 8) phase8(p, smem);
}

__global__ void __launch_bounds__(NTHREADS) k_mega(Params p_in) {
    __shared__ __attribute__((aligned(16))) unsigned char smem[LDS_BYTES];
    Params p = p_in; p.wid = __builtin_amdgcn_readfirstlane(threadIdx.x >> 6);
    volatile unsigned* st = (volatile unsigned*)(smem + LDS_BYTES - 16);
    if (opaque_tid(p) == 0) { st[0] = 0u; st[1] = 0u; }
    __syncthreads();
    const XcdBarrier xb = xcd_barrier_post(p, (unsigned*)(p.ws + WS_BAR), st);
#define RUNP(k) do { run_phase<k>(p, smem); xcd_barrier(p, xb); } while (0)
#define LOCAL_SEAM() do { asm volatile("s_waitcnt vmcnt(0)" ::: "memory"); __syncthreads(); } while (0)
    RUNP(0); RUNP(1); RUNP(2);
    run_phase<3>(p, smem); LOCAL_SEAM();
    run_phase<4>(p, smem); LOCAL_SEAM();
    run_phase<5>(p, smem); LOCAL_SEAM();
    RUNP(6);
    run_phase<8>(p, smem);
}

extern "C" void kernel_launch(void* const* d_in, const int* in_sizes, int n_in, void* d_out, int out_size, void* d_ws, size_t ws_size, hipStream_t stream) {
    if (n_in != 21 || out_size != T * DM || ws_size < WS_END) {
        fprintf(stderr, "kernel_launch: unexpected shapes (n_in %d out %d ws %zu need %zu)\n", n_in, out_size, ws_size, (size_t)WS_END);
        return;
    }
    Params p{};
    const float** f = (const float**)&p;
    for (int i = 0; i < 21; ++i) f[i] = (const float*)d_in[i];
    p.out = (float*)d_out; p.ws = (unsigned char*)d_ws;
    static int grid = 0;
    if (grid < 0) return;
    if (!grid) {
        int dev = 0, cus = 0, per_cu = 0;
        (void)hipGetDevice(&dev);
        (void)hipDeviceGetAttribute(&cus, hipDeviceAttributeMultiprocessorCount, dev);
        (void)hipOccupancyMaxActiveBlocksPerMultiprocessor(&per_cu, (const void*)k_mega, NTHREADS, 0);
        if (per_cu < 1) { fprintf(stderr, "kernel_launch: occupancy query says %d blocks per CU\n", per_cu); per_cu = 1; }
        if (cus < 256) { fprintf(stderr, "kernel_launch: built for a 256-CU device (got %d CUs); nothing launched\n", cus); grid = -1; return; }
        grid = 256;
    }
    (void)hipMemsetAsync((unsigned char*)d_ws + WS_BAR, 0, WS_BAR_BYTES, stream);
    void* args[] = {&p};
    hipError_t e = hipLaunchCooperativeKernel((const void*)k_mega, dim3(grid), dim3(NTHREADS), args, 0, stream);
    if (e != hipSuccess) fprintf(stderr, "cooperative launch failed: %s (grid %d)\n", hipGetErrorString(e), grid);
}
```
